# Optimizing an MI355X kernel written in HIP

```python
import jax, jax.numpy as jnp
from jax import lax
import numpy as np

D_MODEL = 1024
BATCH = 4
SEQ = 8192
DEPTH = 2

CHUNK = 64
PLE_DIM = 256
EPS = 1e-6
N_EVEN = (DEPTH + 1) // 2
N_ODD = DEPTH // 2

MIX_WIDTH = D_MODEL
A_HEADS = 8
A_HEAD_DIM = MIX_WIDTH // 2 // A_HEADS
A_WIDTH = A_HEADS * A_HEAD_DIM
GMLP_BLOCK = 128
B_WIDTH = MIX_WIDTH - A_WIDTH
CONV_W = 3
AB_IN = 2 * A_WIDTH + 3 * B_WIDTH

C_HEAD_DIM = 128
C_HEADS = D_MODEL // C_HEAD_DIM
C_WIDTH = C_HEADS * C_HEAD_DIM

D_FF = ((8 * D_MODEL // 3 + 127) // 128) * 128
N_EXPERTS = 8
TOP_K = 2
E_FF = 7 * D_MODEL // 2

kernel_name = "hybrid_gmlp_shortconv_hgrn2_moe_trunk"


def rms_norm(x, g):
    xf = x.astype(jnp.float32)
    y = xf * lax.rsqrt(jnp.mean(xf * xf, axis=-1, keepdims=True) + EPS)
    return (y * g.astype(jnp.float32)).astype(x.dtype)


def layer_norm(x, g, b):
    xf = x.astype(jnp.float32)
    mu = jnp.mean(xf, axis=-1, keepdims=True)
    xc = xf - mu
    y = xc * lax.rsqrt(jnp.mean(xc * xc, axis=-1, keepdims=True) + EPS)
    return (y * g.astype(jnp.float32) + b.astype(jnp.float32)).astype(x.dtype)


def swiglu(h, w_gu, w_down):
    gate, up = jnp.split(h @ w_gu, 2, axis=-1)
    return (jax.nn.silu(gate) * up) @ w_down


def gmlp_spatial_gate(u, v, ln_g, ln_b, w_s, b_s):
    bsz, s, _ = u.shape
    nb = s // GMLP_BLOCK
    v = v.reshape(bsz, s, A_HEADS, A_HEAD_DIM)
    v = layer_norm(v, ln_g.reshape(A_HEADS, A_HEAD_DIM), ln_b.reshape(A_HEADS, A_HEAD_DIM))
    v = v.reshape(bsz, nb, GMLP_BLOCK, A_HEADS, A_HEAD_DIM)
    chunk_id = jnp.arange(GMLP_BLOCK) // CHUNK
    mask = chunk_id[None, :] <= chunk_id[:, None]
    w = jnp.where(mask[None], w_s, 0)
    f = jnp.einsum('hij,bnjhd->bnihd', w, v) + b_s.T[:, :, None]
    return u * f.reshape(bsz, s, A_WIDTH)


def causal_depthwise_conv(x, w):
    return lax.conv_general_dilated(
        x, w[:, None, :], window_strides=(1,), padding=[(CONV_W - 1, 0)],
        dimension_numbers=('NWC', 'WIO', 'NWC'), feature_group_count=x.shape[-1])


def mixer_ab(h, w_in, a_ln_g, a_ln_b, a_ws, a_bs, b_conv, w_out):
    z = h @ w_in
    u, v, xb, cg, bg = jnp.split(
        z, [A_WIDTH, 2 * A_WIDTH, 2 * A_WIDTH + B_WIDTH, 2 * A_WIDTH + 2 * B_WIDTH], axis=-1)
    ya = gmlp_spatial_gate(jax.nn.gelu(u), jax.nn.gelu(v), a_ln_g, a_ln_b, a_ws, a_bs)
    yb = bg * causal_depthwise_conv(cg * xb, b_conv)
    return jnp.concatenate([ya, yb], axis=-1) @ w_out


def hgrn2(h, w_in, lb, o_norm_g, w_out):
    bsz, s, _ = h.shape
    n = s // CHUNK
    q, f, i, g = jnp.split(h @ w_in, 4, axis=-1)
    forget = lb + (1.0 - lb) * jax.nn.sigmoid(f.astype(jnp.float32))
    log_f = jnp.log(forget)
    k = 1.0 - forget
    q = jax.nn.silu(q.astype(jnp.float32))
    i = i.astype(jnp.float32)

    def to_chunks(t):
        return t.reshape(bsz, n, CHUNK, C_HEADS, C_HEAD_DIM).transpose(1, 0, 3, 2, 4)

    causal = jnp.tril(jnp.ones((CHUNK, CHUNK), dtype=bool))

    def step(state, inp):
        qc, kc, ic, lfc = inp
        b = jnp.cumsum(lfc, axis=2)
        o_inter = jnp.einsum('bhtk,bhkv->bhtv', qc * jnp.exp(b), state)
        diff = b[:, :, :, None, :] - b[:, :, None, :, :]
        decay = jnp.exp(jnp.where(causal[:, :, None], diff, -jnp.inf))
        attn = jnp.einsum('bhtk,bhsk,bhtsk->bhts', qc, kc, decay)
        o = o_inter + jnp.einsum('bhts,bhsv->bhtv', attn, ic)
        b_last = b[:, :, -1:, :]
        k_dec = kc * jnp.exp(b_last - b)
        new_state = jnp.exp(b_last[:, :, 0, :])[..., None] * state + \
            jnp.einsum('bhsk,bhsv->bhkv', k_dec, ic)
        return new_state, o

    state0 = jnp.zeros((bsz, C_HEADS, C_HEAD_DIM, C_HEAD_DIM), jnp.float32)
    _, o = lax.scan(step, state0, (to_chunks(q), to_chunks(k), to_chunks(i), to_chunks(log_f)))
    o = o.transpose(1, 0, 3, 2, 4).reshape(bsz, s, C_HEADS, C_HEAD_DIM).astype(h.dtype)
    o = rms_norm(o, o_norm_g.reshape(C_HEADS, C_HEAD_DIM)).reshape(bsz, s, C_WIDTH)
    return (o * jax.nn.silu(g)) @ w_out


def moe_swiglu(h, w_router, b_router, w_gu, w_down):
    logits = (h @ w_router).astype(jnp.float32) + b_router.astype(jnp.float32)
    top_logit, top_idx = lax.top_k(logits, TOP_K)
    top_w = jax.nn.softmax(top_logit, axis=-1)
    gates = jnp.sum(jax.nn.one_hot(top_idx, N_EXPERTS, dtype=jnp.float32) * top_w[..., None], axis=-2)
    gates = gates.astype(h.dtype)
    out = jnp.zeros_like(h)
    for e in range(N_EXPERTS):
        out = out + gates[..., e:e + 1] * swiglu(h, w_gu[e], w_down[e])
    return out


def setup_inputs(seed: int = 0) -> dict:
    key = jax.random.key(seed)
    ks = iter(jax.random.split(key, 32))
    f32 = jnp.float32

    def nrm(shape, scale):
        return jax.random.normal(next(ks), shape, f32) * scale

    return {
        "x": nrm((BATCH, SEQ, D_MODEL), 1.0),
        "p": nrm((DEPTH, BATCH, SEQ, PLE_DIM), 1.0),
        "norm_g": 1.0 + nrm((DEPTH, 4, D_MODEL), 0.1),
        "w_in_ab": nrm((N_EVEN, D_MODEL, AB_IN), D_MODEL ** -0.5),
        "a_ln_g": 1.0 + nrm((N_EVEN, A_WIDTH), 0.1),
        "a_ln_b": nrm((N_EVEN, A_WIDTH), 0.1),
        "a_ws": nrm((N_EVEN, A_HEADS, GMLP_BLOCK, GMLP_BLOCK), GMLP_BLOCK ** -0.5),
        "a_bs": 1.0 + nrm((N_EVEN, A_HEADS, GMLP_BLOCK), 0.1),
        "b_conv": nrm((N_EVEN, CONV_W, B_WIDTH), CONV_W ** -0.5),
        "w_out_ab": nrm((N_EVEN, MIX_WIDTH, D_MODEL), MIX_WIDTH ** -0.5),
        "ffn_w_gu": nrm((N_EVEN, D_MODEL, 2 * D_FF), D_MODEL ** -0.5),
        "ffn_w_down": nrm((N_EVEN, D_FF, D_MODEL), D_FF ** -0.5),
        "w_in_c": nrm((N_ODD, D_MODEL, 4 * C_WIDTH), D_MODEL ** -0.5),
        "lb_param": nrm((DEPTH, C_WIDTH), 0.5),
        "c_onorm_g": 1.0 + nrm((N_ODD, C_WIDTH), 0.1),
        "w_out_c": nrm((N_ODD, C_WIDTH, D_MODEL), C_WIDTH ** -0.5),
        "w_router": nrm((N_ODD, D_MODEL, N_EXPERTS), D_MODEL ** -0.5),
        "b_router": nrm((N_ODD, N_EXPERTS), 0.01),
        "e_w_gu": nrm((N_ODD, N_EXPERTS, D_MODEL, 2 * E_FF), D_MODEL ** -0.5),
        "e_w_down": nrm((N_ODD, N_EXPERTS, E_FF, D_MODEL), E_FF ** -0.5),
        "ple_w_proj": nrm((DEPTH, PLE_DIM, D_MODEL), PLE_DIM ** -0.5),
        "ple_w_gate": nrm((DEPTH, D_MODEL, D_MODEL), D_MODEL ** -0.5),
    }


def reference(x, p, norm_g, w_in_ab, a_ln_g, a_ln_b, a_ws, a_bs, b_conv, w_out_ab,
              ffn_w_gu, ffn_w_down, w_in_c, lb_param, c_onorm_g, w_out_c,
              w_router, b_router, e_w_gu, e_w_down, ple_w_proj, ple_w_gate):
    sm = jax.nn.softmax(lb_param.astype(jnp.float32), axis=0)
    lower_bounds = jnp.cumsum(sm, axis=0) - sm[0:1]

    for layer in range(DEPTH):
        j = layer // 2
        hn = rms_norm(x, norm_g[layer, 0])
        if layer % 2 == 0:
            mix = mixer_ab(hn, w_in_ab[j], a_ln_g[j], a_ln_b[j], a_ws[j], a_bs[j],
                           b_conv[j], w_out_ab[j])
        else:
            mix = hgrn2(hn, w_in_c[j], lower_bounds[layer], c_onorm_g[j], w_out_c[j])
        x = x + rms_norm(mix, norm_g[layer, 1])

        hn = rms_norm(x, norm_g[layer, 2])
        if layer % 2 == 0:
            ffn = swiglu(hn, ffn_w_gu[j], ffn_w_down[j])
        else:
            ffn = moe_swiglu(hn, w_router[j], b_router[j], e_w_gu[j], e_w_down[j])
        x = x + rms_norm(ffn, norm_g[layer, 3])

        gate = jax.nn.sigmoid(x @ ple_w_gate[layer])
        x = x + gate * (p[layer] @ ple_w_proj[layer])
    return x
```

```cpp
#include <hip/hip_runtime.h>
#include <cstdio>
#include <cstdint>

#ifndef MK_N_LAUNCHES
#define MK_N_LAUNCHES 0
#endif

#define GAS __attribute__((address_space(1)))
#define LAS __attribute__((address_space(3)))
typedef unsigned short bf16_t;
typedef short bf16x8 __attribute__((ext_vector_type(8)));
typedef float f32x4 __attribute__((ext_vector_type(4)));
typedef float f32x2 __attribute__((ext_vector_type(2)));
typedef unsigned u32x4 __attribute__((ext_vector_type(4)));
typedef unsigned u32x2 __attribute__((ext_vector_type(2)));
typedef int i32x4 __attribute__((ext_vector_type(4)));

constexpr int D = 1024, BATCH = 4, SEQ = 8192, M = BATCH * SEQ;
constexpr int PLE = 256, AB_IN = 2560, FF = 2816, CW = 1024, NE = 8, EFF = 3584;
constexpr float EPS = 1e-6f;
constexpr int NWAVES = 8, NTHR = 512;
constexpr int MAXP = 264;

__device__ __forceinline__ float bflo(unsigned w) { return __uint_as_float(w << 16); }
__device__ __forceinline__ float bfhi(unsigned w) { return __uint_as_float(w & 0xffff0000u); }
__device__ __forceinline__ float bf2f(bf16_t b) { return __uint_as_float((unsigned)b << 16); }
__device__ __forceinline__ unsigned cvt_pk_bf16(float lo, float hi) { unsigned r; asm volatile("v_cvt_pk_bf16_f32 %0, %1, %2" : "=v"(r) : "v"(lo), "v"(hi)); return r; }
__device__ __forceinline__ bf16_t f2bf(float f) { return (bf16_t)(cvt_pk_bf16(f, 0.f) & 0xffffu); }
__device__ __forceinline__ float fsigmoid(float x) { return __builtin_amdgcn_rcpf(1.0f + __builtin_amdgcn_exp2f(-1.4426950408889634f * x)); }
__device__ __forceinline__ float fsilu(float x) { return x * fsigmoid(x); }
__device__ __forceinline__ float fgelu_tanh(float x) { const float u = x + 0.044715f * x * x * x; return x * __builtin_amdgcn_rcpf(1.0f + __builtin_amdgcn_exp2f(-2.3022082f * u)); }
__device__ __forceinline__ float wave_sum(float v) {
#pragma unroll
    for (int o = 1; o < 64; o <<= 1) v += __shfl_xor(v, o);
    return v;
}
__device__ __forceinline__ void unpack8(const u32x4 a, float* v) { v[0] = bflo(a.x); v[1] = bfhi(a.x); v[2] = bflo(a.y); v[3] = bfhi(a.y); v[4] = bflo(a.z); v[5] = bfhi(a.z); v[6] = bflo(a.w); v[7] = bfhi(a.w); }
__device__ __forceinline__ u32x4 pack8(const float* v) { u32x4 w; w.x = cvt_pk_bf16(v[0], v[1]); w.y = cvt_pk_bf16(v[2], v[3]); w.z = cvt_pk_bf16(v[4], v[5]); w.w = cvt_pk_bf16(v[6], v[7]); return w; }

namespace pg8 {
constexpr int BM = 256, BK = 64, HALF = 128, HTB = HALF * BK * 2, STAGE_BYTES = 8 * HTB, NXCD = 8, WGM = 8;
__host__ __device__ __forceinline__ int lds_byte(int r, int c) { const int st = (r >> 4) * 2 + (c >> 5), rr = r & 15, cc = c & 31, ob = rr * 64 + cc * 2; return st * 1024 + (ob ^ (((ob >> 9) & 1) << 5)); }
__host__ __device__ __forceinline__ void stage_rc(int b, int& R, int& C) { const int st = b / 1024, sb = b % 1024, swz = sb ^ (((sb >> 9) & 1) << 5); R = (st >> 1) * 16 + swz / 64; C = (st & 1) * 32 + (swz % 64) / 2; }
__host__ __device__ __forceinline__ int perm32(int rho) { const int n = rho >> 4, i = rho & 15; return 8 * (i >> 2) + 4 * n + (i & 3); }

struct Unit { int pm, pn; const char* a; const char* b; };

__device__ __forceinline__ bool tile_of(int i, int G, int c, int nM, int nN, int& pm, int& pn) {
    const int nwg = nM * nN; const long L = (long)i * G + c; if (L >= nwg) return false;
    int wgid = (int)L; { const int q = nwg / NXCD, r = nwg % NXCD, xcd = wgid % NXCD, off = wgid / NXCD; wgid = (xcd < r ? xcd * (q + 1) : r * (q + 1) + (xcd - r) * q) + off; }
    const int nig = WGM * nN, gid = wgid / nig, fm = gid * WGM, gsz = (nM - fm) < WGM ? (nM - fm) : WGM;
    pm = fm + ((wgid % nig) % gsz); pn = (wgid % nig) / gsz; return true;
}
struct StaticOrder {
    int nM, nN, G, c; const char* A; const char* Bt; size_t tstep;
    __device__ __forceinline__ void init(const bf16_t* A_, const bf16_t* Bt_, int M_, int N_, int K_, int G_, int c_) { nM = M_ / BM; nN = N_ / BM; G = G_; c = c_; A = (const char*)A_; Bt = (const char*)Bt_; tstep = (size_t)BM * K_ * 2; }
    __device__ __forceinline__ bool next(int i, Unit& u) const { if (!tile_of(i, G, c, nM, nN, u.pm, u.pn)) return false; u.a = A + (size_t)u.pm * tstep; u.b = Bt + (size_t)u.pn * tstep; return true; }
    __device__ __forceinline__ int gather_tok(const Unit&, int) const { return 0; }
};
template <bool GATHER> struct MoeOrder {
    int nM, nN, G, c; const char* A; const char* Bt; size_t tstep, estride; const int* pexp; const int* perm;
    __device__ __forceinline__ void init(const bf16_t* A_, const bf16_t* Bt_, int nM_, int N_, int K_, int G_, int c_, const int* pexp_, const int* perm_) {
        nM = nM_; nN = N_ / BM; G = G_; c = c_; A = (const char*)A_; Bt = (const char*)Bt_; tstep = (size_t)BM * K_ * 2; estride = (size_t)N_ * K_ * 2; pexp = pexp_; perm = perm_; }
    __device__ __forceinline__ bool next(int i, Unit& u) const { if (!tile_of(i, G, c, nM, nN, u.pm, u.pn)) return false;
        const int e = __builtin_amdgcn_readfirstlane(pexp[u.pm]); u.a = GATHER ? A : A + (size_t)u.pm * tstep; u.b = Bt + (size_t)e * estride + (size_t)u.pn * tstep; return true; }
    __device__ __forceinline__ int gather_tok(const Unit& u, int r) const { return perm[u.pm * BM + r]; }
};

template <class Epi, class Sched, bool GATHER>
__device__ __forceinline__ void gemm_phase(LAS unsigned char* lds, const int K, const Sched& S, const Epi& E) {
    const int tid = threadIdx.x, wid = __builtin_amdgcn_readfirstlane(tid >> 6), lane = tid & 63, wr = wid >> 2, wc = wid & 3, fr = lane & 15, fq = lane >> 4;
    const int nt = K / BK;
    const size_t kstep = (size_t)(BK * 2);
    const size_t hstep = (size_t)HALF * K * 2;
    unsigned voffB[2]; int sR[2], sC[2];
#pragma unroll
    for (int i = 0; i < 2; ++i) { int R, C; stage_rc(tid * 16 + i * 8192, R, C); const int Rb = (R & ~31) + perm32(R & 31); sR[i] = R; sC[i] = C; voffB[i] = (unsigned)(Rb * K + C) * 2u; }
    const unsigned ldsw = (unsigned)wid * 1024u;
    const int aoff = lds_byte(wr * 64 + fr, fq * 8), boff = lds_byte(wc * 32 + fr, fq * 8);
#define PG8_SA(b, h) (((b) * 2 + (h)) * HTB)
#define PG8_SB(b, h) ((4 + (b) * 2 + (h)) * HTB)
#define PG8_STAGE_B(bufoff, gbase) do { _Pragma("unroll") for (int _i = 0; _i < 2; ++_i) \
        __builtin_amdgcn_global_load_lds((const unsigned*)((const char*)(gbase) + voffB[_i]), (LAS unsigned*)(lds + (bufoff) + ldsw + _i * 8192), 16, 0, 0); } while (0)
#define PG8_STAGE_A(bufoff, gbase, off, h) do { _Pragma("unroll") for (int _i = 0; _i < 2; ++_i) \
        __builtin_amdgcn_global_load_lds((const unsigned*)((const char*)(gbase) + (off)[h][_i]), (LAS unsigned*)(lds + (bufoff) + ldsw + _i * 8192), 16, 0, 0); } while (0)
#define PG8_LDA(dst, b, h) do { _Pragma("unroll") for (int m = 0; m < 4; ++m) _Pragma("unroll") for (int k = 0; k < 2; ++k) dst[m][k] = *(const LAS bf16x8*)(lds + PG8_SA(b, h) + aoff + m * 2048 + k * 1024); } while (0)
#define PG8_LDB(dst, b, h) do { _Pragma("unroll") for (int n = 0; n < 2; ++n) _Pragma("unroll") for (int k = 0; k < 2; ++k) dst[n][k] = *(const LAS bf16x8*)(lds + PG8_SB(b, h) + boff + n * 2048 + k * 1024); } while (0)
#define PG8_MMA(ai, bj, At, Bt) do { __builtin_amdgcn_s_setprio(1); _Pragma("unroll") for (int m = 0; m < 4; ++m) _Pragma("unroll") for (int n = 0; n < 2; ++n) _Pragma("unroll") for (int k = 0; k < 2; ++k) \
        acc[ai][bj][m][n] = __builtin_amdgcn_mfma_f32_16x16x32_bf16(Bt[n][k], At[m][k], acc[ai][bj][m][n], 0, 0, 0); __builtin_amdgcn_s_setprio(0); } while (0)
#define PG8_WAIT_V(n) asm volatile("s_waitcnt vmcnt(" #n ")" ::: "memory")
#define PG8_WAIT_L(n) asm volatile("s_waitcnt lgkmcnt(" #n ")" ::: "memory")
#define PG8_BAR __builtin_amdgcn_s_barrier()
#define PG8_SCHED __builtin_amdgcn_sched_barrier(0)
    Unit cur, nxt; int ui = 0;
    if (!S.next(0, cur)) return;
    unsigned coff[2][2], noff[2][2];
#pragma unroll
    for (int h = 0; h < 2; ++h)
#pragma unroll
        for (int i = 0; i < 2; ++i) {
            if constexpr (GATHER) coff[h][i] = (unsigned)(S.gather_tok(cur, h * HALF + sR[i]) * K + sC[i]) * 2u;
            else coff[h][i] = (unsigned)(h * (int)hstep) + (unsigned)(sR[i] * K + sC[i]) * 2u;
            noff[h][i] = coff[h][i];
        }
    f32x4 acc[2][2][4][2];
#pragma unroll
    for (int a = 0; a < 2; ++a)
#pragma unroll
        for (int b = 0; b < 2; ++b)
#pragma unroll
            for (int m = 0; m < 4; ++m)
#pragma unroll
                for (int n = 0; n < 2; ++n) acc[a][b][m][n] = (f32x4){0.f, 0.f, 0.f, 0.f};
    bf16x8 At[4][2], B0[2][2], B1[2][2];
    const char* cA = cur.a; const char* cB = cur.b;
    PG8_STAGE_B(PG8_SB(0, 0), cB); PG8_STAGE_B(PG8_SB(0, 1), cB + hstep); PG8_STAGE_A(PG8_SA(0, 0), cA, coff, 0); PG8_STAGE_A(PG8_SA(0, 1), cA, coff, 1);
    if (wr == 1) PG8_BAR;
    PG8_WAIT_V(2); PG8_BAR;
    PG8_STAGE_B(PG8_SB(1, 0), cB + kstep); PG8_STAGE_A(PG8_SA(1, 0), cA + kstep, coff, 0); PG8_STAGE_B(PG8_SB(1, 1), cB + hstep + kstep);
    PG8_WAIT_V(6); PG8_BAR;
    for (;;) {
        const bool has_next = S.next(ui + 1, nxt);
        const char* nA = has_next ? nxt.a : cA; const char* nB = has_next ? nxt.b : cB;
        if constexpr (GATHER) {
            if (has_next) {
#pragma unroll
                for (int h = 0; h < 2; ++h)
#pragma unroll
                    for (int i = 0; i < 2; ++i) noff[h][i] = (unsigned)(S.gather_tok(nxt, h * HALF + sR[i]) * K + sC[i]) * 2u;
            }
        }
        for (int t = 0; t < nt; t += 2) {
            const bool last = (t == nt - 2);
            const char* a1 = cA + (size_t)(t + 1) * kstep;
            const char* a2 = last ? nA : cA + (size_t)(t + 2) * kstep; const char* b2 = last ? nB : cB + (size_t)(t + 2) * kstep;
            const char* a3 = a2 + kstep; const char* b3 = b2 + kstep;
            unsigned o2[2][2];
#pragma unroll
            for (int h = 0; h < 2; ++h)
#pragma unroll
                for (int i = 0; i < 2; ++i) o2[h][i] = GATHER ? (last ? noff[h][i] : coff[h][i]) : coff[h][i];
            PG8_LDB(B0, 0, 0); PG8_LDB(B1, 0, 1); PG8_SCHED; PG8_LDA(At, 0, 0); PG8_STAGE_A(PG8_SA(1, 1), a1, coff, 1);
            PG8_WAIT_V(8); PG8_WAIT_L(0); PG8_BAR; PG8_MMA(0, 0, At, B0); PG8_MMA(0, 1, At, B1); PG8_BAR; PG8_SCHED;
            PG8_LDA(At, 0, 1); PG8_STAGE_B(PG8_SB(0, 0), b2); PG8_STAGE_B(PG8_SB(0, 1), b2 + hstep); PG8_STAGE_A(PG8_SA(0, 0), a2, o2, 0);
            PG8_WAIT_V(8); PG8_WAIT_L(0); PG8_BAR; PG8_MMA(1, 0, At, B0); PG8_MMA(1, 1, At, B1); PG8_BAR; PG8_SCHED;
            PG8_LDB(B0, 1, 0); PG8_LDB(B1, 1, 1); PG8_SCHED; PG8_LDA(At, 1, 0); PG8_STAGE_A(PG8_SA(0, 1), a2, o2, 1);
            PG8_WAIT_V(8); PG8_WAIT_L(0); PG8_BAR; PG8_MMA(0, 0, At, B0); PG8_MMA(0, 1, At, B1); PG8_BAR; PG8_SCHED;
            PG8_LDA(At, 1, 1); PG8_STAGE_B(PG8_SB(1, 0), b3); PG8_STAGE_B(PG8_SB(1, 1), b3 + hstep); PG8_STAGE_A(PG8_SA(1, 0), a3, o2, 0);
            PG8_WAIT_V(8); PG8_WAIT_L(0); PG8_BAR; PG8_MMA(1, 0, At, B0); PG8_MMA(1, 1, At, B1); PG8_BAR; PG8_SCHED;
        }
        if (wr == 0) PG8_BAR;
        E(acc, cur, wr, wc, fr, fq);
        if (!has_next) break;
#pragma unroll
        for (int a = 0; a < 2; ++a)
#pragma unroll
            for (int b = 0; b < 2; ++b)
#pragma unroll
                for (int m = 0; m < 4; ++m)
#pragma unroll
                    for (int n = 0; n < 2; ++n) acc[a][b][m][n] = (f32x4){0.f, 0.f, 0.f, 0.f};
        cur = nxt; cA = nA; cB = nB; ++ui;
#pragma unroll
        for (int h = 0; h < 2; ++h)
#pragma unroll
            for (int i = 0; i < 2; ++i) coff[h][i] = noff[h][i];
        if (wr == 1) PG8_BAR;
    }
    PG8_WAIT_V(0);
    PG8_BAR;
#undef PG8_SA
#undef PG8_SB
#undef PG8_STAGE_A
#undef PG8_STAGE_B
#undef PG8_LDA
#undef PG8_LDB
#undef PG8_MMA
#undef PG8_WAIT_V
#undef PG8_WAIT_L
#undef PG8_BAR
#undef PG8_SCHED
}

typedef f32x4 AccT[2][2][4][2];
#define EPI_ROWS_BEGIN const int row0 = u.pm * BM + wr * 64 + fr; const int colw = wc * 32 + 8 * fq; \
    _Pragma("unroll") for (int ai = 0; ai < 2; ++ai) _Pragma("unroll") for (int m = 0; m < 4; ++m) { const int r = row0 + ai * HALF + m * 16;
#define EPI_ROWS_END }

struct EpiInAB {
    bf16_t* Z; const float* rstd;
    __device__ __forceinline__ void operator()(const AccT& acc, const Unit& u, int wr, int wc, int fr, int fq) const {
        const bool act = u.pn < 4;
        EPI_ROWS_BEGIN
            const float rs = rstd[r]; bf16_t* rowp = Z + (size_t)r * AB_IN + u.pn * BM + colw;
#pragma unroll
            for (int bj = 0; bj < 2; ++bj) { float v[8];
#pragma unroll
                for (int j = 0; j < 4; ++j) { v[j] = acc[ai][bj][m][0][j] * rs; v[4 + j] = acc[ai][bj][m][1][j] * rs; }
                if (act) {
#pragma unroll
                    for (int j = 0; j < 8; ++j) v[j] = fgelu_tanh(v[j]); }
                *(u32x4*)(rowp + bj * HALF) = pack8(v); }
        EPI_ROWS_END
    }
};
struct EpiPlain {
    bf16_t* O; int ldc;
    __device__ __forceinline__ void operator()(const AccT& acc, const Unit& u, int wr, int wc, int fr, int fq) const {
        EPI_ROWS_BEGIN
            bf16_t* rowp = O + (size_t)r * ldc + u.pn * BM + colw;
#pragma unroll
            for (int bj = 0; bj < 2; ++bj) { float v[8];
#pragma unroll
                for (int j = 0; j < 4; ++j) { v[j] = acc[ai][bj][m][0][j]; v[4 + j] = acc[ai][bj][m][1][j]; }
                *(u32x4*)(rowp + bj * HALF) = pack8(v); }
        EPI_ROWS_END
    }
};
template <bool MOE> struct EpiSwiGLU {
    bf16_t* H; int ldh; const float* rstd; const int* perm;
    __device__ __forceinline__ void operator()(const AccT& acc, const Unit& u, int wr, int wc, int fr, int fq) const {
        EPI_ROWS_BEGIN
            const int tok = MOE ? perm[r] : r; const float rs = rstd[tok];
            float v[8];
#pragma unroll
            for (int n = 0; n < 2; ++n)
#pragma unroll
                for (int j = 0; j < 4; ++j) { const float g = acc[ai][0][m][n][j] * rs, up = acc[ai][1][m][n][j] * rs; v[4 * n + j] = fsilu(g) * up; }
            *(u32x4*)(H + (size_t)r * ldh + u.pn * HALF + colw) = pack8(v);
        EPI_ROWS_END
    }
};
struct EpiInC {
    bf16_t* QFIG; const float* ssp; const float* lb;
    __device__ __forceinline__ void operator()(const AccT& acc, const Unit& u, int wr, int wc, int fr, int fq) const {
        const int type = u.pn >> 2; const int colt = (u.pn & 3) * BM + wc * 32 + 8 * fq;
        bf16_t* base = QFIG + (size_t)type * M * CW;
        EPI_ROWS_BEGIN
            const f32x4* sp = (const f32x4*)(ssp + (size_t)r * 16); const f32x4 s0 = sp[0], s1 = sp[1], s2 = sp[2], s3 = sp[3];
            const float ss = ((s0[0] + s0[1]) + (s0[2] + s0[3])) + ((s1[0] + s1[1]) + (s1[2] + s1[3])) + ((s2[0] + s2[1]) + (s2[2] + s2[3])) + ((s3[0] + s3[1]) + (s3[2] + s3[3]));
            const float rs = __builtin_amdgcn_rsqf(ss * (1.0f / D) + EPS);
#pragma unroll
            for (int bj = 0; bj < 2; ++bj) { float v[8];
#pragma unroll
                for (int j = 0; j < 4; ++j) { v[j] = acc[ai][bj][m][0][j] * rs; v[4 + j] = acc[ai][bj][m][1][j] * rs; }
                if (type == 0 || type == 3) {
#pragma unroll
                    for (int j = 0; j < 8; ++j) v[j] = fsilu(v[j]);
                } else if (type == 1) {
                    const f32x4 l0 = *(const f32x4*)(lb + colt + bj * HALF), l1 = *(const f32x4*)(lb + colt + bj * HALF + 4);
#pragma unroll
                    for (int j = 0; j < 8; ++j) { const float l = j < 4 ? l0[j] : l1[j - 4]; v[j] = __builtin_amdgcn_logf(l + (1.0f - l) * fsigmoid(v[j])); }
                }
                *(u32x4*)(base + (size_t)r * CW + colt + bj * HALF) = pack8(v); }
        EPI_ROWS_END
    }
};
template <bool FINAL> struct EpiPleGate {
    const bf16_t* X; const bf16_t* PP; bf16_t* XO; float* ssp; float* OUT;
    __device__ __forceinline__ void operator()(const AccT& acc, const Unit& u, int wr, int wc, int fr, int fq) const {
        EPI_ROWS_BEGIN
            const size_t off = (size_t)r * D + u.pn * BM + colw; float ssq = 0.f;
#pragma unroll
            for (int bj = 0; bj < 2; ++bj) { float x[8], p[8];
                unpack8(*(const u32x4*)(X + off + bj * HALF), x); unpack8(*(const u32x4*)(PP + off + bj * HALF), p);
#pragma unroll
                for (int j = 0; j < 8; ++j) { const float a = j < 4 ? acc[ai][bj][m][0][j] : acc[ai][bj][m][1][j - 4]; x[j] = x[j] + fsigmoid(a) * p[j]; ssq += x[j] * x[j]; }
                if (FINAL) { *(f32x4*)(OUT + off + bj * HALF) = (f32x4){x[0], x[1], x[2], x[3]}; *(f32x4*)(OUT + off + bj * HALF + 4) = (f32x4){x[4], x[5], x[6], x[7]}; }
                else *(u32x4*)(XO + off + bj * HALF) = pack8(x); }
            if (!FINAL) { ssq += __shfl_xor(ssq, 16); ssq += __shfl_xor(ssq, 32); if (fq == 0) ssp[(size_t)r * 16 + u.pn * 4 + wc] = ssq; }
        EPI_ROWS_END
    }
};
struct EpiMoeDown {
    const int* rowinfo; bf16_t* slots;
    __device__ __forceinline__ void operator()(const AccT& acc, const Unit& u, int wr, int wc, int fr, int fq) const {
        EPI_ROWS_BEGIN
            const int info = rowinfo[2 * r]; const float w = __int_as_float(rowinfo[2 * r + 1]);
            if (info >= 0) { bf16_t* rowp = slots + (size_t)(info & 1) * M * D + (size_t)(info >> 1) * D + u.pn * BM + colw;
#pragma unroll
                for (int bj = 0; bj < 2; ++bj) { float v[8];
#pragma unroll
                    for (int j = 0; j < 4; ++j) { v[j] = acc[ai][bj][m][0][j] * w; v[4 + j] = acc[ai][bj][m][1][j] * w; }
                    *(u32x4*)(rowp + bj * HALF) = pack8(v); } }
        EPI_ROWS_END
    }
};
}

constexpr size_t MiB = 1u << 20;
constexpr size_t WS_CTL = 0, CTL_ZERO_BYTES = 1 * MiB;
constexpr size_t WS_SMALL = 1 * MiB;
constexpr size_t SM_RSTD0 = WS_SMALL, SM_RSTD1 = SM_RSTD0 + 128 * 1024, SM_RSTD4 = SM_RSTD1 + 128 * 1024;
constexpr size_t SM_LB = SM_RSTD4 + 128 * 1024;
constexpr size_t SM_ROUTE = SM_LB + 4096;
constexpr size_t SM_CNT = SM_ROUTE + 512 * 1024;
constexpr size_t SM_META = SM_CNT + 32 * 1024;
constexpr size_t SM_PERM = SM_META + 4096;
constexpr size_t SM_RINFO = SM_PERM + 512 * 1024;
constexpr size_t SM_SSP = SM_RINFO + 1024 * 1024;
static_assert(SM_SSP + 2 * MiB <= 9 * MiB, "small arrays");
constexpr size_t WS_W = 9 * MiB;
constexpr size_t W_INAB = WS_W, W_OUTAB = W_INAB + 5 * MiB, W_GU0 = W_OUTAB + 2 * MiB, W_DN0 = W_GU0 + 11 * MiB, W_INC = W_DN0 + 5 * MiB + 512 * 1024,
                 W_OUTC = W_INC + 8 * MiB, W_EGU = W_OUTC + 2 * MiB, W_EDN = W_EGU + 112 * MiB, W_PPROJ = W_EDN + 56 * MiB, W_PGATE = W_PPROJ + 1 * MiB, W_END = W_PGATE + 4 * MiB;
constexpr size_t WS_PB = W_END;
constexpr size_t WS_XA = WS_PB + 32 * MiB, WS_XB = WS_XA + 64 * MiB;
constexpr size_t WS_R = WS_XB + 64 * MiB;
constexpr size_t R_BYTES = (size_t)MAXP * 256 * EFF * 2;
constexpr size_t WS_END = WS_R + R_BYTES;
constexpr size_t R_Z = 0, R_Y = 160 * MiB, R_MIX = 224 * MiB, R_PP = 288 * MiB, R_HF = 0;
constexpr size_t R_QFIG = 0, R_O = 256 * MiB, R_OG = 384 * MiB, R_MIX1 = 0, R_H = 0, R_PP1 = 0;

constexpr int CW_BAR = 4096;

constexpr int RING_BYTES = 131072;
constexpr int LDSCTL_OFF = RING_BYTES, MISC_OFF = LDSCTL_OFF + 320;
constexpr int LDS_BYTES = 147456;

#define XB_TMO      128
#define XB_XCNT(j)  (256  + 64 * (j))
#define XB_XSUB(j)  (1280 + 64 * (j))
#define XB_XGEN(j)  (2304 + 64 * (j))
#define XB_TOP      3328
#define XB_TOPGEN   3392
#define XCD_BAR_WORDS 3456
#define XB_SPIN_CAP (1u << 18)
__device__ __forceinline__ unsigned xb_ld(unsigned* p)              { return __hip_atomic_load(p, __ATOMIC_RELAXED, __HIP_MEMORY_SCOPE_AGENT); }
__device__ __forceinline__ unsigned xb_add(unsigned* p, unsigned v) { return __hip_atomic_fetch_add(p, v, __ATOMIC_RELAXED, __HIP_MEMORY_SCOPE_AGENT); }
__device__ __forceinline__ unsigned xb_xcc_id() { return (unsigned)__builtin_amdgcn_s_getreg((3 << 11) | 20) & 0xFu; }
#define XB_SPIN(cond, bar) do { unsigned _sp = 0; while (cond) { __builtin_amdgcn_s_sleep(1); \
    if ((++_sp & 255u) == 0u) { if (xb_ld(&(bar)[XB_TMO])) break; if (_sp > XB_SPIN_CAP) { atomicAdd(&(bar)[XB_TMO], 1u); break; } } } } while (0)
struct XcdBarrier { unsigned* bar; unsigned x; volatile LAS unsigned* st; };
__device__ __forceinline__ XcdBarrier xcd_barrier_post(unsigned* bar, volatile LAS unsigned* st) {
    XcdBarrier b; b.bar = bar; b.x = xb_xcc_id(); b.st = st;
    if (threadIdx.x == 0) (void)xb_add(&bar[XB_XCNT(b.x)], 1u);
    return b;
}
__device__ __forceinline__ void xcd_barrier_complete(unsigned* bar, unsigned x, unsigned& nloc, unsigned& nx) {
    const unsigned G = gridDim.x * gridDim.y * gridDim.z;
    unsigned sum, cnt, mine, sp = 0u;
    for (;;) {
        sum = 0u; cnt = 0u; mine = 0u;
#pragma unroll
        for (unsigned j = 0; j < 16; ++j) { const unsigned c = xb_ld(&bar[XB_XCNT(j)]); sum += c; cnt += (c > 0u) ? 1u : 0u; mine = (j == x) ? c : mine; }
        if (sum == G) break;
        __builtin_amdgcn_s_sleep(1);
        if ((++sp & 255u) == 0u) { if (xb_ld(&bar[XB_TMO])) break; if (sp > XB_SPIN_CAP) { atomicAdd(&bar[XB_TMO], 1u); break; } }
    }
    nloc = mine > 0u ? mine : 1u; nx = cnt > 0u ? cnt : 1u;
}
__device__ __forceinline__ void xcd_barrier(const XcdBarrier& b) {
    asm volatile("s_waitcnt vmcnt(0)" ::: "memory");
    __syncthreads();
    if (threadIdx.x == 0) {
        unsigned* bar = b.bar;
        __builtin_amdgcn_s_waitcnt(0);
        unsigned nloc = b.st[0], nx = b.st[1];
        if (nloc == 0u) { xcd_barrier_complete(bar, b.x, nloc, nx); b.st[0] = nloc; b.st[1] = nx; }
        const unsigned old = xb_add(&bar[XB_XSUB(b.x)], 1u);
        const unsigned gen = old / nloc;
        if (old + 1u == (gen + 1u) * nloc) {
            __builtin_amdgcn_fence(__ATOMIC_RELEASE, "agent");
            asm volatile("s_waitcnt vmcnt(0)" ::: "memory");
            const unsigned og = xb_add(&bar[XB_TOP], 1u);
            const unsigned tg = og / nx;
            if (og + 1u == (tg + 1u) * nx) xb_add(&bar[XB_TOPGEN], 1u);
            else XB_SPIN(xb_ld(&bar[XB_TOPGEN]) == tg, bar);
            __builtin_amdgcn_fence(__ATOMIC_ACQUIRE, "agent");
            xb_add(&bar[XB_XGEN(b.x)], 1u);
            asm volatile("s_waitcnt vmcnt(0)" ::: "memory");
        } else {
            XB_SPIN(xb_ld(&bar[XB_XGEN(b.x)]) == gen, bar);
            __builtin_amdgcn_fence(__ATOMIC_ACQUIRE, "agent");
            asm volatile("s_waitcnt vmcnt(0)" ::: "memory");
        }
    }
    __syncthreads();
}

struct Args { const float* in[22]; float* out; unsigned char* ws; int ph_lo, ph_hi, li, pad; };
enum { I_X = 0, I_P, I_NORMG, I_WINAB, I_ALNG, I_ALNB, I_AWS, I_ABS, I_BCONV, I_WOUTAB, I_FFNGU, I_FFNDN, I_WINC, I_LBP, I_ONORMG, I_WOUTC, I_WROUTER, I_BROUTER, I_EGU, I_EDN, I_PPROJ, I_PGATE };

__device__ __forceinline__ void transpose_item(const float* W, int K, int N, bf16_t* WT, const float* gain, int gu_ff, LAS float* scr, int item, int lane) {
    const int nblk = N / 32, kb = item / nblk, nb = item % nblk, k0 = 64 * kb, n0 = 32 * nb;
#pragma unroll 8
    for (int i = 0; i < 32; ++i) { const int kk = 2 * i + (lane >> 5); float w = W[(size_t)(k0 + kk) * N + n0 + (lane & 31)]; if (gain) w *= gain[k0 + kk]; scr[kk * 33 + (lane & 31)] = w; }
    asm volatile("s_waitcnt lgkmcnt(0)" ::: "memory");
    int d0 = n0; if (gu_ff) { const int half = n0 >= gu_ff ? 1 : 0, j = n0 - half * gu_ff; d0 = (j / 128) * 256 + half * 128 + (j % 128); }
    const int c = lane & 7;
#pragma unroll
    for (int j = 0; j < 4; ++j) { const int n = (lane >> 3) + 8 * j; const LAS float* s = scr + (8 * c) * 33 + n;
        u32x4 o; o.x = cvt_pk_bf16(s[0 * 33], s[1 * 33]); o.y = cvt_pk_bf16(s[2 * 33], s[3 * 33]); o.z = cvt_pk_bf16(s[4 * 33], s[5 * 33]); o.w = cvt_pk_bf16(s[6 * 33], s[7 * 33]);
        *(u32x4*)(WT + (size_t)(d0 + n) * K + k0 + 8 * c) = o; }
    asm volatile("s_waitcnt lgkmcnt(0)" ::: "memory");
}

__device__ __forceinline__ void ld_row_bf16(const bf16_t* row, int lane, float (&v)[16]) { unpack8(*(const u32x4*)(row + lane * 8), v); unpack8(*(const u32x4*)(row + 512 + lane * 8), v + 8); }
__device__ __forceinline__ void st_row_bf16(bf16_t* row, int lane, const float (&v)[16]) { *(u32x4*)(row + lane * 8) = pack8(v); *(u32x4*)(row + 512 + lane * 8) = pack8(v + 8); }
__device__ __forceinline__ void ld_row_f32(const float* row, int lane, float (&v)[16]) {
    const f32x4 a = *(const f32x4*)(row + lane * 8), b = *(const f32x4*)(row + lane * 8 + 4), c = *(const f32x4*)(row + 512 + lane * 8), d = *(const f32x4*)(row + 512 + lane * 8 + 4);
#pragma unroll
    for (int j = 0; j < 4; ++j) { v[j] = a[j]; v[4 + j] = b[j]; v[8 + j] = c[j]; v[12 + j] = d[j]; }
}
__device__ __forceinline__ float sumsq16(const float (&v)[16]) { float s = 0.f;
#pragma unroll
    for (int j = 0; j < 16; ++j) s += v[j] * v[j];
    return s; }

__global__ void __launch_bounds__(NTHR, 2) trunk_fwd(Args args) {
    extern __shared__ __attribute__((aligned(16))) unsigned char lds_raw[];
    LAS unsigned char* lds = (LAS unsigned char*)lds_raw;
    volatile LAS unsigned* MISC = (volatile LAS unsigned*)(lds + MISC_OFF);
    const int tid = threadIdx.x, lane = tid & 63, wave = __builtin_amdgcn_readfirstlane(tid >> 6);
    const int G = gridDim.x, bx = blockIdx.x;
    unsigned char* ws = args.ws;
    for (int u = tid; u < (LDS_BYTES - LDSCTL_OFF) / 4; u += NTHR) ((LAS unsigned*)(lds + LDSCTL_OFF))[u] = 0u;
    __syncthreads();
    XcdBarrier bar; bar.bar = (unsigned*)(ws + WS_CTL) + CW_BAR; bar.x = 0; bar.st = nullptr;
    if (MK_N_LAUNCHES == 1) bar = xcd_barrier_post((unsigned*)(ws + WS_CTL) + CW_BAR, MISC + 8);
    const int lo = args.ph_lo, hi = args.ph_hi;
#define IN(k) (lo <= (k) && (k) < hi)
#define SEAM(k) do { if (IN(k) && IN((k) + 1)) xcd_barrier(bar); } while (0)

    const float* normg = args.in[I_NORMG];
    float* rstd0 = (float*)(ws + SM_RSTD0); float* rstd1 = (float*)(ws + SM_RSTD1); float* rstd4 = (float*)(ws + SM_RSTD4);
    float* LB = (float*)(ws + SM_LB); int* route = (int*)(ws + SM_ROUTE); int* cntg = (int*)(ws + SM_CNT); int* meta = (int*)(ws + SM_META);
    int* perm = (int*)(ws + SM_PERM); int* rinfo = (int*)(ws + SM_RINFO); float* ssp = (float*)(ws + SM_SSP);
    bf16_t* XA = (bf16_t*)(ws + WS_XA); bf16_t* XB = (bf16_t*)(ws + WS_XB); bf16_t* PB = (bf16_t*)(ws + WS_PB);
    unsigned char* R = ws + WS_R;
    const int gw = bx * NWAVES + wave, NGW = G * NWAVES;
    const int RPW = M / G;

    if (IN(0)) {
        LAS float* scr = (LAS float*)(lds + wave * 16384);
        constexpr int I1 = 16 * 80, I2 = 16 * 32, I3 = 16 * 176, I4 = 44 * 32, I5 = 16 * 128, I6 = 16 * 32, I7E = 16 * 224, I8E = 56 * 32, I9L = 4 * 32, I10L = 16 * 32;
        constexpr int NITEMS = I1 + I2 + I3 + I4 + I5 + I6 + 8 * I7E + 8 * I8E + 2 * I9L + 2 * I10L;
        for (int it = gw; it < NITEMS; it += NGW) {
            int r = it;
            if (r < I1) { transpose_item(args.in[I_WINAB], D, AB_IN, (bf16_t*)(ws + W_INAB), normg + 0 * D, 0, scr, r, lane); continue; } r -= I1;
            if (r < I2) { transpose_item(args.in[I_WOUTAB], D, D, (bf16_t*)(ws + W_OUTAB), nullptr, 0, scr, r, lane); continue; } r -= I2;
            if (r < I3) { transpose_item(args.in[I_FFNGU], D, 2 * FF, (bf16_t*)(ws + W_GU0), normg + 2 * D, FF, scr, r, lane); continue; } r -= I3;
            if (r < I4) { transpose_item(args.in[I_FFNDN], FF, D, (bf16_t*)(ws + W_DN0), nullptr, 0, scr, r, lane); continue; } r -= I4;
            if (r < I5) { transpose_item(args.in[I_WINC], D, 4 * CW, (bf16_t*)(ws + W_INC), normg + 4 * D, 0, scr, r, lane); continue; } r -= I5;
            if (r < I6) { transpose_item(args.in[I_WOUTC], CW, D, (bf16_t*)(ws + W_OUTC), nullptr, 0, scr, r, lane); continue; } r -= I6;
            if (r < 8 * I7E) { const int e = r / I7E; transpose_item(args.in[I_EGU] + (size_t)e * D * 2 * EFF, D, 2 * EFF, (bf16_t*)(ws + W_EGU) + (size_t)e * 2 * EFF * D, normg + 6 * D, EFF, scr, r % I7E, lane); continue; } r -= 8 * I7E;
            if (r < 8 * I8E) { const int e = r / I8E; transpose_item(args.in[I_EDN] + (size_t)e * EFF * D, EFF, D, (bf16_t*)(ws + W_EDN) + (size_t)e * D * EFF, nullptr, 0, scr, r % I8E, lane); continue; } r -= 8 * I8E;
            if (r < 2 * I9L) { const int l = r / I9L; transpose_item(args.in[I_PPROJ] + (size_t)l * PLE * D, PLE, D, (bf16_t*)(ws + W_PPROJ) + (size_t)l * D * PLE, nullptr, 0, scr, r % I9L, lane); continue; } r -= 2 * I9L;
            { const int l = r / I10L; transpose_item(args.in[I_PGATE] + (size_t)l * D * D, D, D, (bf16_t*)(ws + W_PGATE) + (size_t)l * D * D, nullptr, 0, scr, r % I10L, lane); }
        }
        for (int m = gw; m < M; m += NGW) { float v[16]; ld_row_f32(args.in[I_X] + (size_t)m * D, lane, v);
            const float ss = wave_sum(sumsq16(v)); st_row_bf16(XA + (size_t)m * D, lane, v); if (lane == 0) rstd0[m] = __builtin_amdgcn_rsqf(ss * (1.0f / D) + EPS); }
        { const float* p = args.in[I_P]; const size_t n8 = (size_t)2 * M * PLE / 8;
          for (size_t i = (size_t)bx * NTHR + tid; i < n8; i += (size_t)G * NTHR) { const f32x4 a = *(const f32x4*)(p + i * 8), b = *(const f32x4*)(p + i * 8 + 4);
              float v[8] = {a[0], a[1], a[2], a[3], b[0], b[1], b[2], b[3]}; *(u32x4*)(PB + i * 8) = pack8(v); } }
        if (bx == 0) for (int c = tid; c < CW; c += NTHR) { const float d = args.in[I_LBP][CW + c] - args.in[I_LBP][c]; LB[c] = 1.0f / (1.0f + expf(-d)); }
    }
    SEAM(0);

    if (IN(1)) { pg8::StaticOrder S; S.init(XA, (const bf16_t*)(ws + W_INAB), M, AB_IN, D, G, bx); pg8::EpiInAB E{(bf16_t*)(R + R_Z), rstd0};
        pg8::gemm_phase<pg8::EpiInAB, pg8::StaticOrder, false>(lds, D, S, E); }
    SEAM(1);

    if (IN(2)) {
        const bf16_t* Z = (const bf16_t*)(R + R_Z); bf16_t* Y = (bf16_t*)(R + R_Y);
        LAS float* vln = (LAS float*)lds;
        LAS float* wt = (LAS float*)(lds + 32768);
        for (int blk = bx; blk < M / 128; blk += G) {
            const int t0 = blk * 128;
            for (int h = 0; h < 8; ++h) {
                { const float* Wh = args.in[I_AWS] + (size_t)h * 128 * 128;
                  for (int e = tid; e < 128 * 128; e += NTHR) { const int i = e >> 7, j = e & 127; float w = Wh[e]; if ((j >> 6) > (i >> 6)) w = 0.f; wt[j * 128 + i] = w; } }
                { const int row = tid >> 2, dq = tid & 3; const bf16_t* vp = Z + (size_t)(t0 + row) * AB_IN + 512 + h * 64 + dq * 16; float v[16];
                  unpack8(*(const u32x4*)vp, v); unpack8(*(const u32x4*)(vp + 8), v + 8);
                  float s = 0.f;
#pragma unroll
                  for (int j = 0; j < 16; ++j) s += v[j];
                  s += __shfl_xor(s, 1); s += __shfl_xor(s, 2); const float mu = s * (1.0f / 64.0f); float q = 0.f;
#pragma unroll
                  for (int j = 0; j < 16; ++j) { v[j] -= mu; q += v[j] * v[j]; }
                  q += __shfl_xor(q, 1); q += __shfl_xor(q, 2); const float rs = __builtin_amdgcn_rsqf(q * (1.0f / 64.0f) + EPS);
#pragma unroll
                  for (int j = 0; j < 16; ++j) { const int c = h * 64 + dq * 16 + j; vln[row * 64 + dq * 16 + j] = v[j] * rs * args.in[I_ALNG][c] + args.in[I_ALNB][c]; } }
                __syncthreads();
                { const int d = tid & 63, ig = wave; const int jmax = ig < 4 ? 64 : 128; float a[16];
#pragma unroll
                  for (int ii = 0; ii < 16; ++ii) a[ii] = 0.f;
                  for (int j = 0; j < jmax; ++j) { const float vj = vln[j * 64 + d]; const LAS f32x4* wp = (const LAS f32x4*)(wt + j * 128 + ig * 16);
                      const f32x4 w0 = wp[0], w1 = wp[1], w2 = wp[2], w3 = wp[3];
#pragma unroll
                      for (int ii = 0; ii < 4; ++ii) { a[ii] += w0[ii] * vj; a[4 + ii] += w1[ii] * vj; a[8 + ii] += w2[ii] * vj; a[12 + ii] += w3[ii] * vj; } }
#pragma unroll
                  for (int ii = 0; ii < 16; ++ii) { const int i = ig * 16 + ii; const float f = a[ii] + args.in[I_ABS][h * 128 + i];
                      const float uu = bf2f(Z[(size_t)(t0 + i) * AB_IN + h * 64 + d]); Y[(size_t)(t0 + i) * D + h * 64 + d] = f2bf(uu * f); } }
                __syncthreads();
            }
            { const int c = tid; const float w0 = args.in[I_BCONV][c], w1 = args.in[I_BCONV][512 + c], w2 = args.in[I_BCONV][1024 + c];
              float p2 = 0.f, p1 = 0.f;
              if ((t0 % SEQ) != 0) { const bf16_t* z2 = Z + (size_t)(t0 - 2) * AB_IN; const bf16_t* z1 = Z + (size_t)(t0 - 1) * AB_IN;
                  p2 = bf2f(z2[1536 + c]) * bf2f(z2[1024 + c]); p1 = bf2f(z1[1536 + c]) * bf2f(z1[1024 + c]); }
              for (int t = 0; t < 128; ++t) { const bf16_t* z = Z + (size_t)(t0 + t) * AB_IN; const float p0 = bf2f(z[1536 + c]) * bf2f(z[1024 + c]);
                  Y[(size_t)(t0 + t) * D + 512 + c] = f2bf(bf2f(z[2048 + c]) * (w0 * p2 + w1 * p1 + w2 * p0)); p2 = p1; p1 = p0; } }
        }
    }
    SEAM(2);

    if (IN(3)) { pg8::StaticOrder S; S.init((const bf16_t*)(R + R_Y), (const bf16_t*)(ws + W_OUTAB), M, D, D, G, bx); pg8::EpiPlain E{(bf16_t*)(R + R_MIX), D};
        pg8::gemm_phase<pg8::EpiPlain, pg8::StaticOrder, false>(lds, D, S, E); }
    SEAM(3);

    if (IN(4)) { const bf16_t* MIX = (const bf16_t*)(R + R_MIX); float g[16]; ld_row_f32(normg + 1 * D, lane, g);
        for (int i = 0; i < RPW / NWAVES; ++i) { const int m = bx * RPW + wave * (RPW / NWAVES) + i; float mx[16], x[16]; ld_row_bf16(MIX + (size_t)m * D, lane, mx); ld_row_bf16(XA + (size_t)m * D, lane, x);
            const float rm = __builtin_amdgcn_rsqf(wave_sum(sumsq16(mx)) * (1.0f / D) + EPS);
#pragma unroll
            for (int j = 0; j < 16; ++j) x[j] += g[j] * mx[j] * rm;
            const float ss = wave_sum(sumsq16(x)); st_row_bf16(XB + (size_t)m * D, lane, x); if (lane == 0) rstd1[m] = __builtin_amdgcn_rsqf(ss * (1.0f / D) + EPS); } }
    SEAM(4);

    if (IN(5)) { pg8::StaticOrder S; S.init(XB, (const bf16_t*)(ws + W_GU0), M, 2 * FF, D, G, bx); pg8::EpiSwiGLU<false> E{(bf16_t*)(R + R_HF), FF, rstd1, nullptr};
        pg8::gemm_phase<pg8::EpiSwiGLU<false>, pg8::StaticOrder, false>(lds, D, S, E); }
    SEAM(5);

    if (IN(6)) { pg8::StaticOrder S; S.init((const bf16_t*)(R + R_HF), (const bf16_t*)(ws + W_DN0), M, D, FF, G, bx); pg8::EpiPlain E{(bf16_t*)(R + R_MIX), D};
        pg8::gemm_phase<pg8::EpiPlain, pg8::StaticOrder, false>(lds, FF, S, E); }
    SEAM(6);

    if (IN(7)) { const bf16_t* MIX = (const bf16_t*)(R + R_MIX); float g[16]; ld_row_f32(normg + 3 * D, lane, g);
        for (int i = 0; i < RPW / NWAVES; ++i) { const int m = bx * RPW + wave * (RPW / NWAVES) + i; float mx[16], x[16]; ld_row_bf16(MIX + (size_t)m * D, lane, mx); ld_row_bf16(XB + (size_t)m * D, lane, x);
            const float rm = __builtin_amdgcn_rsqf(wave_sum(sumsq16(mx)) * (1.0f / D) + EPS);
#pragma unroll
            for (int j = 0; j < 16; ++j) x[j] += g[j] * mx[j] * rm;
            st_row_bf16(XA + (size_t)m * D, lane, x); } }
    SEAM(7);

    if (IN(8)) { pg8::StaticOrder S; S.init(PB, (const bf16_t*)(ws + W_PPROJ), M, D, PLE, G, bx); pg8::EpiPlain E{(bf16_t*)(R + R_PP), D};
        pg8::gemm_phase<pg8::EpiPlain, pg8::StaticOrder, false>(lds, PLE, S, E); }
    SEAM(8);

    if (IN(9)) { pg8::StaticOrder S; S.init(XA, (const bf16_t*)(ws + W_PGATE), M, D, D, G, bx); pg8::EpiPleGate<false> E{XA, (const bf16_t*)(R + R_PP), XB, ssp, nullptr};
        pg8::gemm_phase<pg8::EpiPleGate<false>, pg8::StaticOrder, false>(lds, D, S, E); }
    SEAM(9);

    if (IN(10)) { pg8::StaticOrder S; S.init(XB, (const bf16_t*)(ws + W_INC), M, 4 * CW, D, G, bx); pg8::EpiInC E{(bf16_t*)(R + R_QFIG), ssp, LB};
        pg8::gemm_phase<pg8::EpiInC, pg8::StaticOrder, false>(lds, D, S, E); }
    SEAM(10);

    if (IN(11)) {
        const bf16_t* Qb = (const bf16_t*)(R + R_QFIG); const bf16_t* Fb = Qb + (size_t)M * CW; const bf16_t* Ib = Fb + (size_t)M * CW; float* O = (float*)(R + R_O);
        LAS float* red = (LAS float*)lds;
        constexpr int TB = 16;
        for (int item = bx; item < BATCH * 8 * 8; item += G) {
            const int b = item >> 6, h = (item >> 3) & 7, vq = item & 7; const int v = tid & 15, kg = tid >> 4;
            const size_t rowb = (size_t)b * SEQ; const int colk = h * 128 + kg * 4, colv = h * 128 + vq * 16 + v;
            float s[4] = {0.f, 0.f, 0.f, 0.f};
            u32x2 cf[TB], cq[TB]; bf16_t ci[TB];
#pragma unroll
            for (int t = 0; t < TB; ++t) { const size_t r = rowb + t; cf[t] = *(const u32x2*)(Fb + r * CW + colk); cq[t] = *(const u32x2*)(Qb + r * CW + colk); ci[t] = Ib[r * CW + colv]; }
            for (int tb = 0; tb < SEQ / TB; ++tb) {
                u32x2 nf[TB], nq[TB]; bf16_t ni[TB];
                const int tn = (tb + 1 < SEQ / TB) ? (tb + 1) * TB : tb * TB;
#pragma unroll
                for (int t = 0; t < TB; ++t) { const size_t r = rowb + tn + t; nf[t] = *(const u32x2*)(Fb + r * CW + colk); nq[t] = *(const u32x2*)(Qb + r * CW + colk); ni[t] = Ib[r * CW + colv]; }
                float part[TB];
#pragma unroll
                for (int t = 0; t < TB; ++t) { const float iv = bf2f(ci[t]);
                    const float f0 = __builtin_amdgcn_exp2f(bflo(cf[t].x)), f1 = __builtin_amdgcn_exp2f(bfhi(cf[t].x)), f2 = __builtin_amdgcn_exp2f(bflo(cf[t].y)), f3 = __builtin_amdgcn_exp2f(bfhi(cf[t].y));
                    s[0] = f0 * s[0] + (1.0f - f0) * iv; s[1] = f1 * s[1] + (1.0f - f1) * iv; s[2] = f2 * s[2] + (1.0f - f2) * iv; s[3] = f3 * s[3] + (1.0f - f3) * iv;
                    float p = bflo(cq[t].x) * s[0] + bfhi(cq[t].x) * s[1] + bflo(cq[t].y) * s[2] + bfhi(cq[t].y) * s[3];
                    p += __shfl_xor(p, 16); p += __shfl_xor(p, 32); part[t] = p; }
                LAS float* rb = red + (tb & 1) * 2048;
                if (lane < 16) {
#pragma unroll
                    for (int t = 0; t < TB; ++t) rb[wave * 256 + t * 16 + lane] = part[t]; }
                __syncthreads();
                if (tid < 256) { float o = 0.f;
#pragma unroll
                    for (int w = 0; w < 8; ++w) o += rb[w * 256 + tid];
                    O[(rowb + tb * TB + (tid >> 4)) * CW + h * 128 + vq * 16 + (tid & 15)] = o; }
#pragma unroll
                for (int t = 0; t < TB; ++t) { cf[t] = nf[t]; cq[t] = nq[t]; ci[t] = ni[t]; }
            }
            __syncthreads();
        }
    }
    SEAM(11);

    if (IN(12)) { const float* O = (const float*)(R + R_O); const bf16_t* Gb = (const bf16_t*)(R + R_QFIG) + (size_t)3 * M * CW; bf16_t* OG = (bf16_t*)(R + R_OG); float g[16]; ld_row_f32(args.in[I_ONORMG], lane, g);
        for (int i = 0; i < RPW / NWAVES; ++i) { const int m = bx * RPW + wave * (RPW / NWAVES) + i; float o[16], gg[16]; ld_row_f32(O + (size_t)m * CW, lane, o); ld_row_bf16(Gb + (size_t)m * CW, lane, gg);
            float s0 = 0.f, s1 = 0.f;
#pragma unroll
            for (int j = 0; j < 8; ++j) { s0 += o[j] * o[j]; s1 += o[8 + j] * o[8 + j]; }
#pragma unroll
            for (int sh = 1; sh < 16; sh <<= 1) { s0 += __shfl_xor(s0, sh); s1 += __shfl_xor(s1, sh); }
            const float r0 = __builtin_amdgcn_rsqf(s0 * (1.0f / 128.0f) + EPS), r1 = __builtin_amdgcn_rsqf(s1 * (1.0f / 128.0f) + EPS);
#pragma unroll
            for (int j = 0; j < 8; ++j) { o[j] = o[j] * r0 * g[j] * gg[j]; o[8 + j] = o[8 + j] * r1 * g[8 + j] * gg[8 + j]; }
            st_row_bf16(OG + (size_t)m * CW, lane, o); } }
    SEAM(12);

    if (IN(13)) { pg8::StaticOrder S; S.init((const bf16_t*)(R + R_OG), (const bf16_t*)(ws + W_OUTC), M, D, CW, G, bx); pg8::EpiPlain E{(bf16_t*)(R + R_MIX1), D};
        pg8::gemm_phase<pg8::EpiPlain, pg8::StaticOrder, false>(lds, CW, S, E); }
    SEAM(13);

    if (IN(14)) { const bf16_t* MIX = (const bf16_t*)(R + R_MIX1); float g[16], g2[16]; ld_row_f32(normg + 5 * D, lane, g); ld_row_f32(normg + 6 * D, lane, g2);
        LAS float* wrl = (LAS float*)lds;
        LAS int* lcnt = (LAS int*)(lds + 32768);
        for (int e = tid; e < D * NE; e += NTHR) wrl[e] = args.in[I_WROUTER][e];
        if (tid < NE) lcnt[tid] = 0;
        __syncthreads();
        for (int i = 0; i < RPW / NWAVES; ++i) { const int m = bx * RPW + wave * (RPW / NWAVES) + i; float mx[16], x[16]; ld_row_bf16(MIX + (size_t)m * D, lane, mx); ld_row_bf16(XB + (size_t)m * D, lane, x);
            const float rm = __builtin_amdgcn_rsqf(wave_sum(sumsq16(mx)) * (1.0f / D) + EPS);
#pragma unroll
            for (int j = 0; j < 16; ++j) x[j] += g[j] * mx[j] * rm;
            const float rs = __builtin_amdgcn_rsqf(wave_sum(sumsq16(x)) * (1.0f / D) + EPS);
            st_row_bf16(XA + (size_t)m * D, lane, x); if (lane == 0) rstd4[m] = rs;
            float lg[NE];
#pragma unroll
            for (int e = 0; e < NE; ++e) lg[e] = 0.f;
#pragma unroll
            for (int j = 0; j < 16; ++j) { const int col = (j < 8 ? 0 : 512) + lane * 8 + (j & 7); const float hn = x[j] * rs * g2[j];
                const LAS f32x4* wp = (const LAS f32x4*)(wrl + col * NE); const f32x4 w0 = wp[0], w1 = wp[1];
#pragma unroll
                for (int e = 0; e < 4; ++e) { lg[e] += hn * w0[e]; lg[4 + e] += hn * w1[e]; } }
#pragma unroll
            for (int e = 0; e < NE; ++e) lg[e] = wave_sum(lg[e]) + args.in[I_BROUTER][e];
            if (lane == 0) { int e1 = 0; float l1 = lg[0];
#pragma unroll
                for (int e = 1; e < NE; ++e) if (lg[e] > l1) { l1 = lg[e]; e1 = e; }
                int e2 = -1; float l2 = -3.0e38f;
#pragma unroll
                for (int e = 0; e < NE; ++e) if (e != e1 && lg[e] > l2) { l2 = lg[e]; e2 = e; }
                const float ex = expf(l2 - l1), w1 = 1.0f / (1.0f + ex), w2 = ex / (1.0f + ex);
                *(i32x4*)(route + (size_t)m * 4) = (i32x4){e1, e2, __float_as_int(w1), __float_as_int(w2)};
                atomicAdd((int*)(lcnt + e1), 1); atomicAdd((int*)(lcnt + e2), 1); } }
        __syncthreads();
        if (tid < NE) cntg[bx * NE + tid] = lcnt[tid];
    }
    SEAM(14);

    if (IN(15)) {
        LAS int* lc = (LAS int*)lds;
        LAS int* tot = (LAS int*)(lds + 32768);
        for (int e = tid; e < G * NE; e += NTHR) lc[e] = cntg[e];
        __syncthreads();
        if (tid < NE) { int t = 0, pre = 0; for (int w = 0; w < G; ++w) { if (w == bx) pre = t; t += lc[w * NE + tid]; } tot[tid] = t; tot[8 + tid] = pre; }
        __syncthreads();
        if (tid == 0) { int b = 0; for (int e = 0; e < NE; ++e) { tot[16 + e] = b; b += (tot[e] + 255) & ~255; } tot[24] = b; }
        __syncthreads();
        if (wave == 0) { int run[NE];
#pragma unroll
            for (int e = 0; e < NE; ++e) run[e] = 0;
            for (int it = 0; it < RPW / 64; ++it) { const int m = bx * RPW + it * 64 + lane; const i32x4 rt = *(const i32x4*)(route + (size_t)m * 4);
                const unsigned long long lt = (1ull << lane) - 1ull;
#pragma unroll
                for (int e = 0; e < NE; ++e) { const bool has = (rt[0] == e) || (rt[1] == e); const unsigned long long mask = __ballot(has);
                    if (has) { const int pos = tot[16 + e] + tot[8 + e] + run[e] + __popcll(mask & lt); const int slot = (rt[1] == e) ? 1 : 0;
                        perm[pos] = m; rinfo[2 * pos] = m * 2 + slot; rinfo[2 * pos + 1] = slot ? rt[3] : rt[2]; }
                    run[e] += __popcll(mask); } } }
        if (bx < NE) { const int e = bx; const int beg = tot[16 + e] + tot[e], end = tot[16 + e] + ((tot[e] + 255) & ~255);
            for (int p = beg + tid; p < end; p += NTHR) { perm[p] = 0; rinfo[2 * p] = -1; rinfo[2 * p + 1] = 0; } }
        if (bx == 0) { if (tid == 0) meta[0] = tot[24] / 256;
            for (int p = tid; p < tot[24] / 256; p += NTHR) { int e = 0;
#pragma unroll
                for (int k = 1; k < NE; ++k) if (p * 256 >= tot[16 + k]) e = k;
                meta[16 + p] = e; } }
        __syncthreads();
    }
    SEAM(15);

    if (IN(16)) { const int nP = __builtin_amdgcn_readfirstlane(meta[0]);
        pg8::MoeOrder<true> S; S.init(XA, (const bf16_t*)(ws + W_EGU), nP, 2 * EFF, D, G, bx, meta + 16, perm); pg8::EpiSwiGLU<true> E{(bf16_t*)(R + R_H), EFF, rstd4, perm};
        pg8::gemm_phase<pg8::EpiSwiGLU<true>, pg8::MoeOrder<true>, true>(lds, D, S, E); }
    SEAM(16);

    if (IN(17)) { const int nP = __builtin_amdgcn_readfirstlane(meta[0]);
        pg8::MoeOrder<false> S; S.init((const bf16_t*)(R + R_H), (const bf16_t*)(ws + W_EDN), nP, D, EFF, G, bx, meta + 16, perm); pg8::EpiMoeDown E{rinfo, (bf16_t*)args.out};
        pg8::gemm_phase<pg8::EpiMoeDown, pg8::MoeOrder<false>, false>(lds, EFF, S, E); }
    SEAM(17);

    if (IN(18)) { const bf16_t* S0 = (const bf16_t*)args.out; const bf16_t* S1 = S0 + (size_t)M * D; float g[16]; ld_row_f32(normg + 7 * D, lane, g);
        for (int i = 0; i < RPW / NWAVES; ++i) { const int m = bx * RPW + wave * (RPW / NWAVES) + i; float mx[16], m2[16], x[16]; ld_row_bf16(S0 + (size_t)m * D, lane, mx); ld_row_bf16(S1 + (size_t)m * D, lane, m2); ld_row_bf16(XA + (size_t)m * D, lane, x);
#pragma unroll
            for (int j = 0; j < 16; ++j) mx[j] += m2[j];
            const float rm = __builtin_amdgcn_rsqf(wave_sum(sumsq16(mx)) * (1.0f / D) + EPS);
#pragma unroll
            for (int j = 0; j < 16; ++j) x[j] += g[j] * mx[j] * rm;
            st_row_bf16(XB + (size_t)m * D, lane, x); } }
    SEAM(18);

    if (IN(19)) { pg8::StaticOrder S; S.init(PB + (size_t)M * PLE, (const bf16_t*)(ws + W_PPROJ) + (size_t)D * PLE, M, D, PLE, G, bx); pg8::EpiPlain E{(bf16_t*)(R + R_PP1), D};
        pg8::gemm_phase<pg8::EpiPlain, pg8::StaticOrder, false>(lds, PLE, S, E); }
    SEAM(19);

    if (IN(20)) { pg8::StaticOrder S; S.init(XB, (const bf16_t*)(ws + W_PGATE) + (size_t)D * D, M, D, D, G, bx); pg8::EpiPleGate<true> E{XB, (const bf16_t*)(R + R_PP1), nullptr, nullptr, args.out};
        pg8::gemm_phase<pg8::EpiPleGate<true>, pg8::StaticOrder, false>(lds, D, S, E); }
#undef IN
#undef SEAM
}

constexpr int N_PHASES = 21;
extern "C" void kernel_launch(void* const* d_in, const int* in_sizes, int n_in, void* d_out, int out_size, void* d_ws, size_t ws_size, hipStream_t stream) {
    static int grid = 0;
    if (grid == 0) {
        if (n_in != 22 || in_sizes[0] != M * D || out_size != M * D || ws_size < WS_END) { fprintf(stderr, "kernel_launch: unexpected shapes (n_in %d, in0 %d, out %d, ws %zu < %zu); nothing launched\n", n_in, n_in > 0 ? in_sizes[0] : -1, out_size, ws_size, (size_t)WS_END); grid = -1; return; }
        int dev = 0, cus = 0, per_cu = 0;
        if (hipGetDevice(&dev) != hipSuccess || hipDeviceGetAttribute(&cus, hipDeviceAttributeMultiprocessorCount, dev) != hipSuccess) { grid = -1; return; }
        if (hipFuncSetAttribute((const void*)trunk_fwd, hipFuncAttributeMaxDynamicSharedMemorySize, LDS_BYTES) != hipSuccess) { fprintf(stderr, "kernel_launch: hipFuncSetAttribute failed\n"); grid = -1; return; }
        if (hipOccupancyMaxActiveBlocksPerMultiprocessor(&per_cu, (const void*)trunk_fwd, NTHR, LDS_BYTES) != hipSuccess || per_cu < 1) { fprintf(stderr, "kernel_launch: occupancy query reports %d workgroups per CU\n", per_cu); }
        (void)hipGetLastError();
        grid = cus;
        if (grid > 1024 || (M % (grid * NWAVES)) != 0 || ((M / grid) % 64) != 0) { fprintf(stderr, "kernel_launch: unsupported CU count %d\n", grid); grid = -1; return; }
    }
    if (grid < 0) return;
    if (hipMemsetAsync((char*)d_ws + WS_CTL, 0, CTL_ZERO_BYTES, stream) != hipSuccess) return;
    Args a{};
    for (int i = 0; i < 22; ++i) a.in[i] = (const float*)d_in[i];
    a.out = (float*)d_out; a.ws = (unsigned char*)d_ws; a.pad = 0;
    if (MK_N_LAUNCHES == 1) { a.ph_lo = 0; a.ph_hi = N_PHASES; a.li = 0; hipLaunchKernelGGL(trunk_fwd, dim3(grid), dim3(NTHR), LDS_BYTES, stream, a); }
    else for (int ph = 0; ph < N_PHASES; ++ph) { a.ph_lo = ph; a.ph_hi = ph + 1; a.li = ph; hipLaunchKernelGGL(trunk_fwd, dim3(grid), dim3(NTHR), LDS_BYTES, stream, a); }
}
```

```cpp
#include <hip/hip_runtime.h>
#include <cstdio>
#include <cstdint>

#ifndef MK_N_LAUNCHES
#define MK_N_LAUNCHES 1
#endif

#define GAS __attribute__((address_space(1)))
#define LAS __attribute__((address_space(3)))
typedef unsigned short bf16_t;
typedef short bf16x8 __attribute__((ext_vector_type(8)));
typedef float f32x4 __attribute__((ext_vector_type(4)));
typedef float f32x2 __attribute__((ext_vector_type(2)));
typedef unsigned u32x4 __attribute__((ext_vector_type(4)));
typedef unsigned u32x2 __attribute__((ext_vector_type(2)));
typedef int i32x4 __attribute__((ext_vector_type(4)));

constexpr int D = 1024, BATCH = 4, SEQ = 8192, M = BATCH * SEQ;
constexpr int PLE = 256, AB_IN = 2560, FF = 2816, CW = 1024, NE = 8, EFF = 3584;
constexpr float EPS = 1e-6f;
constexpr int NWAVES = 8, NTHR = 512;
constexpr int MAXP = 264;

__device__ __forceinline__ float bflo(unsigned w) { return __uint_as_float(w << 16); }
__device__ __forceinline__ float bfhi(unsigned w) { return __uint_as_float(w & 0xffff0000u); }
__device__ __forceinline__ float bf2f(bf16_t b) { return __uint_as_float((unsigned)b << 16); }
__device__ __forceinline__ unsigned cvt_pk_bf16(float lo, float hi) { unsigned r; asm volatile("v_cvt_pk_bf16_f32 %0, %1, %2" : "=v"(r) : "v"(lo), "v"(hi)); return r; }
__device__ __forceinline__ bf16_t f2bf(float f) { return (bf16_t)(cvt_pk_bf16(f, 0.f) & 0xffffu); }
__device__ __forceinline__ float fsigmoid(float x) { return __builtin_amdgcn_rcpf(1.0f + __builtin_amdgcn_exp2f(-1.4426950408889634f * x)); }
__device__ __forceinline__ float fsilu(float x) { return x * fsigmoid(x); }
__device__ __forceinline__ float fgelu_tanh(float x) { const float u = x + 0.044715f * x * x * x; return x * __builtin_amdgcn_rcpf(1.0f + __builtin_amdgcn_exp2f(-2.3022082f * u)); }
__device__ __forceinline__ float wave_sum(float v) {
#pragma unroll
    for (int o = 1; o < 64; o <<= 1) v += __shfl_xor(v, o);
    return v;
}
__device__ __forceinline__ void unpack8(const u32x4 a, float* v) { v[0] = bflo(a.x); v[1] = bfhi(a.x); v[2] = bflo(a.y); v[3] = bfhi(a.y); v[4] = bflo(a.z); v[5] = bfhi(a.z); v[6] = bflo(a.w); v[7] = bfhi(a.w); }
__device__ __forceinline__ u32x4 pack8(const float* v) { u32x4 w; w.x = cvt_pk_bf16(v[0], v[1]); w.y = cvt_pk_bf16(v[2], v[3]); w.z = cvt_pk_bf16(v[4], v[5]); w.w = cvt_pk_bf16(v[6], v[7]); return w; }

namespace pg8 {
constexpr int BM = 256, BK = 64, HALF = 128, HTB = HALF * BK * 2, STAGE_BYTES = 8 * HTB, NXCD = 8, WGM = 8;
__host__ __device__ __forceinline__ int lds_byte(int r, int c) { const int st = (r >> 4) * 2 + (c >> 5), rr = r & 15, cc = c & 31, ob = rr * 64 + cc * 2; return st * 1024 + (ob ^ (((ob >> 9) & 1) << 5)); }
__host__ __device__ __forceinline__ void stage_rc(int b, int& R, int& C) { const int st = b / 1024, sb = b % 1024, swz = sb ^ (((sb >> 9) & 1) << 5); R = (st >> 1) * 16 + swz / 64; C = (st & 1) * 32 + (swz % 64) / 2; }
__host__ __device__ __forceinline__ int perm32(int rho) { const int n = rho >> 4, i = rho & 15; return 8 * (i >> 2) + 4 * n + (i & 3); }

struct Unit { int pm, pn; const char* a; const char* b; };

__device__ __forceinline__ bool tile_of(int i, int G, int c, int nM, int nN, int& pm, int& pn) {
    const int nwg = nM * nN; const long L = (long)i * G + c; if (L >= nwg) return false;
    int wgid = (int)L; { const int q = nwg / NXCD, r = nwg % NXCD, xcd = wgid % NXCD, off = wgid / NXCD; wgid = (xcd < r ? xcd * (q + 1) : r * (q + 1) + (xcd - r) * q) + off; }
    const int nig = WGM * nN, gid = wgid / nig, fm = gid * WGM, gsz = (nM - fm) < WGM ? (nM - fm) : WGM;
    pm = fm + ((wgid % nig) % gsz); pn = (wgid % nig) / gsz; return true;
}
struct StaticOrder {
    int nM, nN, G, c; const char* A; const char* Bt; size_t tstep;
    __device__ __forceinline__ void init(const bf16_t* A_, const bf16_t* Bt_, int M_, int N_, int K_, int G_, int c_) { nM = M_ / BM; nN = N_ / BM; G = G_; c = c_; A = (const char*)A_; Bt = (const char*)Bt_; tstep = (size_t)BM * K_ * 2; }
    __device__ __forceinline__ bool next(int i, Unit& u) const { if (!tile_of(i, G, c, nM, nN, u.pm, u.pn)) return false; u.a = A + (size_t)u.pm * tstep; u.b = Bt + (size_t)u.pn * tstep; return true; }
    __device__ __forceinline__ int gather_tok(const Unit&, int) const { return 0; }
};
template <bool GATHER> struct MoeOrder {
    int nM, nN, G, c; const char* A; const char* Bt; size_t tstep, estride; const int* pexp; const int* perm;
    __device__ __forceinline__ void init(const bf16_t* A_, const bf16_t* Bt_, int nM_, int N_, int K_, int G_, int c_, const int* pexp_, const int* perm_) {
        nM = nM_; nN = N_ / BM; G = G_; c = c_; A = (const char*)A_; Bt = (const char*)Bt_; tstep = (size_t)BM * K_ * 2; estride = (size_t)N_ * K_ * 2; pexp = pexp_; perm = perm_; }
    __device__ __forceinline__ bool next(int i, Unit& u) const { if (!tile_of(i, G, c, nM, nN, u.pm, u.pn)) return false;
        const int e = __builtin_amdgcn_readfirstlane(pexp[u.pm]); u.a = GATHER ? A : A + (size_t)u.pm * tstep; u.b = Bt + (size_t)e * estride + (size_t)u.pn * tstep; return true; }
    __device__ __forceinline__ int gather_tok(const Unit& u, int r) const { return perm[u.pm * BM + r]; }
};

template <class Epi, class Sched, bool GATHER>
__device__ __forceinline__ void gemm_phase(LAS unsigned char* lds, const int K, const Sched& S, const Epi& E) {
    const int tid = threadIdx.x, wid = __builtin_amdgcn_readfirstlane(tid >> 6), lane = tid & 63, wr = wid >> 2, wc = wid & 3, fr = lane & 15, fq = lane >> 4;
    const int nt = K / BK;
    const size_t kstep = (size_t)(BK * 2);
    const size_t hstep = (size_t)HALF * K * 2;
    unsigned voffB[2]; int sR[2], sC[2];
#pragma unroll
    for (int i = 0; i < 2; ++i) { int R, C; stage_rc(tid * 16 + i * 8192, R, C); const int Rb = (R & ~31) + perm32(R & 31); sR[i] = R; sC[i] = C; voffB[i] = (unsigned)(Rb * K + C) * 2u; }
    const unsigned ldsw = (unsigned)wid * 1024u;
    const int aoff = lds_byte(wr * 64 + fr, fq * 8), boff = lds_byte(wc * 32 + fr, fq * 8);
#define PG8_SA(b, h) (((b) * 2 + (h)) * HTB)
#define PG8_SB(b, h) ((4 + (b) * 2 + (h)) * HTB)
#define PG8_STAGE_B(bufoff, gbase) do { _Pragma("unroll") for (int _i = 0; _i < 2; ++_i) \
        __builtin_amdgcn_global_load_lds((const unsigned*)((const char*)(gbase) + voffB[_i]), (LAS unsigned*)(lds + (bufoff) + ldsw + _i * 8192), 16, 0, 0); } while (0)
#define PG8_STAGE_A(bufoff, gbase, off, h) do { _Pragma("unroll") for (int _i = 0; _i < 2; ++_i) \
        __builtin_amdgcn_global_load_lds((const unsigned*)((const char*)(gbase) + (off)[h][_i]), (LAS unsigned*)(lds + (bufoff) + ldsw + _i * 8192), 16, 0, 0); } while (0)
#define PG8_LDA(dst, b, h) do { _Pragma("unroll") for (int m = 0; m < 4; ++m) _Pragma("unroll") for (int k = 0; k < 2; ++k) dst[m][k] = *(const LAS bf16x8*)(lds + PG8_SA(b, h) + aoff + m * 2048 + k * 1024); } while (0)
#define PG8_LDB(dst, b, h) do { _Pragma("unroll") for (int n = 0; n < 2; ++n) _Pragma("unroll") for (int k = 0; k < 2; ++k) dst[n][k] = *(const LAS bf16x8*)(lds + PG8_SB(b, h) + boff + n * 2048 + k * 1024); } while (0)
#define PG8_MMA(ai, bj, At, Bt) do { __builtin_amdgcn_s_setprio(1); _Pragma("unroll") for (int m = 0; m < 4; ++m) _Pragma("unroll") for (int n = 0; n < 2; ++n) _Pragma("unroll") for (int k = 0; k < 2; ++k) \
        acc[ai][bj][m][n] = __builtin_amdgcn_mfma_f32_16x16x32_bf16(Bt[n][k], At[m][k], acc[ai][bj][m][n], 0, 0, 0); __builtin_amdgcn_s_setprio(0); } while (0)
#define PG8_WAIT_V(n) asm volatile("s_waitcnt vmcnt(" #n ")" ::: "memory")
#define PG8_WAIT_L(n) asm volatile("s_waitcnt lgkmcnt(" #n ")" ::: "memory")
#define PG8_BAR __builtin_amdgcn_s_barrier()
#define PG8_SCHED __builtin_amdgcn_sched_barrier(0)
    Unit cur, nxt; int ui = 0;
    if (!S.next(0, cur)) return;
    unsigned coff[2][2], noff[2][2];
#pragma unroll
    for (int h = 0; h < 2; ++h)
#pragma unroll
        for (int i = 0; i < 2; ++i) {
            if constexpr (GATHER) coff[h][i] = (unsigned)(S.gather_tok(cur, h * HALF + sR[i]) * K + sC[i]) * 2u;
            else coff[h][i] = (unsigned)(h * (int)hstep) + (unsigned)(sR[i] * K + sC[i]) * 2u;
            noff[h][i] = coff[h][i];
        }
    f32x4 acc[2][2][4][2];
#pragma unroll
    for (int a = 0; a < 2; ++a)
#pragma unroll
        for (int b = 0; b < 2; ++b)
#pragma unroll
            for (int m = 0; m < 4; ++m)
#pragma unroll
                for (int n = 0; n < 2; ++n) acc[a][b][m][n] = (f32x4){0.f, 0.f, 0.f, 0.f};
    bf16x8 At[4][2], B0[2][2], B1[2][2];
    const char* cA = cur.a; const char* cB = cur.b;
    PG8_STAGE_B(PG8_SB(0, 0), cB); PG8_STAGE_B(PG8_SB(0, 1), cB + hstep); PG8_STAGE_A(PG8_SA(0, 0), cA, coff, 0); PG8_STAGE_A(PG8_SA(0, 1), cA, coff, 1);
    if (wr == 1) PG8_BAR;
    PG8_WAIT_V(2); PG8_BAR;
    PG8_STAGE_B(PG8_SB(1, 0), cB + kstep); PG8_STAGE_A(PG8_SA(1, 0), cA + kstep, coff, 0); PG8_STAGE_B(PG8_SB(1, 1), cB + hstep + kstep);
    PG8_WAIT_V(6); PG8_BAR;
    for (;;) {
        const bool has_next = S.next(ui + 1, nxt);
        const char* nA = has_next ? nxt.a : cA; const char* nB = has_next ? nxt.b : cB;
        if constexpr (GATHER) {
            if (has_next) {
#pragma unroll
                for (int h = 0; h < 2; ++h)
#pragma unroll
                    for (int i = 0; i < 2; ++i) noff[h][i] = (unsigned)(S.gather_tok(nxt, h * HALF + sR[i]) * K + sC[i]) * 2u;
            }
        }
        for (int t = 0; t < nt; t += 2) {
            const bool last = (t == nt - 2);
            const char* a1 = cA + (size_t)(t + 1) * kstep;
            const char* a2 = last ? nA : cA + (size_t)(t + 2) * kstep; const char* b2 = last ? nB : cB + (size_t)(t + 2) * kstep;
            const char* a3 = a2 + kstep; const char* b3 = b2 + kstep;
            unsigned o2[2][2];
#pragma unroll
            for (int h = 0; h < 2; ++h)
#pragma unroll
                for (int i = 0; i < 2; ++i) o2[h][i] = GATHER ? (last ? noff[h][i] : coff[h][i]) : coff[h][i];
            PG8_LDB(B0, 0, 0); PG8_LDB(B1, 0, 1); PG8_SCHED; PG8_LDA(At, 0, 0); PG8_STAGE_A(PG8_SA(1, 1), a1, coff, 1);
            PG8_WAIT_V(8); PG8_WAIT_L(0); PG8_BAR; PG8_MMA(0, 0, At, B0); PG8_MMA(0, 1, At, B1); PG8_BAR; PG8_SCHED;
            PG8_LDA(At, 0, 1); PG8_STAGE_B(PG8_SB(0, 0), b2); PG8_STAGE_B(PG8_SB(0, 1), b2 + hstep); PG8_STAGE_A(PG8_SA(0, 0), a2, o2, 0);
            PG8_WAIT_V(8); PG8_WAIT_L(0); PG8_BAR; PG8_MMA(1, 0, At, B0); PG8_MMA(1, 1, At, B1); PG8_BAR; PG8_SCHED;
            PG8_LDB(B0, 1, 0); PG8_LDB(B1, 1, 1); PG8_SCHED; PG8_LDA(At, 1, 0); PG8_STAGE_A(PG8_SA(0, 1), a2, o2, 1);
            PG8_WAIT_V(8); PG8_WAIT_L(0); PG8_BAR; PG8_MMA(0, 0, At, B0); PG8_MMA(0, 1, At, B1); PG8_BAR; PG8_SCHED;
            PG8_LDA(At, 1, 1); PG8_STAGE_B(PG8_SB(1, 0), b3); PG8_STAGE_B(PG8_SB(1, 1), b3 + hstep); PG8_STAGE_A(PG8_SA(1, 0), a3, o2, 0);
            PG8_WAIT_V(8); PG8_WAIT_L(0); PG8_BAR; PG8_MMA(1, 0, At, B0); PG8_MMA(1, 1, At, B1); PG8_BAR; PG8_SCHED;
        }
        if (wr == 0) PG8_BAR;
        E(acc, cur, wr, wc, fr, fq);
        if (!has_next) break;
#pragma unroll
        for (int a = 0; a < 2; ++a)
#pragma unroll
            for (int b = 0; b < 2; ++b)
#pragma unroll
                for (int m = 0; m < 4; ++m)
#pragma unroll
                    for (int n = 0; n < 2; ++n) acc[a][b][m][n] = (f32x4){0.f, 0.f, 0.f, 0.f};
        cur = nxt; cA = nA; cB = nB; ++ui;
#pragma unroll
        for (int h = 0; h < 2; ++h)
#pragma unroll
            for (int i = 0; i < 2; ++i) coff[h][i] = noff[h][i];
        if (wr == 1) PG8_BAR;
    }
    PG8_WAIT_V(0);
    PG8_BAR;
#undef PG8_SA
#undef PG8_SB
#undef PG8_STAGE_A
#undef PG8_STAGE_B
#undef PG8_LDA
#undef PG8_LDB
#undef PG8_MMA
#undef PG8_WAIT_V
#undef PG8_WAIT_L
#undef PG8_BAR
#undef PG8_SCHED
}

typedef f32x4 AccT[2][2][4][2];
#define EPI_ROWS_BEGIN const int row0 = u.pm * BM + wr * 64 + fr; const int colw = wc * 32 + 8 * fq; \
    _Pragma("unroll") for (int ai = 0; ai < 2; ++ai) _Pragma("unroll") for (int m = 0; m < 4; ++m) { const int r = row0 + ai * HALF + m * 16;
#define EPI_ROWS_END }

struct EpiInAB {
    bf16_t* Z; const float* rstd;
    __device__ __forceinline__ void operator()(const AccT& acc, const Unit& u, int wr, int wc, int fr, int fq) const {
        const bool act = u.pn < 4;
        EPI_ROWS_BEGIN
            const float rs = rstd[r]; bf16_t* rowp = Z + (size_t)r * AB_IN + u.pn * BM + colw;
#pragma unroll
            for (int bj = 0; bj < 2; ++bj) { float v[8];
#pragma unroll
                for (int j = 0; j < 4; ++j) { v[j] = acc[ai][bj][m][0][j] * rs; v[4 + j] = acc[ai][bj][m][1][j] * rs; }
                if (act) {
#pragma unroll
                    for (int j = 0; j < 8; ++j) v[j] = fgelu_tanh(v[j]); }
                *(u32x4*)(rowp + bj * HALF) = pack8(v); }
        EPI_ROWS_END
    }
};
struct EpiPlain {
    bf16_t* O; int ldc;
    __device__ __forceinline__ void operator()(const AccT& acc, const Unit& u, int wr, int wc, int fr, int fq) const {
        EPI_ROWS_BEGIN
            bf16_t* rowp = O + (size_t)r * ldc + u.pn * BM + colw;
#pragma unroll
            for (int bj = 0; bj < 2; ++bj) { float v[8];
#pragma unroll
                for (int j = 0; j < 4; ++j) { v[j] = acc[ai][bj][m][0][j]; v[4 + j] = acc[ai][bj][m][1][j]; }
                *(u32x4*)(rowp + bj * HALF) = pack8(v); }
        EPI_ROWS_END
    }
};
template <bool MOE> struct EpiSwiGLU {
    bf16_t* H; int ldh; const float* rstd; const int* perm;
    __device__ __forceinline__ void operator()(const AccT& acc, const Unit& u, int wr, int wc, int fr, int fq) const {
        EPI_ROWS_BEGIN
            const int tok = MOE ? perm[r] : r; const float rs = rstd[tok];
            float v[8];
#pragma unroll
            for (int n = 0; n < 2; ++n)
#pragma unroll
                for (int j = 0; j < 4; ++j) { const float g = acc[ai][0][m][n][j] * rs, up = acc[ai][1][m][n][j] * rs; v[4 * n + j] = fsilu(g) * up; }
            *(u32x4*)(H + (size_t)r * ldh + u.pn * HALF + colw) = pack8(v);
        EPI_ROWS_END
    }
};
struct EpiInC {
    bf16_t* QFIG; const float* ssp; const float* lb;
    __device__ __forceinline__ void operator()(const AccT& acc, const Unit& u, int wr, int wc, int fr, int fq) const {
        const int type = u.pn >> 2; const int colt = (u.pn & 3) * BM + wc * 32 + 8 * fq;
        bf16_t* base = QFIG + (size_t)type * M * CW;
        EPI_ROWS_BEGIN
            const f32x4* sp = (const f32x4*)(ssp + (size_t)r * 16); const f32x4 s0 = sp[0], s1 = sp[1], s2 = sp[2], s3 = sp[3];
            const float ss = ((s0[0] + s0[1]) + (s0[2] + s0[3])) + ((s1[0] + s1[1]) + (s1[2] + s1[3])) + ((s2[0] + s2[1]) + (s2[2] + s2[3])) + ((s3[0] + s3[1]) + (s3[2] + s3[3]));
            const float rs = __builtin_amdgcn_rsqf(ss * (1.0f / D) + EPS);
#pragma unroll
            for (int bj = 0; bj < 2; ++bj) { float v[8];
#pragma unroll
                for (int j = 0; j < 4; ++j) { v[j] = acc[ai][bj][m][0][j] * rs; v[4 + j] = acc[ai][bj][m][1][j] * rs; }
                if (type == 0 || type == 3) {
#pragma unroll
                    for (int j = 0; j < 8; ++j) v[j] = fsilu(v[j]);
                } else if (type == 1) {
                    const f32x4 l0 = *(const f32x4*)(lb + colt + bj * HALF), l1 = *(const f32x4*)(lb + colt + bj * HALF + 4);
#pragma unroll
                    for (int j = 0; j < 8; ++j) { const float l = j < 4 ? l0[j] : l1[j - 4]; v[j] = __builtin_amdgcn_logf(l + (1.0f - l) * fsigmoid(v[j])); }
                }
                *(u32x4*)(base + (size_t)r * CW + colt + bj * HALF) = pack8(v); }
        EPI_ROWS_END
    }
};
template <bool FINAL> struct EpiPleGate {
    const bf16_t* X; const bf16_t* PP; bf16_t* XO; float* ssp; float* OUT;
    __device__ __forceinline__ void operator()(const AccT& acc, const Unit& u, int wr, int wc, int fr, int fq) const {
        EPI_ROWS_BEGIN
            const size_t off = (size_t)r * D + u.pn * BM + colw; float ssq = 0.f;
#pragma unroll
            for (int bj = 0; bj < 2; ++bj) { float x[8], p[8];
                unpack8(*(const u32x4*)(X + off + bj * HALF), x); unpack8(*(const u32x4*)(PP + off + bj * HALF), p);
#pragma unroll
                for (int j = 0; j < 8; ++j) { const float a = j < 4 ? acc[ai][bj][m][0][j] : acc[ai][bj][m][1][j - 4]; x[j] = x[j] + fsigmoid(a) * p[j]; ssq += x[j] * x[j]; }
                if (FINAL) { *(f32x4*)(OUT + off + bj * HALF) = (f32x4){x[0], x[1], x[2], x[3]}; *(f32x4*)(OUT + off + bj * HALF + 4) = (f32x4){x[4], x[5], x[6], x[7]}; }
                else *(u32x4*)(XO + off + bj * HALF) = pack8(x); }
            if (!FINAL) { ssq += __shfl_xor(ssq, 16); ssq += __shfl_xor(ssq, 32); if (fq == 0) ssp[(size_t)r * 16 + u.pn * 4 + wc] = ssq; }
        EPI_ROWS_END
    }
};
struct EpiMoeDown {
    const int* rowinfo; bf16_t* slots;
    __device__ __forceinline__ void operator()(const AccT& acc, const Unit& u, int wr, int wc, int fr, int fq) const {
        EPI_ROWS_BEGIN
            const int info = rowinfo[2 * r]; const float w = __int_as_float(rowinfo[2 * r + 1]);
            if (info >= 0) { bf16_t* rowp = slots + (size_t)(info & 1) * M * D + (size_t)(info >> 1) * D + u.pn * BM + colw;
#pragma unroll
                for (int bj = 0; bj < 2; ++bj) { float v[8];
#pragma unroll
                    for (int j = 0; j < 4; ++j) { v[j] = acc[ai][bj][m][0][j] * w; v[4 + j] = acc[ai][bj][m][1][j] * w; }
                    *(u32x4*)(rowp + bj * HALF) = pack8(v); } }
        EPI_ROWS_END
    }
};
}

constexpr size_t MiB = 1u << 20;
constexpr size_t WS_CTL = 0, CTL_ZERO_BYTES = 1 * MiB;
constexpr size_t WS_SMALL = 1 * MiB;
constexpr size_t SM_RSTD0 = WS_SMALL, SM_RSTD1 = SM_RSTD0 + 128 * 1024, SM_RSTD4 = SM_RSTD1 + 128 * 1024;
constexpr size_t SM_LB = SM_RSTD4 + 128 * 1024;
constexpr size_t SM_ROUTE = SM_LB + 4096;
constexpr size_t SM_CNT = SM_ROUTE + 512 * 1024;
constexpr size_t SM_META = SM_CNT + 32 * 1024;
constexpr size_t SM_PERM = SM_META + 4096;
constexpr size_t SM_RINFO = SM_PERM + 512 * 1024;
constexpr size_t SM_SSP = SM_RINFO + 1024 * 1024;
static_assert(SM_SSP + 2 * MiB <= 9 * MiB, "small arrays");
constexpr size_t WS_W = 9 * MiB;
constexpr size_t W_INAB = WS_W, W_OUTAB = W_INAB + 5 * MiB, W_GU0 = W_OUTAB + 2 * MiB, W_DN0 = W_GU0 + 11 * MiB, W_INC = W_DN0 + 5 * MiB + 512 * 1024,
                 W_OUTC = W_INC + 8 * MiB, W_EGU = W_OUTC + 2 * MiB, W_EDN = W_EGU + 112 * MiB, W_PPROJ = W_EDN + 56 * MiB, W_PGATE = W_PPROJ + 1 * MiB, W_END = W_PGATE + 4 * MiB;
constexpr size_t WS_PB = W_END;
constexpr size_t WS_XA = WS_PB + 32 * MiB, WS_XB = WS_XA + 64 * MiB;
constexpr size_t WS_R = WS_XB + 64 * MiB;
constexpr size_t R_BYTES = (size_t)MAXP * 256 * EFF * 2;
constexpr size_t WS_END = WS_R + R_BYTES;
constexpr size_t R_Z = 0, R_Y = 160 * MiB, R_MIX = 224 * MiB, R_PP = 288 * MiB, R_HF = 0;
constexpr size_t R_QFIG = 0, R_O = 256 * MiB, R_OG = 384 * MiB, R_MIX1 = 0, R_H = 0, R_PP1 = 0;

constexpr int CW_BAR = 4096;

constexpr int RING_BYTES = 131072;
constexpr int LDSCTL_OFF = RING_BYTES, MISC_OFF = LDSCTL_OFF + 320;
constexpr int LDS_BYTES = 147456;

#define XB_TMO      128
#define XB_XCNT(j)  (256  + 64 * (j))
#define XB_XSUB(j)  (1280 + 64 * (j))
#define XB_XGEN(j)  (2304 + 64 * (j))
#define XB_TOP      3328
#define XB_TOPGEN   3392
#define XCD_BAR_WORDS 3456
#define XB_SPIN_CAP (1u << 18)
__device__ __forceinline__ unsigned xb_ld(unsigned* p)              { return __hip_atomic_load(p, __ATOMIC_RELAXED, __HIP_MEMORY_SCOPE_AGENT); }
__device__ __forceinline__ unsigned xb_add(unsigned* p, unsigned v) { return __hip_atomic_fetch_add(p, v, __ATOMIC_RELAXED, __HIP_MEMORY_SCOPE_AGENT); }
__device__ __forceinline__ unsigned xb_xcc_id() { return (unsigned)__builtin_amdgcn_s_getreg((3 << 11) | 20) & 0xFu; }
#define XB_SPIN(cond, bar) do { unsigned _sp = 0; while (cond) { __builtin_amdgcn_s_sleep(1); \
    if ((++_sp & 255u) == 0u) { if (xb_ld(&(bar)[XB_TMO])) break; if (_sp > XB_SPIN_CAP) { atomicAdd(&(bar)[XB_TMO], 1u); break; } } } } while (0)
struct XcdBarrier { unsigned* bar; unsigned x; volatile LAS unsigned* st; };
__device__ __forceinline__ XcdBarrier xcd_barrier_post(unsigned* bar, volatile LAS unsigned* st) {
    XcdBarrier b; b.bar = bar; b.x = xb_xcc_id(); b.st = st;
    if (threadIdx.x == 0) (void)xb_add(&bar[XB_XCNT(b.x)], 1u);
    return b;
}
__device__ __forceinline__ void xcd_barrier_complete(unsigned* bar, unsigned x, unsigned& nloc, unsigned& nx) {
    const unsigned G = gridDim.x * gridDim.y * gridDim.z;
    unsigned sum, cnt, mine, sp = 0u;
    for (;;) {
        sum = 0u; cnt = 0u; mine = 0u;
#pragma unroll
        for (unsigned j = 0; j < 16; ++j) { const unsigned c = xb_ld(&bar[XB_XCNT(j)]); sum += c; cnt += (c > 0u) ? 1u : 0u; mine = (j == x) ? c : mine; }
        if (sum == G) break;
        __builtin_amdgcn_s_sleep(1);
        if ((++sp & 255u) == 0u) { if (xb_ld(&bar[XB_TMO])) break; if (sp > XB_SPIN_CAP) { atomicAdd(&bar[XB_TMO], 1u); break; } }
    }
    nloc = mine > 0u ? mine : 1u; nx = cnt > 0u ? cnt : 1u;
}
__device__ __forceinline__ void xcd_barrier(const XcdBarrier& b) {
    asm volatile("s_waitcnt vmcnt(0)" ::: "memory");
    __syncthreads();
    if (threadIdx.x == 0) {
        unsigned* bar = b.bar;
        __builtin_amdgcn_s_waitcnt(0);
        unsigned nloc = b.st[0], nx = b.st[1];
        if (nloc == 0u) { xcd_barrier_complete(bar, b.x, nloc, nx); b.st[0] = nloc; b.st[1] = nx; }
        const unsigned old = xb_add(&bar[XB_XSUB(b.x)], 1u);
        const unsigned gen = old / nloc;
        if (old + 1u == (gen + 1u) * nloc) {
            __builtin_amdgcn_fence(__ATOMIC_RELEASE, "agent");
            asm volatile("s_waitcnt vmcnt(0)" ::: "memory");
            const unsigned og = xb_add(&bar[XB_TOP], 1u);
            const unsigned tg = og / nx;
            if (og + 1u == (tg + 1u) * nx) xb_add(&bar[XB_TOPGEN], 1u);
            else XB_SPIN(xb_ld(&bar[XB_TOPGEN]) == tg, bar);
            __builtin_amdgcn_fence(__ATOMIC_ACQUIRE, "agent");
            xb_add(&bar[XB_XGEN(b.x)], 1u);
            asm volatile("s_waitcnt vmcnt(0)" ::: "memory");
        } else {
            XB_SPIN(xb_ld(&bar[XB_XGEN(b.x)]) == gen, bar);
            __builtin_amdgcn_fence(__ATOMIC_ACQUIRE, "agent");
            asm volatile("s_waitcnt vmcnt(0)" ::: "memory");
        }
    }
    __syncthreads();
}

struct Args { const float* in[22]; float* out; unsigned char* ws; int ph_lo, ph_hi, li, pad; };
enum { I_X = 0, I_P, I_NORMG, I_WINAB, I_ALNG, I_ALNB, I_AWS, I_ABS, I_BCONV, I_WOUTAB, I_FFNGU, I_FFNDN, I_WINC, I_LBP, I_ONORMG, I_WOUTC, I_WROUTER, I_BROUTER, I_EGU, I_EDN, I_PPROJ, I_PGATE };

__device__ __forceinline__ void transpose_item(const float* W, int K, int N, bf16_t* WT, const float* gain, int gu_ff, LAS float* scr, int item, int lane) {
    const int nblk = N / 32, kb = item / nblk, nb = item % nblk, k0 = 64 * kb, n0 = 32 * nb;
#pragma unroll 8
    for (int i = 0; i < 32; ++i) { const int kk = 2 * i + (lane >> 5); float w = W[(size_t)(k0 + kk) * N + n0 + (lane & 31)]; if (gain) w *= gain[k0 + kk]; scr[kk * 33 + (lane & 31)] = w; }
    asm volatile("s_waitcnt lgkmcnt(0)" ::: "memory");
    int d0 = n0; if (gu_ff) { const int half = n0 >= gu_ff ? 1 : 0, j = n0 - half * gu_ff; d0 = (j / 128) * 256 + half * 128 + (j % 128); }
    const int c = lane & 7;
#pragma unroll
    for (int j = 0; j < 4; ++j) { const int n = (lane >> 3) + 8 * j; const LAS float* s = scr + (8 * c) * 33 + n;
        u32x4 o; o.x = cvt_pk_bf16(s[0 * 33], s[1 * 33]); o.y = cvt_pk_bf16(s[2 * 33], s[3 * 33]); o.z = cvt_pk_bf16(s[4 * 33], s[5 * 33]); o.w = cvt_pk_bf16(s[6 * 33], s[7 * 33]);
        *(u32x4*)(WT + (size_t)(d0 + n) * K + k0 + 8 * c) = o; }
    asm volatile("s_waitcnt lgkmcnt(0)" ::: "memory");
}

__device__ __forceinline__ void ld_row_bf16(const bf16_t* row, int lane, float (&v)[16]) { unpack8(*(const u32x4*)(row + lane * 8), v); unpack8(*(const u32x4*)(row + 512 + lane * 8), v + 8); }
__device__ __forceinline__ void st_row_bf16(bf16_t* row, int lane, const float (&v)[16]) { *(u32x4*)(row + lane * 8) = pack8(v); *(u32x4*)(row + 512 + lane * 8) = pack8(v + 8); }
__device__ __forceinline__ void ld_row_f32(const float* row, int lane, float (&v)[16]) {
    const f32x4 a = *(const f32x4*)(row + lane * 8), b = *(const f32x4*)(row + lane * 8 + 4), c = *(const f32x4*)(row + 512 + lane * 8), d = *(const f32x4*)(row + 512 + lane * 8 + 4);
#pragma unroll
    for (int j = 0; j < 4; ++j) { v[j] = a[j]; v[4 + j] = b[j]; v[8 + j] = c[j]; v[12 + j] = d[j]; }
}
__device__ __forceinline__ float sumsq16(const float (&v)[16]) { float s = 0.f;
#pragma unroll
    for (int j = 0; j < 16; ++j) s += v[j] * v[j];
    return s; }

__global__ void __launch_bounds__(NTHR, 2) trunk_fwd(Args args) {
    extern __shared__ __attribute__((aligned(16))) unsigned char lds_raw[];
    LAS unsigned char* lds = (LAS unsigned char*)lds_raw;
    volatile LAS unsigned* MISC = (volatile LAS unsigned*)(lds + MISC_OFF);
    const int tid = threadIdx.x, lane = tid & 63, wave = __builtin_amdgcn_readfirstlane(tid >> 6);
    const int G = gridDim.x, bx = blockIdx.x;
    unsigned char* ws = args.ws;
    for (int u = tid; u < (LDS_BYTES - LDSCTL_OFF) / 4; u += NTHR) ((LAS unsigned*)(lds + LDSCTL_OFF))[u] = 0u;
    __syncthreads();
    XcdBarrier bar; bar.bar = (unsigned*)(ws + WS_CTL) + CW_BAR; bar.x = 0; bar.st = nullptr;
    if (MK_N_LAUNCHES == 1) bar = xcd_barrier_post((unsigned*)(ws + WS_CTL) + CW_BAR, MISC + 8);
    const int lo = args.ph_lo, hi = args.ph_hi;
#define IN(k) (lo <= (k) && (k) < hi)
#define SEAM(k) do { if (IN(k) && IN((k) + 1)) xcd_barrier(bar); } while (0)

    const float* normg = args.in[I_NORMG];
    float* rstd0 = (float*)(ws + SM_RSTD0); float* rstd1 = (float*)(ws + SM_RSTD1); float* rstd4 = (float*)(ws + SM_RSTD4);
    float* LB = (float*)(ws + SM_LB); int* route = (int*)(ws + SM_ROUTE); int* cntg = (int*)(ws + SM_CNT); int* meta = (int*)(ws + SM_META);
    int* perm = (int*)(ws + SM_PERM); int* rinfo = (int*)(ws + SM_RINFO); float* ssp = (float*)(ws + SM_SSP);
    bf16_t* XA = (bf16_t*)(ws + WS_XA); bf16_t* XB = (bf16_t*)(ws + WS_XB); bf16_t* PB = (bf16_t*)(ws + WS_PB);
    unsigned char* R = ws + WS_R;
    const int gw = bx * NWAVES + wave, NGW = G * NWAVES;
    const int RPW = M / G;

    if (IN(0)) {
        LAS float* scr = (LAS float*)(lds + wave * 16384);
        constexpr int I1 = 16 * 80, I2 = 16 * 32, I3 = 16 * 176, I4 = 44 * 32, I5 = 16 * 128, I6 = 16 * 32, I7E = 16 * 224, I8E = 56 * 32, I9L = 4 * 32, I10L = 16 * 32;
        constexpr int NITEMS = I1 + I2 + I3 + I4 + I5 + I6 + 8 * I7E + 8 * I8E + 2 * I9L + 2 * I10L;
        for (int it = gw; it < NITEMS; it += NGW) {
            int r = it;
            if (r < I1) { transpose_item(args.in[I_WINAB], D, AB_IN, (bf16_t*)(ws + W_INAB), normg + 0 * D, 0, scr, r, lane); continue; } r -= I1;
            if (r < I2) { transpose_item(args.in[I_WOUTAB], D, D, (bf16_t*)(ws + W_OUTAB), nullptr, 0, scr, r, lane); continue; } r -= I2;
            if (r < I3) { transpose_item(args.in[I_FFNGU], D, 2 * FF, (bf16_t*)(ws + W_GU0), normg + 2 * D, FF, scr, r, lane); continue; } r -= I3;
            if (r < I4) { transpose_item(args.in[I_FFNDN], FF, D, (bf16_t*)(ws + W_DN0), nullptr, 0, scr, r, lane); continue; } r -= I4;
            if (r < I5) { transpose_item(args.in[I_WINC], D, 4 * CW, (bf16_t*)(ws + W_INC), normg + 4 * D, 0, scr, r, lane); continue; } r -= I5;
            if (r < I6) { transpose_item(args.in[I_WOUTC], CW, D, (bf16_t*)(ws + W_OUTC), nullptr, 0, scr, r, lane); continue; } r -= I6;
            if (r < 8 * I7E) { const int e = r / I7E; transpose_item(args.in[I_EGU] + (size_t)e * D * 2 * EFF, D, 2 * EFF, (bf16_t*)(ws + W_EGU) + (size_t)e * 2 * EFF * D, normg + 6 * D, EFF, scr, r % I7E, lane); continue; } r -= 8 * I7E;
            if (r < 8 * I8E) { const int e = r / I8E; transpose_item(args.in[I_EDN] + (size_t)e * EFF * D, EFF, D, (bf16_t*)(ws + W_EDN) + (size_t)e * D * EFF, nullptr, 0, scr, r % I8E, lane); continue; } r -= 8 * I8E;
            if (r < 2 * I9L) { const int l = r / I9L; transpose_item(args.in[I_PPROJ] + (size_t)l * PLE * D, PLE, D, (bf16_t*)(ws + W_PPROJ) + (size_t)l * D * PLE, nullptr, 0, scr, r % I9L, lane); continue; } r -= 2 * I9L;
            { const int l = r / I10L; transpose_item(args.in[I_PGATE] + (size_t)l * D * D, D, D, (bf16_t*)(ws + W_PGATE) + (size_t)l * D * D, nullptr, 0, scr, r % I10L, lane); }
        }
        for (int m = gw; m < M; m += NGW) { float v[16]; ld_row_f32(args.in[I_X] + (size_t)m * D, lane, v);
            const float ss = wave_sum(sumsq16(v)); st_row_bf16(XA + (size_t)m * D, lane, v); if (lane == 0) rstd0[m] = __builtin_amdgcn_rsqf(ss * (1.0f / D) + EPS); }
        { const float* p = args.in[I_P]; const size_t n8 = (size_t)2 * M * PLE / 8;
          for (size_t i = (size_t)bx * NTHR + tid; i < n8; i += (size_t)G * NTHR) { const f32x4 a = *(const f32x4*)(p + i * 8), b = *(const f32x4*)(p + i * 8 + 4);
              float v[8] = {a[0], a[1], a[2], a[3], b[0], b[1], b[2], b[3]}; *(u32x4*)(PB + i * 8) = pack8(v); } }
        if (bx == 0) for (int c = tid; c < CW; c += NTHR) { const float d = args.in[I_LBP][CW + c] - args.in[I_LBP][c]; LB[c] = 1.0f / (1.0f + expf(-d)); }
    }
    SEAM(0);

    if (IN(1)) { pg8::StaticOrder S; S.init(XA, (const bf16_t*)(ws + W_INAB), M, AB_IN, D, G, bx); pg8::EpiInAB E{(bf16_t*)(R + R_Z), rstd0};
        pg8::gemm_phase<pg8::EpiInAB, pg8::StaticOrder, false>(lds, D, S, E); }
    SEAM(1);

    if (IN(2)) {
        const bf16_t* Z = (const bf16_t*)(R + R_Z); bf16_t* Y = (bf16_t*)(R + R_Y);
        LAS float* vln = (LAS float*)lds;
        LAS float* wt = (LAS float*)(lds + 32768);
        for (int blk = bx; blk < M / 128; blk += G) {
            const int t0 = blk * 128;
            for (int h = 0; h < 8; ++h) {
                { const float* Wh = args.in[I_AWS] + (size_t)h * 128 * 128;
                  for (int e = tid; e < 128 * 128; e += NTHR) { const int i = e >> 7, j = e & 127; float w = Wh[e]; if ((j >> 6) > (i >> 6)) w = 0.f; wt[j * 128 + i] = w; } }
                { const int row = tid >> 2, dq = tid & 3; const bf16_t* vp = Z + (size_t)(t0 + row) * AB_IN + 512 + h * 64 + dq * 16; float v[16];
                  unpack8(*(const u32x4*)vp, v); unpack8(*(const u32x4*)(vp + 8), v + 8);
                  float s = 0.f;
#pragma unroll
                  for (int j = 0; j < 16; ++j) s += v[j];
                  s += __shfl_xor(s, 1); s += __shfl_xor(s, 2); const float mu = s * (1.0f / 64.0f); float q = 0.f;
#pragma unroll
                  for (int j = 0; j < 16; ++j) { v[j] -= mu; q += v[j] * v[j]; }
                  q += __shfl_xor(q, 1); q += __shfl_xor(q, 2); const float rs = __builtin_amdgcn_rsqf(q * (1.0f / 64.0f) + EPS);
#pragma unroll
                  for (int j = 0; j < 16; ++j) { const int c = h * 64 + dq * 16 + j; vln[row * 64 + dq * 16 + j] = v[j] * rs * args.in[I_ALNG][c] + args.in[I_ALNB][c]; } }
                __syncthreads();
                { const int d = tid & 63, ig = wave; const int jmax = ig < 4 ? 64 : 128; float a[16];
#pragma unroll
                  for (int ii = 0; ii < 16; ++ii) a[ii] = 0.f;
                  for (int j = 0; j < jmax; ++j) { const float vj = vln[j * 64 + d]; const LAS f32x4* wp = (const LAS f32x4*)(wt + j * 128 + ig * 16);
                      const f32x4 w0 = wp[0], w1 = wp[1], w2 = wp[2], w3 = wp[3];
#pragma unroll
                      for (int ii = 0; ii < 4; ++ii) { a[ii] += w0[ii] * vj; a[4 + ii] += w1[ii] * vj; a[8 + ii] += w2[ii] * vj; a[12 + ii] += w3[ii] * vj; } }
#pragma unroll
                  for (int ii = 0; ii < 16; ++ii) { const int i = ig * 16 + ii; const float f = a[ii] + args.in[I_ABS][h * 128 + i];
                      const float uu = bf2f(Z[(size_t)(t0 + i) * AB_IN + h * 64 + d]); Y[(size_t)(t0 + i) * D + h * 64 + d] = f2bf(uu * f); } }
                __syncthreads();
            }
            { const int c = tid; const float w0 = args.in[I_BCONV][c], w1 = args.in[I_BCONV][512 + c], w2 = args.in[I_BCONV][1024 + c];
              float p2 = 0.f, p1 = 0.f;
              if ((t0 % SEQ) != 0) { const bf16_t* z2 = Z + (size_t)(t0 - 2) * AB_IN; const bf16_t* z1 = Z + (size_t)(t0 - 1) * AB_IN;
                  p2 = bf2f(z2[1536 + c]) * bf2f(z2[1024 + c]); p1 = bf2f(z1[1536 + c]) * bf2f(z1[1024 + c]); }
              for (int t = 0; t < 128; ++t) { const bf16_t* z = Z + (size_t)(t0 + t) * AB_IN; const float p0 = bf2f(z[1536 + c]) * bf2f(z[1024 + c]);
                  Y[(size_t)(t0 + t) * D + 512 + c] = f2bf(bf2f(z[2048 + c]) * (w0 * p2 + w1 * p1 + w2 * p0)); p2 = p1; p1 = p0; } }
        }
    }
    SEAM(2);

    if (IN(3)) { pg8::StaticOrder S; S.init((const bf16_t*)(R + R_Y), (const bf16_t*)(ws + W_OUTAB), M, D, D, G, bx); pg8::EpiPlain E{(bf16_t*)(R + R_MIX), D};
        pg8::gemm_phase<pg8::EpiPlain, pg8::StaticOrder, false>(lds, D, S, E); }
    SEAM(3);

    if (IN(4)) { const bf16_t* MIX = (const bf16_t*)(R + R_MIX); float g[16]; ld_row_f32(normg + 1 * D, lane, g);
        for (int i = 0; i < RPW / NWAVES; ++i) { const int m = bx * RPW + wave * (RPW / NWAVES) + i; float mx[16], x[16]; ld_row_bf16(MIX + (size_t)m * D, lane, mx); ld_row_bf16(XA + (size_t)m * D, lane, x);
            const float rm = __builtin_amdgcn_rsqf(wave_sum(sumsq16(mx)) * (1.0f / D) + EPS);
#pragma unroll
            for (int j = 0; j < 16; ++j) x[j] += g[j] * mx[j] * rm;
            const float ss = wave_sum(sumsq16(x)); st_row_bf16(XB + (size_t)m * D, lane, x); if (lane == 0) rstd1[m] = __builtin_amdgcn_rsqf(ss * (1.0f / D) + EPS); } }
    SEAM(4);

    if (IN(5)) { pg8::StaticOrder S; S.init(XB, (const bf16_t*)(ws + W_GU0), M, 2 * FF, D, G, bx); pg8::EpiSwiGLU<false> E{(bf16_t*)(R + R_HF), FF, rstd1, nullptr};
        pg8::gemm_phase<pg8::EpiSwiGLU<false>, pg8::StaticOrder, false>(lds, D, S, E); }
    SEAM(5);

    if (IN(6)) { pg8::StaticOrder S; S.init((const bf16_t*)(R + R_HF), (const bf16_t*)(ws + W_DN0), M, D, FF, G, bx); pg8::EpiPlain E{(bf16_t*)(R + R_MIX), D};
        pg8::gemm_phase<pg8::EpiPlain, pg8::StaticOrder, false>(lds, FF, S, E); }
    SEAM(6);

    if (IN(7)) { const bf16_t* MIX = (const bf16_t*)(R + R_MIX); float g[16]; ld_row_f32(normg + 3 * D, lane, g);
        for (int i = 0; i < RPW / NWAVES; ++i) { const int m = bx * RPW + wave * (RPW / NWAVES) + i; float mx[16], x[16]; ld_row_bf16(MIX + (size_t)m * D, lane, mx); ld_row_bf16(XB + (size_t)m * D, lane, x);
            const float rm = __builtin_amdgcn_rsqf(wave_sum(sumsq16(mx)) * (1.0f / D) + EPS);
#pragma unroll
            for (int j = 0; j < 16; ++j) x[j] += g[j] * mx[j] * rm;
            st_row_bf16(XA + (size_t)m * D, lane, x); } }
    SEAM(7);

    if (IN(8)) { pg8::StaticOrder S; S.init(PB, (const bf16_t*)(ws + W_PPROJ), M, D, PLE, G, bx); pg8::EpiPlain E{(bf16_t*)(R + R_PP), D};
        pg8::gemm_phase<pg8::EpiPlain, pg8::StaticOrder, false>(lds, PLE, S, E); }
    SEAM(8);

    if (IN(9)) { pg8::StaticOrder S; S.init(XA, (const bf16_t*)(ws + W_PGATE), M, D, D, G, bx); pg8::EpiPleGate<false> E{XA, (const bf16_t*)(R + R_PP), XB, ssp, nullptr};
        pg8::gemm_phase<pg8::EpiPleGate<false>, pg8::StaticOrder, false>(lds, D, S, E); }
    SEAM(9);

    if (IN(10)) { pg8::StaticOrder S; S.init(XB, (const bf16_t*)(ws + W_INC), M, 4 * CW, D, G, bx); pg8::EpiInC E{(bf16_t*)(R + R_QFIG), ssp, LB};
        pg8::gemm_phase<pg8::EpiInC, pg8::StaticOrder, false>(lds, D, S, E); }
    SEAM(10);

    if (IN(11)) {
        const bf16_t* Qb = (const bf16_t*)(R + R_QFIG); const bf16_t* Fb = Qb + (size_t)M * CW; const bf16_t* Ib = Fb + (size_t)M * CW; float* O = (float*)(R + R_O);
        LAS float* red = (LAS float*)lds;
        constexpr int TB = 16;
        for (int item = bx; item < BATCH * 8 * 8; item += G) {
            const int b = item >> 6, h = (item >> 3) & 7, vq = item & 7; const int v = tid & 15, kg = tid >> 4;
            const size_t rowb = (size_t)b * SEQ; const int colk = h * 128 + kg * 4, colv = h * 128 + vq * 16 + v;
            float s[4] = {0.f, 0.f, 0.f, 0.f};
            u32x2 cf[TB], cq[TB]; bf16_t ci[TB];
#pragma unroll
            for (int t = 0; t < TB; ++t) { const size_t r = rowb + t; cf[t] = *(const u32x2*)(Fb + r * CW + colk); cq[t] = *(const u32x2*)(Qb + r * CW + colk); ci[t] = Ib[r * CW + colv]; }
            for (int tb = 0; tb < SEQ / TB; ++tb) {
                u32x2 nf[TB], nq[TB]; bf16_t ni[TB];
                const int tn = (tb + 1 < SEQ / TB) ? (tb + 1) * TB : tb * TB;
#pragma unroll
                for (int t = 0; t < TB; ++t) { const size_t r = rowb + tn + t; nf[t] = *(const u32x2*)(Fb + r * CW + colk); nq[t] = *(const u32x2*)(Qb + r * CW + colk); ni[t] = Ib[r * CW + colv]; }
                float part[TB];
#pragma unroll
                for (int t = 0; t < TB; ++t) { const float iv = bf2f(ci[t]);
                    const float f0 = __builtin_amdgcn_exp2f(bflo(cf[t].x)), f1 = __builtin_amdgcn_exp2f(bfhi(cf[t].x)), f2 = __builtin_amdgcn_exp2f(bflo(cf[t].y)), f3 = __builtin_amdgcn_exp2f(bfhi(cf[t].y));
                    s[0] = f0 * s[0] + (1.0f - f0) * iv; s[1] = f1 * s[1] + (1.0f - f1) * iv; s[2] = f2 * s[2] + (1.0f - f2) * iv; s[3] = f3 * s[3] + (1.0f - f3) * iv;
                    float p = bflo(cq[t].x) * s[0] + bfhi(cq[t].x) * s[1] + bflo(cq[t].y) * s[2] + bfhi(cq[t].y) * s[3];
                    p += __shfl_xor(p, 16); p += __shfl_xor(p, 32); part[t] = p; }
                LAS float* rb = red + (tb & 1) * 2048;
                if (lane < 16) {
#pragma unroll
                    for (int t = 0; t < TB; ++t) rb[wave * 256 + t * 16 + lane] = part[t]; }
                __syncthreads();
                if (tid < 256) { float o = 0.f;
#pragma unroll
                    for (int w = 0; w < 8; ++w) o += rb[w * 256 + tid];
                    O[(rowb + tb * TB + (tid >> 4)) * CW + h * 128 + vq * 16 + (tid & 15)] = o; }
#pragma unroll
                for (int t = 0; t < TB; ++t) { cf[t] = nf[t]; cq[t] = nq[t]; ci[t] = ni[t]; }
            }
            __syncthreads();
        }
    }
    SEAM(11);

    if (IN(12)) { const float* O = (const float*)(R + R_O); const bf16_t* Gb = (const bf16_t*)(R + R_QFIG) + (size_t)3 * M * CW; bf16_t* OG = (bf16_t*)(R + R_OG); float g[16]; ld_row_f32(args.in[I_ONORMG], lane, g);
        for (int i = 0; i < RPW / NWAVES; ++i) { const int m = bx * RPW + wave * (RPW / NWAVES) + i; float o[16], gg[16]; ld_row_f32(O + (size_t)m * CW, lane, o); ld_row_bf16(Gb + (size_t)m * CW, lane, gg);
            float s0 = 0.f, s1 = 0.f;
#pragma unroll
            for (int j = 0; j < 8; ++j) { s0 += o[j] * o[j]; s1 += o[8 + j] * o[8 + j]; }
#pragma unroll
            for (int sh = 1; sh < 16; sh <<= 1) { s0 += __shfl_xor(s0, sh); s1 += __shfl_xor(s1, sh); }
            const float r0 = __builtin_amdgcn_rsqf(s0 * (1.0f / 128.0f) + EPS), r1 = __builtin_amdgcn_rsqf(s1 * (1.0f / 128.0f) + EPS);
#pragma unroll
            for (int j = 0; j < 8; ++j) { o[j] = o[j] * r0 * g[j] * gg[j]; o[8 + j] = o[8 + j] * r1 * g[8 + j] * gg[8 + j]; }
            st_row_bf16(OG + (size_t)m * CW, lane, o); } }
    SEAM(12);

    if (IN(13)) { pg8::StaticOrder S; S.init((const bf16_t*)(R + R_OG), (const bf16_t*)(ws + W_OUTC), M, D, CW, G, bx); pg8::EpiPlain E{(bf16_t*)(R + R_MIX1), D};
        pg8::gemm_phase<pg8::EpiPlain, pg8::StaticOrder, false>(lds, CW, S, E); }
    SEAM(13);

    if (IN(14)) { const bf16_t* MIX = (const bf16_t*)(R + R_MIX1); float g[16], g2[16]; ld_row_f32(normg + 5 * D, lane, g); ld_row_f32(normg + 6 * D, lane, g2);
        LAS float* wrl = (LAS float*)lds;
        LAS int* lcnt = (LAS int*)(lds + 32768);
        for (int e = tid; e < D * NE; e += NTHR) wrl[e] = args.in[I_WROUTER][e];
        if (tid < NE) lcnt[tid] = 0;
        __syncthreads();
        for (int i = 0; i < RPW / NWAVES; ++i) { const int m = bx * RPW + wave * (RPW / NWAVES) + i; float mx[16], x[16]; ld_row_bf16(MIX + (size_t)m * D, lane, mx); ld_row_bf16(XB + (size_t)m * D, lane, x);
            const float rm = __builtin_amdgcn_rsqf(wave_sum(sumsq16(mx)) * (1.0f / D) + EPS);
#pragma unroll
            for (int j = 0; j < 16; ++j) x[j] += g[j] * mx[j] * rm;
            const float rs = __builtin_amdgcn_rsqf(wave_sum(sumsq16(x)) * (1.0f / D) + EPS);
            st_row_bf16(XA + (size_t)m * D, lane, x); if (lane == 0) rstd4[m] = rs;
            float lg[NE];
#pragma unroll
            for (int e = 0; e < NE; ++e) lg[e] = 0.f;
#pragma unroll
            for (int j = 0; j < 16; ++j) { const int col = (j < 8 ? 0 : 512) + lane * 8 + (j & 7); const float hn = x[j] * rs * g2[j];
                const LAS f32x4* wp = (const LAS f32x4*)(wrl + col * NE); const f32x4 w0 = wp[0], w1 = wp[1];
#pragma unroll
                for (int e = 0; e < 4; ++e) { lg[e] += hn * w0[e]; lg[4 + e] += hn * w1[e]; } }
#pragma unroll
            for (int e = 0; e < NE; ++e) lg[e] = wave_sum(lg[e]) + args.in[I_BROUTER][e];
            if (lane == 0) { int e1 = 0; float l1 = lg[0];
#pragma unroll
                for (int e = 1; e < NE; ++e) if (lg[e] > l1) { l1 = lg[e]; e1 = e; }
                int e2 = -1; float l2 = -3.0e38f;
#pragma unroll
                for (int e = 0; e < NE; ++e) if (e != e1 && lg[e] > l2) { l2 = lg[e]; e2 = e; }
                const float ex = expf(l2 - l1), w1 = 1.0f / (1.0f + ex), w2 = ex / (1.0f + ex);
                *(i32x4*)(route + (size_t)m * 4) = (i32x4){e1, e2, __float_as_int(w1), __float_as_int(w2)};
                atomicAdd((int*)(lcnt + e1), 1); atomicAdd((int*)(lcnt + e2), 1); } }
        __syncthreads();
        if (tid < NE) cntg[bx * NE + tid] = lcnt[tid];
    }
    SEAM(14);

    if (IN(15)) {
        LAS int* lc = (LAS int*)lds;
        LAS int* tot = (LAS int*)(lds + 32768);
        for (int e = tid; e < G * NE; e += NTHR) lc[e] = cntg[e];
        __syncthreads();
        if (tid < NE) { int t = 0, pre = 0; for (int w = 0; w < G; ++w) { if (w == bx) pre = t; t += lc[w * NE + tid]; } tot[tid] = t; tot[8 + tid] = pre; }
        __syncthreads();
        if (tid == 0) { int b = 0; for (int e = 0; e < NE; ++e) { tot[16 + e] = b; b += (tot[e] + 255) & ~255; } tot[24] = b; }
        __syncthreads();
        if (wave == 0) { int run[NE];
#pragma unroll
            for (int e = 0; e < NE; ++e) run[e] = 0;
            for (int it = 0; it < RPW / 64; ++it) { const int m = bx * RPW + it * 64 + lane; const i32x4 rt = *(const i32x4*)(route + (size_t)m * 4);
                const unsigned long long lt = (1ull << lane) - 1ull;
#pragma unroll
                for (int e = 0; e < NE; ++e) { const bool has = (rt[0] == e) || (rt[1] == e); const unsigned long long mask = __ballot(has);
                    if (has) { const int pos = tot[16 + e] + tot[8 + e] + run[e] + __popcll(mask & lt); const int slot = (rt[1] == e) ? 1 : 0;
                        perm[pos] = m; rinfo[2 * pos] = m * 2 + slot; rinfo[2 * pos + 1] = slot ? rt[3] : rt[2]; }
                    run[e] += __popcll(mask); } } }
        if (bx < NE) { const int e = bx; const int beg = tot[16 + e] + tot[e], end = tot[16 + e] + ((tot[e] + 255) & ~255);
            for (int p = beg + tid; p < end; p += NTHR) { perm[p] = 0; rinfo[2 * p] = -1; rinfo[2 * p + 1] = 0; } }
        if (bx == 0) { if (tid == 0) meta[0] = tot[24] / 256;
            for (int p = tid; p < tot[24] / 256; p += NTHR) { int e = 0;
#pragma unroll
                for (int k = 1; k < NE; ++k) if (p * 256 >= tot[16 + k]) e = k;
                meta[16 + p] = e; } }
        __syncthreads();
    }
    SEAM(15);

    if (IN(16)) { const int nP = __builtin_amdgcn_readfirstlane(meta[0]);
        pg8::MoeOrder<true> S; S.init(XA, (const bf16_t*)(ws + W_EGU), nP, 2 * EFF, D, G, bx, meta + 16, perm); pg8::EpiSwiGLU<true> E{(bf16_t*)(R + R_H), EFF, rstd4, perm};
        pg8::gemm_phase<pg8::EpiSwiGLU<true>, pg8::MoeOrder<true>, true>(lds, D, S, E); }
    SEAM(16);

    if (IN(17)) { const int nP = __builtin_amdgcn_readfirstlane(meta[0]);
        pg8::MoeOrder<false> S; S.init((const bf16_t*)(R + R_H), (const bf16_t*)(ws + W_EDN), nP, D, EFF, G, bx, meta + 16, perm); pg8::EpiMoeDown E{rinfo, (bf16_t*)args.out};
        pg8::gemm_phase<pg8::EpiMoeDown, pg8::MoeOrder<false>, false>(lds, EFF, S, E); }
    SEAM(17);

    if (IN(18)) { const bf16_t* S0 = (const bf16_t*)args.out; const bf16_t* S1 = S0 + (size_t)M * D; float g[16]; ld_row_f32(normg + 7 * D, lane, g);
        for (int i = 0; i < RPW / NWAVES; ++i) { const int m = bx * RPW + wave * (RPW / NWAVES) + i; float mx[16], m2[16], x[16]; ld_row_bf16(S0 + (size_t)m * D, lane, mx); ld_row_bf16(S1 + (size_t)m * D, lane, m2); ld_row_bf16(XA + (size_t)m * D, lane, x);
#pragma unroll
            for (int j = 0; j < 16; ++j) mx[j] += m2[j];
            const float rm = __builtin_amdgcn_rsqf(wave_sum(sumsq16(mx)) * (1.0f / D) + EPS);
#pragma unroll
            for (int j = 0; j < 16; ++j) x[j] += g[j] * mx[j] * rm;
            st_row_bf16(XB + (size_t)m * D, lane, x); } }
    SEAM(18);

    if (IN(19)) { pg8::StaticOrder S; S.init(PB + (size_t)M * PLE, (const bf16_t*)(ws + W_PPROJ) + (size_t)D * PLE, M, D, PLE, G, bx); pg8::EpiPlain E{(bf16_t*)(R + R_PP1), D};
        pg8::gemm_phase<pg8::EpiPlain, pg8::StaticOrder, false>(lds, PLE, S, E); }
    SEAM(19);

    if (IN(20)) { pg8::StaticOrder S; S.init(XB, (const bf16_t*)(ws + W_PGATE) + (size_t)D * D, M, D, D, G, bx); pg8::EpiPleGate<true> E{XB, (const bf16_t*)(R + R_PP1), nullptr, nullptr, args.out};
        pg8::gemm_phase<pg8::EpiPleGate<true>, pg8::StaticOrder, false>(lds, D, S, E); }
#undef IN
#undef SEAM
}

constexpr int N_PHASES = 21;
extern "C" void kernel_launch(void* const* d_in, const int* in_sizes, int n_in, void* d_out, int out_size, void* d_ws, size_t ws_size, hipStream_t stream) {
    static int grid = 0;
    if (grid == 0) {
        if (n_in != 22 || in_sizes[0] != M * D || out_size != M * D || ws_size < WS_END) { fprintf(stderr, "kernel_launch: unexpected shapes (n_in %d, in0 %d, out %d, ws %zu < %zu); nothing launched\n", n_in, n_in > 0 ? in_sizes[0] : -1, out_size, ws_size, (size_t)WS_END); grid = -1; return; }
        int dev = 0, cus = 0, per_cu = 0;
        if (hipGetDevice(&dev) != hipSuccess || hipDeviceGetAttribute(&cus, hipDeviceAttributeMultiprocessorCount, dev) != hipSuccess) { grid = -1; return; }
        if (hipFuncSetAttribute((const void*)trunk_fwd, hipFuncAttributeMaxDynamicSharedMemorySize, LDS_BYTES) != hipSuccess) { fprintf(stderr, "kernel_launch: hipFuncSetAttribute failed\n"); grid = -1; return; }
        if (hipOccupancyMaxActiveBlocksPerMultiprocessor(&per_cu, (const void*)trunk_fwd, NTHR, LDS_BYTES) != hipSuccess || per_cu < 1) { fprintf(stderr, "kernel_launch: occupancy query reports %d workgroups per CU\n", per_cu); }
        (void)hipGetLastError();
        grid = cus;
        if (grid > 1024 || (M % (grid * NWAVES)) != 0 || ((M / grid) % 64) != 0) { fprintf(stderr, "kernel_launch: unsupported CU count %d\n", grid); grid = -1; return; }
    }
    if (grid < 0) return;
    if (hipMemsetAsync((char*)d_ws + WS_CTL, 0, CTL_ZERO_BYTES, stream) != hipSuccess) return;
    Args a{};
    for (int i = 0; i < 22; ++i) a.in[i] = (const float*)d_in[i];
    a.out = (float*)d_out; a.ws = (unsigned char*)d_ws; a.pad = 0;
    if (MK_N_LAUNCHES == 1) { a.ph_lo = 0; a.ph_hi = N_PHASES; a.li = 0; hipLaunchKernelGGL(trunk_fwd, dim3(grid), dim3(NTHR), LDS_BYTES, stream, a); }
    else for (int ph = 0; ph < N_PHASES; ++ph) { a.ph_lo = ph; a.ph_hi = ph + 1; a.li = ph; hipLaunchKernelGGL(trunk_fwd, dim3(grid), dim3(NTHR), LDS_BYTES, stream, a); }
}
```

```cpp
#include <hip/hip_runtime.h>
#include <cstdio>
#include <cstdint>

#ifndef MK_N_LAUNCHES
#define MK_N_LAUNCHES 1
#endif

#ifndef PROBE_REP
#define PROBE_REP 0u
#endif
#define NREP(k) (1 + (int)((PROBE_REP >> (k)) & 1u))
#define GAS __attribute__((address_space(1)))
#define LAS __attribute__((address_space(3)))
typedef unsigned short bf16_t;
typedef short bf16x8 __attribute__((ext_vector_type(8)));
typedef float f32x4 __attribute__((ext_vector_type(4)));
typedef float f32x2 __attribute__((ext_vector_type(2)));
typedef unsigned u32x4 __attribute__((ext_vector_type(4)));
typedef unsigned u32x2 __attribute__((ext_vector_type(2)));
typedef int i32x4 __attribute__((ext_vector_type(4)));

constexpr int D = 1024, BATCH = 4, SEQ = 8192, M = BATCH * SEQ;
constexpr int PLE = 256, AB_IN = 2560, FF = 2816, CW = 1024, NE = 8, EFF = 3584;
constexpr float EPS = 1e-6f;
constexpr int NWAVES = 8, NTHR = 512;
constexpr int MAXP = 264;

__device__ __forceinline__ float bflo(unsigned w) { return __uint_as_float(w << 16); }
__device__ __forceinline__ float bfhi(unsigned w) { return __uint_as_float(w & 0xffff0000u); }
__device__ __forceinline__ float bf2f(bf16_t b) { return __uint_as_float((unsigned)b << 16); }
__device__ __forceinline__ unsigned cvt_pk_bf16(float lo, float hi) { unsigned r; asm volatile("v_cvt_pk_bf16_f32 %0, %1, %2" : "=v"(r) : "v"(lo), "v"(hi)); return r; }
__device__ __forceinline__ bf16_t f2bf(float f) { return (bf16_t)(cvt_pk_bf16(f, 0.f) & 0xffffu); }
__device__ __forceinline__ float fsigmoid(float x) { return __builtin_amdgcn_rcpf(1.0f + __builtin_amdgcn_exp2f(-1.4426950408889634f * x)); }
__device__ __forceinline__ float fsilu(float x) { return x * fsigmoid(x); }
__device__ __forceinline__ float fgelu_tanh(float x) { const float u = x + 0.044715f * x * x * x; return x * __builtin_amdgcn_rcpf(1.0f + __builtin_amdgcn_exp2f(-2.3022082f * u)); }
__device__ __forceinline__ float wave_sum(float v) {
#pragma unroll
    for (int o = 1; o < 64; o <<= 1) v += __shfl_xor(v, o);
    return v;
}
__device__ __forceinline__ void unpack8(const u32x4 a, float* v) { v[0] = bflo(a.x); v[1] = bfhi(a.x); v[2] = bflo(a.y); v[3] = bfhi(a.y); v[4] = bflo(a.z); v[5] = bfhi(a.z); v[6] = bflo(a.w); v[7] = bfhi(a.w); }
__device__ __forceinline__ u32x4 pack8(const float* v) { u32x4 w; w.x = cvt_pk_bf16(v[0], v[1]); w.y = cvt_pk_bf16(v[2], v[3]); w.z = cvt_pk_bf16(v[4], v[5]); w.w = cvt_pk_bf16(v[6], v[7]); return w; }

namespace pg8 {
constexpr int BM = 256, BK = 64, HALF = 128, HTB = HALF * BK * 2, STAGE_BYTES = 8 * HTB, NXCD = 8, WGM = 8;
__host__ __device__ __forceinline__ int lds_byte(int r, int c) { const int st = (r >> 4) * 2 + (c >> 5), rr = r & 15, cc = c & 31, ob = rr * 64 + cc * 2; return st * 1024 + (ob ^ (((ob >> 9) & 1) << 5)); }
__host__ __device__ __forceinline__ void stage_rc(int b, int& R, int& C) { const int st = b / 1024, sb = b % 1024, swz = sb ^ (((sb >> 9) & 1) << 5); R = (st >> 1) * 16 + swz / 64; C = (st & 1) * 32 + (swz % 64) / 2; }
__host__ __device__ __forceinline__ int perm32(int rho) { const int n = rho >> 4, i = rho & 15; return 8 * (i >> 2) + 4 * n + (i & 3); }

struct Unit { int pm, pn; const char* a; const char* b; };

__device__ __forceinline__ bool tile_of(int i, int G, int c, int nM, int nN, int& pm, int& pn) {
    const int nwg = nM * nN; const long L = (long)i * G + c; if (L >= nwg) return false;
    int wgid = (int)L; { const int q = nwg / NXCD, r = nwg % NXCD, xcd = wgid % NXCD, off = wgid / NXCD; wgid = (xcd < r ? xcd * (q + 1) : r * (q + 1) + (xcd - r) * q) + off; }
    const int nig = WGM * nN, gid = wgid / nig, fm = gid * WGM, gsz = (nM - fm) < WGM ? (nM - fm) : WGM;
    pm = fm + ((wgid % nig) % gsz); pn = (wgid % nig) / gsz; return true;
}
struct StaticOrder {
    int nM, nN, G, c; const char* A; const char* Bt; size_t tstep;
    __device__ __forceinline__ void init(const bf16_t* A_, const bf16_t* Bt_, int M_, int N_, int K_, int G_, int c_) { nM = M_ / BM; nN = N_ / BM; G = G_; c = c_; A = (const char*)A_; Bt = (const char*)Bt_; tstep = (size_t)BM * K_ * 2; }
    __device__ __forceinline__ bool next(int i, Unit& u) const { if (!tile_of(i, G, c, nM, nN, u.pm, u.pn)) return false; u.a = A + (size_t)u.pm * tstep; u.b = Bt + (size_t)u.pn * tstep; return true; }
    __device__ __forceinline__ int gather_tok(const Unit&, int) const { return 0; }
};
template <bool GATHER> struct MoeOrder {
    int nM, nN, G, c; const char* A; const char* Bt; size_t tstep, estride; const int* pexp; const int* perm;
    __device__ __forceinline__ void init(const bf16_t* A_, const bf16_t* Bt_, int nM_, int N_, int K_, int G_, int c_, const int* pexp_, const int* perm_) {
        nM = nM_; nN = N_ / BM; G = G_; c = c_; A = (const char*)A_; Bt = (const char*)Bt_; tstep = (size_t)BM * K_ * 2; estride = (size_t)N_ * K_ * 2; pexp = pexp_; perm = perm_; }
    __device__ __forceinline__ bool next(int i, Unit& u) const { if (!tile_of(i, G, c, nM, nN, u.pm, u.pn)) return false;
        const int e = __builtin_amdgcn_readfirstlane(pexp[u.pm]); u.a = GATHER ? A : A + (size_t)u.pm * tstep; u.b = Bt + (size_t)e * estride + (size_t)u.pn * tstep; return true; }
    __device__ __forceinline__ int gather_tok(const Unit& u, int r) const { return perm[u.pm * BM + r]; }
};

template <class Epi, class Sched, bool GATHER>
__device__ __forceinline__ void gemm_phase(LAS unsigned char* lds, const int K, const Sched& S, const Epi& E) {
    const int tid = threadIdx.x, wid = __builtin_amdgcn_readfirstlane(tid >> 6), lane = tid & 63, wr = wid >> 2, wc = wid & 3, fr = lane & 15, fq = lane >> 4;
    const int nt = K / BK;
    const size_t kstep = (size_t)(BK * 2);
    const size_t hstep = (size_t)HALF * K * 2;
    unsigned voffB[2]; int sR[2], sC[2];
#pragma unroll
    for (int i = 0; i < 2; ++i) { int R, C; stage_rc(tid * 16 + i * 8192, R, C); const int Rb = (R & ~31) + perm32(R & 31); sR[i] = R; sC[i] = C; voffB[i] = (unsigned)(Rb * K + C) * 2u; }
    const unsigned ldsw = (unsigned)wid * 1024u;
    const int aoff = lds_byte(wr * 64 + fr, fq * 8), boff = lds_byte(wc * 32 + fr, fq * 8);
#define PG8_SA(b, h) (((b) * 2 + (h)) * HTB)
#define PG8_SB(b, h) ((4 + (b) * 2 + (h)) * HTB)
#define PG8_STAGE_B(bufoff, gbase) do { _Pragma("unroll") for (int _i = 0; _i < 2; ++_i) \
        __builtin_amdgcn_global_load_lds((const unsigned*)((const char*)(gbase) + voffB[_i]), (LAS unsigned*)(lds + (bufoff) + ldsw + _i * 8192), 16, 0, 0); } while (0)
#define PG8_STAGE_A(bufoff, gbase, off, h) do { _Pragma("unroll") for (int _i = 0; _i < 2; ++_i) \
        __builtin_amdgcn_global_load_lds((const unsigned*)((const char*)(gbase) + (off)[h][_i]), (LAS unsigned*)(lds + (bufoff) + ldsw + _i * 8192), 16, 0, 0); } while (0)
#define PG8_LDA(dst, b, h) do { _Pragma("unroll") for (int m = 0; m < 4; ++m) _Pragma("unroll") for (int k = 0; k < 2; ++k) dst[m][k] = *(const LAS bf16x8*)(lds + PG8_SA(b, h) + aoff + m * 2048 + k * 1024); } while (0)
#define PG8_LDB(dst, b, h) do { _Pragma("unroll") for (int n = 0; n < 2; ++n) _Pragma("unroll") for (int k = 0; k < 2; ++k) dst[n][k] = *(const LAS bf16x8*)(lds + PG8_SB(b, h) + boff + n * 2048 + k * 1024); } while (0)
#define PG8_MMA(ai, bj, At, Bt) do { __builtin_amdgcn_s_setprio(1); _Pragma("unroll") for (int m = 0; m < 4; ++m) _Pragma("unroll") for (int n = 0; n < 2; ++n) _Pragma("unroll") for (int k = 0; k < 2; ++k) \
        acc[ai][bj][m][n] = __builtin_amdgcn_mfma_f32_16x16x32_bf16(Bt[n][k], At[m][k], acc[ai][bj][m][n], 0, 0, 0); __builtin_amdgcn_s_setprio(0); } while (0)
#define PG8_WAIT_V(n) asm volatile("s_waitcnt vmcnt(" #n ")" ::: "memory")
#define PG8_WAIT_L(n) asm volatile("s_waitcnt lgkmcnt(" #n ")" ::: "memory")
#define PG8_BAR __builtin_amdgcn_s_barrier()
#define PG8_SCHED __builtin_amdgcn_sched_barrier(0)
    Unit cur, nxt; int ui = 0;
    if (!S.next(0, cur)) return;
    unsigned coff[2][2], noff[2][2];
#pragma unroll
    for (int h = 0; h < 2; ++h)
#pragma unroll
        for (int i = 0; i < 2; ++i) {
            if constexpr (GATHER) coff[h][i] = (unsigned)(S.gather_tok(cur, h * HALF + sR[i]) * K + sC[i]) * 2u;
            else coff[h][i] = (unsigned)(h * (int)hstep) + (unsigned)(sR[i] * K + sC[i]) * 2u;
            noff[h][i] = coff[h][i];
        }
    f32x4 acc[2][2][4][2];
#pragma unroll
    for (int a = 0; a < 2; ++a)
#pragma unroll
        for (int b = 0; b < 2; ++b)
#pragma unroll
            for (int m = 0; m < 4; ++m)
#pragma unroll
                for (int n = 0; n < 2; ++n) acc[a][b][m][n] = (f32x4){0.f, 0.f, 0.f, 0.f};
    bf16x8 At[4][2], B0[2][2], B1[2][2];
    const char* cA = cur.a; const char* cB = cur.b;
    PG8_STAGE_B(PG8_SB(0, 0), cB); PG8_STAGE_B(PG8_SB(0, 1), cB + hstep); PG8_STAGE_A(PG8_SA(0, 0), cA, coff, 0); PG8_STAGE_A(PG8_SA(0, 1), cA, coff, 1);
    if (wr == 1) PG8_BAR;
    PG8_WAIT_V(2); PG8_BAR;
    PG8_STAGE_B(PG8_SB(1, 0), cB + kstep); PG8_STAGE_A(PG8_SA(1, 0), cA + kstep, coff, 0); PG8_STAGE_B(PG8_SB(1, 1), cB + hstep + kstep);
    PG8_WAIT_V(6); PG8_BAR;
    for (;;) {
        const bool has_next = S.next(ui + 1, nxt);
        const char* nA = has_next ? nxt.a : cA; const char* nB = has_next ? nxt.b : cB;
        if constexpr (GATHER) {
            if (has_next) {
#pragma unroll
                for (int h = 0; h < 2; ++h)
#pragma unroll
                    for (int i = 0; i < 2; ++i) noff[h][i] = (unsigned)(S.gather_tok(nxt, h * HALF + sR[i]) * K + sC[i]) * 2u;
            }
        }
        for (int t = 0; t < nt; t += 2) {
            const bool last = (t == nt - 2);
            const char* a1 = cA + (size_t)(t + 1) * kstep;
            const char* a2 = last ? nA : cA + (size_t)(t + 2) * kstep; const char* b2 = last ? nB : cB + (size_t)(t + 2) * kstep;
            const char* a3 = a2 + kstep; const char* b3 = b2 + kstep;
            unsigned o2[2][2];
#pragma unroll
            for (int h = 0; h < 2; ++h)
#pragma unroll
                for (int i = 0; i < 2; ++i) o2[h][i] = GATHER ? (last ? noff[h][i] : coff[h][i]) : coff[h][i];
            PG8_LDB(B0, 0, 0); PG8_LDB(B1, 0, 1); PG8_SCHED; PG8_LDA(At, 0, 0); PG8_STAGE_A(PG8_SA(1, 1), a1, coff, 1);
            PG8_WAIT_V(8); PG8_WAIT_L(0); PG8_BAR; PG8_MMA(0, 0, At, B0); PG8_MMA(0, 1, At, B1); PG8_BAR; PG8_SCHED;
            PG8_LDA(At, 0, 1); PG8_STAGE_B(PG8_SB(0, 0), b2); PG8_STAGE_B(PG8_SB(0, 1), b2 + hstep); PG8_STAGE_A(PG8_SA(0, 0), a2, o2, 0);
            PG8_WAIT_V(8); PG8_WAIT_L(0); PG8_BAR; PG8_MMA(1, 0, At, B0); PG8_MMA(1, 1, At, B1); PG8_BAR; PG8_SCHED;
            PG8_LDB(B0, 1, 0); PG8_LDB(B1, 1, 1); PG8_SCHED; PG8_LDA(At, 1, 0); PG8_STAGE_A(PG8_SA(0, 1), a2, o2, 1);
            PG8_WAIT_V(8); PG8_WAIT_L(0); PG8_BAR; PG8_MMA(0, 0, At, B0); PG8_MMA(0, 1, At, B1); PG8_BAR; PG8_SCHED;
            PG8_LDA(At, 1, 1); PG8_STAGE_B(PG8_SB(1, 0), b3); PG8_STAGE_B(PG8_SB(1, 1), b3 + hstep); PG8_STAGE_A(PG8_SA(1, 0), a3, o2, 0);
            PG8_WAIT_V(8); PG8_WAIT_L(0); PG8_BAR; PG8_MMA(1, 0, At, B0); PG8_MMA(1, 1, At, B1); PG8_BAR; PG8_SCHED;
        }
        if (wr == 0) PG8_BAR;
        E(acc, cur, wr, wc, fr, fq);
        if (!has_next) break;
#pragma unroll
        for (int a = 0; a < 2; ++a)
#pragma unroll
            for (int b = 0; b < 2; ++b)
#pragma unroll
                for (int m = 0; m < 4; ++m)
#pragma unroll
                    for (int n = 0; n < 2; ++n) acc[a][b][m][n] = (f32x4){0.f, 0.f, 0.f, 0.f};
        cur = nxt; cA = nA; cB = nB; ++ui;
#pragma unroll
        for (int h = 0; h < 2; ++h)
#pragma unroll
            for (int i = 0; i < 2; ++i) coff[h][i] = noff[h][i];
        if (wr == 1) PG8_BAR;
    }
    PG8_WAIT_V(0);
    PG8_BAR;
#undef PG8_SA
#undef PG8_SB
#undef PG8_STAGE_A
#undef PG8_STAGE_B
#undef PG8_LDA
#undef PG8_LDB
#undef PG8_MMA
#undef PG8_WAIT_V
#undef PG8_WAIT_L
#undef PG8_BAR
#undef PG8_SCHED
}

typedef f32x4 AccT[2][2][4][2];
#define EPI_ROWS_BEGIN const int row0 = u.pm * BM + wr * 64 + fr; const int colw = wc * 32 + 8 * fq; \
    _Pragma("unroll") for (int ai = 0; ai < 2; ++ai) _Pragma("unroll") for (int m = 0; m < 4; ++m) { const int r = row0 + ai * HALF + m * 16;
#define EPI_ROWS_END }

struct EpiInAB {
    bf16_t* Z; const float* rstd;
    __device__ __forceinline__ void operator()(const AccT& acc, const Unit& u, int wr, int wc, int fr, int fq) const {
        const bool act = u.pn < 4;
        EPI_ROWS_BEGIN
            const float rs = rstd[r]; bf16_t* rowp = Z + (size_t)r * AB_IN + u.pn * BM + colw;
#pragma unroll
            for (int bj = 0; bj < 2; ++bj) { float v[8];
#pragma unroll
                for (int j = 0; j < 4; ++j) { v[j] = acc[ai][bj][m][0][j] * rs; v[4 + j] = acc[ai][bj][m][1][j] * rs; }
                if (act) {
#pragma unroll
                    for (int j = 0; j < 8; ++j) v[j] = fgelu_tanh(v[j]); }
                *(u32x4*)(rowp + bj * HALF) = pack8(v); }
        EPI_ROWS_END
    }
};
struct EpiPlain {
    bf16_t* O; int ldc;
    __device__ __forceinline__ void operator()(const AccT& acc, const Unit& u, int wr, int wc, int fr, int fq) const {
        EPI_ROWS_BEGIN
            bf16_t* rowp = O + (size_t)r * ldc + u.pn * BM + colw;
#pragma unroll
            for (int bj = 0; bj < 2; ++bj) { float v[8];
#pragma unroll
                for (int j = 0; j < 4; ++j) { v[j] = acc[ai][bj][m][0][j]; v[4 + j] = acc[ai][bj][m][1][j]; }
                *(u32x4*)(rowp + bj * HALF) = pack8(v); }
        EPI_ROWS_END
    }
};
template <bool MOE> struct EpiSwiGLU {
    bf16_t* H; int ldh; const float* rstd; const int* perm;
    __device__ __forceinline__ void operator()(const AccT& acc, const Unit& u, int wr, int wc, int fr, int fq) const {
        EPI_ROWS_BEGIN
            const int tok = MOE ? perm[r] : r; const float rs = rstd[tok];
            float v[8];
#pragma unroll
            for (int n = 0; n < 2; ++n)
#pragma unroll
                for (int j = 0; j < 4; ++j) { const float g = acc[ai][0][m][n][j] * rs, up = acc[ai][1][m][n][j] * rs; v[4 * n + j] = fsilu(g) * up; }
            *(u32x4*)(H + (size_t)r * ldh + u.pn * HALF + colw) = pack8(v);
        EPI_ROWS_END
    }
};
struct EpiInC {
    bf16_t* QFIG; const float* ssp; const float* lb;
    __device__ __forceinline__ void operator()(const AccT& acc, const Unit& u, int wr, int wc, int fr, int fq) const {
        const int type = u.pn >> 2; const int colt = (u.pn & 3) * BM + wc * 32 + 8 * fq;
        bf16_t* base = QFIG + (size_t)type * M * CW;
        EPI_ROWS_BEGIN
            const f32x4* sp = (const f32x4*)(ssp + (size_t)r * 16); const f32x4 s0 = sp[0], s1 = sp[1], s2 = sp[2], s3 = sp[3];
            const float ss = ((s0[0] + s0[1]) + (s0[2] + s0[3])) + ((s1[0] + s1[1]) + (s1[2] + s1[3])) + ((s2[0] + s2[1]) + (s2[2] + s2[3])) + ((s3[0] + s3[1]) + (s3[2] + s3[3]));
            const float rs = __builtin_amdgcn_rsqf(ss * (1.0f / D) + EPS);
#pragma unroll
            for (int bj = 0; bj < 2; ++bj) { float v[8];
#pragma unroll
                for (int j = 0; j < 4; ++j) { v[j] = acc[ai][bj][m][0][j] * rs; v[4 + j] = acc[ai][bj][m][1][j] * rs; }
                if (type == 0 || type == 3) {
#pragma unroll
                    for (int j = 0; j < 8; ++j) v[j] = fsilu(v[j]);
                } else if (type == 1) {
                    const f32x4 l0 = *(const f32x4*)(lb + colt + bj * HALF), l1 = *(const f32x4*)(lb + colt + bj * HALF + 4);
#pragma unroll
                    for (int j = 0; j < 8; ++j) { const float l = j < 4 ? l0[j] : l1[j - 4]; v[j] = __builtin_amdgcn_logf(l + (1.0f - l) * fsigmoid(v[j])); }
                }
                *(u32x4*)(base + (size_t)r * CW + colt + bj * HALF) = pack8(v); }
        EPI_ROWS_END
    }
};
template <bool FINAL> struct EpiPleGate {
    const bf16_t* X; const bf16_t* PP; bf16_t* XO; float* ssp; float* OUT;
    __device__ __forceinline__ void operator()(const AccT& acc, const Unit& u, int wr, int wc, int fr, int fq) const {
        EPI_ROWS_BEGIN
            const size_t off = (size_t)r * D + u.pn * BM + colw; float ssq = 0.f;
#pragma unroll
            for (int bj = 0; bj < 2; ++bj) { float x[8], p[8];
                unpack8(*(const u32x4*)(X + off + bj * HALF), x); unpack8(*(const u32x4*)(PP + off + bj * HALF), p);
#pragma unroll
                for (int j = 0; j < 8; ++j) { const float a = j < 4 ? acc[ai][bj][m][0][j] : acc[ai][bj][m][1][j - 4]; x[j] = x[j] + fsigmoid(a) * p[j]; ssq += x[j] * x[j]; }
                if (FINAL) { *(f32x4*)(OUT + off + bj * HALF) = (f32x4){x[0], x[1], x[2], x[3]}; *(f32x4*)(OUT + off + bj * HALF + 4) = (f32x4){x[4], x[5], x[6], x[7]}; }
                else *(u32x4*)(XO + off + bj * HALF) = pack8(x); }
            if (!FINAL) { ssq += __shfl_xor(ssq, 16); ssq += __shfl_xor(ssq, 32); if (fq == 0) ssp[(size_t)r * 16 + u.pn * 4 + wc] = ssq; }
        EPI_ROWS_END
    }
};
struct EpiMoeDown {
    const int* rowinfo; bf16_t* slots;
    __device__ __forceinline__ void operator()(const AccT& acc, const Unit& u, int wr, int wc, int fr, int fq) const {
        EPI_ROWS_BEGIN
            const int info = rowinfo[2 * r]; const float w = __int_as_float(rowinfo[2 * r + 1]);
            if (info >= 0) { bf16_t* rowp = slots + (size_t)(info & 1) * M * D + (size_t)(info >> 1) * D + u.pn * BM + colw;
#pragma unroll
                for (int bj = 0; bj < 2; ++bj) { float v[8];
#pragma unroll
                    for (int j = 0; j < 4; ++j) { v[j] = acc[ai][bj][m][0][j] * w; v[4 + j] = acc[ai][bj][m][1][j] * w; }
                    *(u32x4*)(rowp + bj * HALF) = pack8(v); } }
        EPI_ROWS_END
    }
};
}

constexpr size_t MiB = 1u << 20;
constexpr size_t WS_CTL = 0, CTL_ZERO_BYTES = 1 * MiB;
constexpr size_t WS_SMALL = 1 * MiB;
constexpr size_t SM_RSTD0 = WS_SMALL, SM_RSTD1 = SM_RSTD0 + 128 * 1024, SM_RSTD4 = SM_RSTD1 + 128 * 1024;
constexpr size_t SM_LB = SM_RSTD4 + 128 * 1024;
constexpr size_t SM_ROUTE = SM_LB + 4096;
constexpr size_t SM_CNT = SM_ROUTE + 512 * 1024;
constexpr size_t SM_META = SM_CNT + 32 * 1024;
constexpr size_t SM_PERM = SM_META + 4096;
constexpr size_t SM_RINFO = SM_PERM + 512 * 1024;
constexpr size_t SM_SSP = SM_RINFO + 1024 * 1024;
constexpr size_t SM_DLOG = SM_SSP + 2 * MiB;
static_assert(SM_DLOG + 128 * 1024 <= 9 * MiB, "small arrays");
constexpr size_t WS_W = 9 * MiB;
constexpr size_t W_INAB = WS_W, W_OUTAB = W_INAB + 5 * MiB, W_GU0 = W_OUTAB + 2 * MiB, W_DN0 = W_GU0 + 11 * MiB, W_INC = W_DN0 + 5 * MiB + 512 * 1024,
                 W_OUTC = W_INC + 8 * MiB, W_EGU = W_OUTC + 2 * MiB, W_EDN = W_EGU + 112 * MiB, W_PPROJ = W_EDN + 56 * MiB, W_PGATE = W_PPROJ + 1 * MiB, W_END = W_PGATE + 4 * MiB;
constexpr size_t WS_PB = W_END;
constexpr size_t WS_XA = WS_PB + 32 * MiB, WS_XB = WS_XA + 64 * MiB;
constexpr size_t WS_R = WS_XB + 64 * MiB;
constexpr size_t R_BYTES = (size_t)MAXP * 256 * EFF * 2;
constexpr size_t WS_END = WS_R + R_BYTES;
constexpr size_t R_Z = 0, R_Y = 160 * MiB, R_MIX = 224 * MiB, R_PP = 288 * MiB, R_HF = 0;
constexpr size_t R_QFIG = 0, R_O = 256 * MiB, R_OG = 384 * MiB, R_MIX1 = 0, R_H = 0, R_PP1 = 0;

constexpr int CW_BAR = 4096;

constexpr int RING_BYTES = 131072;
constexpr int LDSCTL_OFF = RING_BYTES, MISC_OFF = LDSCTL_OFF + 320;
constexpr int LDS_BYTES = 147456;

#define XB_TMO      128
#define XB_XCNT(j)  (256  + 64 * (j))
#define XB_XSUB(j)  (1280 + 64 * (j))
#define XB_XGEN(j)  (2304 + 64 * (j))
#define XB_TOP      3328
#define XB_TOPGEN   3392
#define XCD_BAR_WORDS 3456
#define XB_SPIN_CAP (1u << 18)
__device__ __forceinline__ unsigned xb_ld(unsigned* p)              { return __hip_atomic_load(p, __ATOMIC_RELAXED, __HIP_MEMORY_SCOPE_AGENT); }
__device__ __forceinline__ unsigned xb_add(unsigned* p, unsigned v) { return __hip_atomic_fetch_add(p, v, __ATOMIC_RELAXED, __HIP_MEMORY_SCOPE_AGENT); }
__device__ __forceinline__ unsigned xb_xcc_id() { return (unsigned)__builtin_amdgcn_s_getreg((3 << 11) | 20) & 0xFu; }
#define XB_SPIN(cond, bar) do { unsigned _sp = 0; while (cond) { __builtin_amdgcn_s_sleep(1); \
    if ((++_sp & 255u) == 0u) { if (xb_ld(&(bar)[XB_TMO])) break; if (_sp > XB_SPIN_CAP) { atomicAdd(&(bar)[XB_TMO], 1u); break; } } } } while (0)
struct XcdBarrier { unsigned* bar; unsigned x; volatile LAS unsigned* st; };
__device__ __forceinline__ XcdBarrier xcd_barrier_post(unsigned* bar, volatile LAS unsigned* st) {
    XcdBarrier b; b.bar = bar; b.x = xb_xcc_id(); b.st = st;
    if (threadIdx.x == 0) (void)xb_add(&bar[XB_XCNT(b.x)], 1u);
    return b;
}
__device__ __forceinline__ void xcd_barrier_complete(unsigned* bar, unsigned x, unsigned& nloc, unsigned& nx) {
    const unsigned G = gridDim.x * gridDim.y * gridDim.z;
    unsigned sum, cnt, mine, sp = 0u;
    for (;;) {
        sum = 0u; cnt = 0u; mine = 0u;
#pragma unroll
        for (unsigned j = 0; j < 16; ++j) { const unsigned c = xb_ld(&bar[XB_XCNT(j)]); sum += c; cnt += (c > 0u) ? 1u : 0u; mine = (j == x) ? c : mine; }
        if (sum == G) break;
        __builtin_amdgcn_s_sleep(1);
        if ((++sp & 255u) == 0u) { if (xb_ld(&bar[XB_TMO])) break; if (sp > XB_SPIN_CAP) { atomicAdd(&bar[XB_TMO], 1u); break; } }
    }
    nloc = mine > 0u ? mine : 1u; nx = cnt > 0u ? cnt : 1u;
}
__device__ __forceinline__ void xcd_barrier(const XcdBarrier& b) {
    asm volatile("s_waitcnt vmcnt(0)" ::: "memory");
    __syncthreads();
    if (threadIdx.x == 0) {
        unsigned* bar = b.bar;
        __builtin_amdgcn_s_waitcnt(0);
        unsigned nloc = b.st[0], nx = b.st[1];
        if (nloc == 0u) { xcd_barrier_complete(bar, b.x, nloc, nx); b.st[0] = nloc; b.st[1] = nx; }
        const unsigned old = xb_add(&bar[XB_XSUB(b.x)], 1u);
        const unsigned gen = old / nloc;
        if (old + 1u == (gen + 1u) * nloc) {
            __builtin_amdgcn_fence(__ATOMIC_RELEASE, "agent");
            asm volatile("s_waitcnt vmcnt(0)" ::: "memory");
            const unsigned og = xb_add(&bar[XB_TOP], 1u);
            const unsigned tg = og / nx;
            if (og + 1u == (tg + 1u) * nx) xb_add(&bar[XB_TOPGEN], 1u);
            else XB_SPIN(xb_ld(&bar[XB_TOPGEN]) == tg, bar);
            __builtin_amdgcn_fence(__ATOMIC_ACQUIRE, "agent");
            xb_add(&bar[XB_XGEN(b.x)], 1u);
            asm volatile("s_waitcnt vmcnt(0)" ::: "memory");
        } else {
            XB_SPIN(xb_ld(&bar[XB_XGEN(b.x)]) == gen, bar);
            __builtin_amdgcn_fence(__ATOMIC_ACQUIRE, "agent");
            asm volatile("s_waitcnt vmcnt(0)" ::: "memory");
        }
    }
    __syncthreads();
}


namespace hg {
constexpr int QS_OFF = 0, QS_RS = 272, KS_OFF = 17408, KS_RS = 288, IS_OFF = 35840, IS_RS = 288, PS_OFF = 54272, PS_RS = 144,
              TOT_OFF = 63488, RSC_OFF = 67584, DSC_OFF = 68096, RED_OFF = 68608;
typedef short s16x4 __attribute__((ext_vector_type(4)));
#define HG_MFMA(a, b, c) __builtin_amdgcn_mfma_f32_16x16x32_bf16((a), (b), (c), 0, 0, 0)
__device__ __forceinline__ bf16x8 rowfrag(const LAS unsigned char* img, int rs, int row, int step, int g) {
    const LAS s16x4* p = (const LAS s16x4*)(img + row * rs + (32 * step + 4 * g) * 2); const s16x4 lo = p[0], hi = p[4];
    return __builtin_shufflevector(lo, hi, 0, 1, 2, 3, 4, 5, 6, 7);
}
__device__ __forceinline__ bf16x8 trfrag(unsigned img_addr, int rs, int sb, int cb, int c, int g) {
    const unsigned a0 = img_addr + (unsigned)((32 * sb + 4 * g + (c >> 2)) * rs + 32 * cb + 8 * (c & 3)), a1 = a0 + (unsigned)(16 * rs);
    s16x4 lo, hi;
    asm volatile("ds_read_b64_tr_b16 %0, %2\n\tds_read_b64_tr_b16 %1, %3\n\ts_waitcnt lgkmcnt(0)" : "=&v"(lo), "=&v"(hi) : "v"(a0), "v"(a1) : "memory");
    return __builtin_shufflevector(lo, hi, 0, 1, 2, 3, 4, 5, 6, 7);
}
__device__ __forceinline__ bf16x8 pack_acc(const f32x4 a, const f32x4 b) {
    u32x4 p; p.x = cvt_pk_bf16(a[0], a[1]); p.y = cvt_pk_bf16(a[2], a[3]); p.z = cvt_pk_bf16(b[0], b[1]); p.w = cvt_pk_bf16(b[2], b[3]);
    return __builtin_bit_cast(bf16x8, p);
}
template <int PASS>
__device__ __forceinline__ void run(LAS unsigned char* lds, const bf16_t* Qb, const bf16_t* Fb, const bf16_t* Ib, const bf16_t* Gb,
                                    const float* onormg, float* Useg, float* Dlog, bf16_t* OG, int item) {
    const int tid = threadIdx.x, lane = tid & 63, w = __builtin_amdgcn_readfirstlane(tid >> 6), c = lane & 15, g = lane >> 4;
    const int b = item >> 6, h = (item >> 3) & 7, seg = item & 7;
    const size_t row0 = (size_t)b * SEQ + (size_t)seg * 1024;
    const int colh = h * 128;
    const int kp = lane, tg = w;
    const int isr = tid >> 3, ipc = tid & 7;
    const unsigned lds_addr = (unsigned)(size_t)lds;
    f32x4 S[8];
#pragma unroll
    for (int kt = 0; kt < 8; ++kt) S[kt] = (f32x4){0.f, 0.f, 0.f, 0.f};
    if (PASS == 2) {
        for (int j = 0; j < seg; ++j) { const int it = item - seg + j;
#pragma unroll
            for (int kt = 0; kt < 8; ++kt) { const f32x4 dl = *(const f32x4*)(Dlog + (size_t)it * 128 + 16 * kt + 4 * g);
                const f32x4 uu = *((const f32x4*)Useg + ((size_t)(it * 8 + w) * 8 + kt) * 64 + lane);
#pragma unroll
                for (int r = 0; r < 4; ++r) S[kt][r] = __builtin_amdgcn_exp2f(dl[r]) * S[kt][r] + uu[r]; } }
    }
    f32x4 og4 = (f32x4){0.f, 0.f, 0.f, 0.f}; if (PASS == 2) og4 = *(const f32x4*)(onormg + colh + 16 * w + 4 * g);
    float bsum0 = 0.f, bsum1 = 0.f;
    unsigned lfw[8], qw[8]; u32x4 iw0, iw1;
#pragma unroll
    for (int j = 0; j < 8; ++j) { const size_t r = row0 + 8 * tg + j; lfw[j] = *(const unsigned*)(Fb + r * CW + colh + 2 * kp); qw[j] = PASS == 2 ? *(const unsigned*)(Qb + r * CW + colh + 2 * kp) : 0u; }
    { const size_t r = row0 + isr; iw0 = *(const u32x4*)(Ib + r * CW + colh + ipc * 16); iw1 = *(const u32x4*)(Ib + r * CW + colh + ipc * 16 + 8); }
    for (int ch = 0; ch < 16; ++ch) {
        const size_t crow = row0 + (size_t)ch * 64;
        float b0[8], b1[8]; { float a0 = 0.f, a1 = 0.f;
#pragma unroll
            for (int j = 0; j < 8; ++j) { a0 += bflo(lfw[j]); a1 += bfhi(lfw[j]); b0[j] = a0; b1[j] = a1; }
            *(LAS f32x2*)(lds + TOT_OFF + (tg * 128 + 2 * kp) * 4) = (f32x2){a0, a1}; }
        u32x2 gw[4];
        if (PASS == 2) {
#pragma unroll
            for (int tt = 0; tt < 4; ++tt) gw[tt] = *(const u32x2*)(Gb + (crow + 16 * tt + c) * CW + colh + 16 * w + 4 * g); }
        __syncthreads();
        { float p0 = 0.f, p1 = 0.f, r0 = 0.f, r1 = 0.f, e0 = 0.f, e1 = 0.f;
#pragma unroll
          for (int t8 = 0; t8 < 8; ++t8) { const f32x2 tv = *(const LAS f32x2*)(lds + TOT_OFF + (t8 * 128 + 2 * kp) * 4);
              if (t8 < tg) { p0 += tv.x; p1 += tv.y; } if (t8 < 4) { r0 += tv.x; r1 += tv.y; } e0 += tv.x; e1 += tv.y; }
#pragma unroll
          for (int j = 0; j < 8; ++j) { const int t = 8 * tg + j; const float bb0 = b0[j] + p0, bb1 = b1[j] + p1;
              const float k0 = 1.0f - __builtin_amdgcn_exp2f(bflo(lfw[j])), k1 = 1.0f - __builtin_amdgcn_exp2f(bfhi(lfw[j]));
              *(LAS unsigned*)(lds + KS_OFF + t * KS_RS + kp * 4) = cvt_pk_bf16(k0 * __builtin_amdgcn_exp2f(r0 - bb0), k1 * __builtin_amdgcn_exp2f(r1 - bb1));
              if (PASS == 2) *(LAS unsigned*)(lds + QS_OFF + t * QS_RS + kp * 4) = cvt_pk_bf16(bflo(qw[j]) * __builtin_amdgcn_exp2f(bb0 - r0), bfhi(qw[j]) * __builtin_amdgcn_exp2f(bb1 - r1)); }
          if (tg == 0) { *(LAS f32x2*)(lds + RSC_OFF + kp * 8) = (f32x2){__builtin_amdgcn_exp2f(r0), __builtin_amdgcn_exp2f(r1)};
              *(LAS f32x2*)(lds + DSC_OFF + kp * 8) = (f32x2){__builtin_amdgcn_exp2f(e0 - r0), __builtin_amdgcn_exp2f(e1 - r1)}; bsum0 += e0; bsum1 += e1; }
          *(LAS u32x4*)(lds + IS_OFF + isr * IS_RS + ipc * 32) = iw0; *(LAS u32x4*)(lds + IS_OFF + isr * IS_RS + ipc * 32 + 16) = iw1; }
        { const size_t nrow = row0 + (size_t)(ch < 15 ? ch + 1 : ch) * 64;
#pragma unroll
          for (int j = 0; j < 8; ++j) { const size_t r = nrow + 8 * tg + j; lfw[j] = *(const unsigned*)(Fb + r * CW + colh + 2 * kp); if (PASS == 2) qw[j] = *(const unsigned*)(Qb + r * CW + colh + 2 * kp); }
          const size_t r = nrow + isr; iw0 = *(const u32x4*)(Ib + r * CW + colh + ipc * 16); iw1 = *(const u32x4*)(Ib + r * CW + colh + ipc * 16 + 8); }
        __syncthreads();
        if (PASS == 2) {
            const int st = w >> 1;
            bf16x8 Kf[4];
#pragma unroll
            for (int sp = 0; sp < 4; ++sp) Kf[sp] = rowfrag(lds + KS_OFF, KS_RS, 16 * st + c, sp, g);
#pragma unroll
            for (int i = 0; i < 2; ++i) { const int tt = 2 * (w & 1) + i; f32x4 acc = (f32x4){0.f, 0.f, 0.f, 0.f};
#pragma unroll
                for (int sp = 0; sp < 4; ++sp) acc = HG_MFMA(Kf[sp], rowfrag(lds + QS_OFF, QS_RS, 16 * tt + c, sp, g), acc);
                const int t = 16 * tt + c, s0 = 16 * st + 4 * g;
#pragma unroll
                for (int r = 0; r < 4; ++r) acc[r] = (s0 + r <= t) ? acc[r] : 0.f;
                u32x2 pw; pw.x = cvt_pk_bf16(acc[0], acc[1]); pw.y = cvt_pk_bf16(acc[2], acc[3]);
                *(LAS u32x2*)(lds + PS_OFF + t * PS_RS + s0 * 2) = pw; }
            __syncthreads();
        }
#pragma unroll
        for (int kt = 0; kt < 8; ++kt) { const f32x4 rs = *(const LAS f32x4*)(lds + RSC_OFF + (16 * kt + 4 * g) * 4); S[kt] = S[kt] * rs; }
        bf16x8 If[2];
#pragma unroll
        for (int sb = 0; sb < 2; ++sb) If[sb] = trfrag(lds_addr + IS_OFF, IS_RS, sb, w, c, g);
        f32x4 O[4];
        if (PASS == 2) {
            bf16x8 Sp[4];
#pragma unroll
            for (int sp = 0; sp < 4; ++sp) Sp[sp] = pack_acc(S[2 * sp], S[2 * sp + 1]);
#pragma unroll
            for (int tt = 0; tt < 4; ++tt) { f32x4 acc = (f32x4){0.f, 0.f, 0.f, 0.f};
#pragma unroll
                for (int sp = 0; sp < 4; ++sp) acc = HG_MFMA(Sp[sp], rowfrag(lds + QS_OFF, QS_RS, 16 * tt + c, sp, g), acc);
#pragma unroll
                for (int sb = 0; sb < 2; ++sb) if (32 * sb <= 16 * tt + 15) acc = HG_MFMA(If[sb], rowfrag(lds + PS_OFF, PS_RS, 16 * tt + c, sb, g), acc);
                O[tt] = acc; }
        }
#pragma unroll
        for (int kt = 0; kt < 8; ++kt) {
#pragma unroll
            for (int sb = 0; sb < 2; ++sb) S[kt] = HG_MFMA(trfrag(lds_addr + KS_OFF, KS_RS, sb, kt, c, g), If[sb], S[kt]);
            const f32x4 ds = *(const LAS f32x4*)(lds + DSC_OFF + (16 * kt + 4 * g) * 4); S[kt] = S[kt] * ds; }
        if (PASS == 2) {
#pragma unroll
            for (int tt = 0; tt < 4; ++tt) { float ss = (O[tt][0] * O[tt][0] + O[tt][1] * O[tt][1]) + (O[tt][2] * O[tt][2] + O[tt][3] * O[tt][3]);
                ss += __shfl_xor(ss, 16); ss += __shfl_xor(ss, 32); if (g == 0) *(LAS float*)(lds + RED_OFF + ((16 * tt + c) * 8 + w) * 4) = ss; }
            __syncthreads();
#pragma unroll
            for (int tt = 0; tt < 4; ++tt) { const LAS f32x4* rp = (const LAS f32x4*)(lds + RED_OFF + (16 * tt + c) * 32); const f32x4 ra = rp[0], rb = rp[1];
                const float tot = ((ra[0] + ra[1]) + (ra[2] + ra[3])) + ((rb[0] + rb[1]) + (rb[2] + rb[3]));
                const float rstd = __builtin_amdgcn_rsqf(tot * (1.0f / 128.0f) + EPS);
                const float o0 = O[tt][0] * rstd * og4[0] * bflo(gw[tt].x), o1 = O[tt][1] * rstd * og4[1] * bfhi(gw[tt].x), o2 = O[tt][2] * rstd * og4[2] * bflo(gw[tt].y), o3 = O[tt][3] * rstd * og4[3] * bfhi(gw[tt].y);
                u32x2 ow; ow.x = cvt_pk_bf16(o0, o1); ow.y = cvt_pk_bf16(o2, o3);
                *(u32x2*)(OG + (crow + 16 * tt + c) * CW + colh + 16 * w + 4 * g) = ow; }
        }
    }
    if (PASS == 1) {
#pragma unroll
        for (int kt = 0; kt < 8; ++kt) *((f32x4*)Useg + ((size_t)(item * 8 + w) * 8 + kt) * 64 + lane) = S[kt];
        if (tg == 0) *(f32x2*)(Dlog + (size_t)item * 128 + 2 * kp) = (f32x2){bsum0, bsum1};
    }
    __syncthreads();
}
}

struct Args { const float* in[22]; float* out; unsigned char* ws; int ph_lo, ph_hi, li, pad; };
enum { I_X = 0, I_P, I_NORMG, I_WINAB, I_ALNG, I_ALNB, I_AWS, I_ABS, I_BCONV, I_WOUTAB, I_FFNGU, I_FFNDN, I_WINC, I_LBP, I_ONORMG, I_WOUTC, I_WROUTER, I_BROUTER, I_EGU, I_EDN, I_PPROJ, I_PGATE };

__device__ __forceinline__ void transpose_item(const float* W, int K, int N, bf16_t* WT, const float* gain, int gu_ff, LAS float* scr, int item, int lane) {
    const int nblk = N / 32, kb = item / nblk, nb = item % nblk, k0 = 64 * kb, n0 = 32 * nb;
#pragma unroll 8
    for (int i = 0; i < 32; ++i) { const int kk = 2 * i + (lane >> 5); float w = W[(size_t)(k0 + kk) * N + n0 + (lane & 31)]; if (gain) w *= gain[k0 + kk]; scr[kk * 33 + (lane & 31)] = w; }
    asm volatile("s_waitcnt lgkmcnt(0)" ::: "memory");
    int d0 = n0; if (gu_ff) { const int half = n0 >= gu_ff ? 1 : 0, j = n0 - half * gu_ff; d0 = (j / 128) * 256 + half * 128 + (j % 128); }
    const int c = lane & 7;
#pragma unroll
    for (int j = 0; j < 4; ++j) { const int n = (lane >> 3) + 8 * j; const LAS float* s = scr + (8 * c) * 33 + n;
        u32x4 o; o.x = cvt_pk_bf16(s[0 * 33], s[1 * 33]); o.y = cvt_pk_bf16(s[2 * 33], s[3 * 33]); o.z = cvt_pk_bf16(s[4 * 33], s[5 * 33]); o.w = cvt_pk_bf16(s[6 * 33], s[7 * 33]);
        *(u32x4*)(WT + (size_t)(d0 + n) * K + k0 + 8 * c) = o; }
    asm volatile("s_waitcnt lgkmcnt(0)" ::: "memory");
}

__device__ __forceinline__ void ld_row_bf16(const bf16_t* row, int lane, float (&v)[16]) { unpack8(*(const u32x4*)(row + lane * 8), v); unpack8(*(const u32x4*)(row + 512 + lane * 8), v + 8); }
__device__ __forceinline__ void st_row_bf16(bf16_t* row, int lane, const float (&v)[16]) { *(u32x4*)(row + lane * 8) = pack8(v); *(u32x4*)(row + 512 + lane * 8) = pack8(v + 8); }
__device__ __forceinline__ void ld_row_f32(const float* row, int lane, float (&v)[16]) {
    const f32x4 a = *(const f32x4*)(row + lane * 8), b = *(const f32x4*)(row + lane * 8 + 4), c = *(const f32x4*)(row + 512 + lane * 8), d = *(const f32x4*)(row + 512 + lane * 8 + 4);
#pragma unroll
    for (int j = 0; j < 4; ++j) { v[j] = a[j]; v[4 + j] = b[j]; v[8 + j] = c[j]; v[12 + j] = d[j]; }
}
__device__ __forceinline__ float sumsq16(const float (&v)[16]) { float s = 0.f;
#pragma unroll
    for (int j = 0; j < 16; ++j) s += v[j] * v[j];
    return s; }

__global__ void __launch_bounds__(NTHR, 2) trunk_fwd(Args args) {
    extern __shared__ __attribute__((aligned(16))) unsigned char lds_raw[];
    LAS unsigned char* lds = (LAS unsigned char*)lds_raw;
    volatile LAS unsigned* MISC = (volatile LAS unsigned*)(lds + MISC_OFF);
    const int tid = threadIdx.x, lane = tid & 63, wave = __builtin_amdgcn_readfirstlane(tid >> 6);
    const int G = gridDim.x, bx = blockIdx.x;
    unsigned char* ws = args.ws;
    for (int u = tid; u < (LDS_BYTES - LDSCTL_OFF) / 4; u += NTHR) ((LAS unsigned*)(lds + LDSCTL_OFF))[u] = 0u;
    __syncthreads();
    XcdBarrier bar; bar.bar = (unsigned*)(ws + WS_CTL) + CW_BAR; bar.x = 0; bar.st = nullptr;
    if (MK_N_LAUNCHES == 1) bar = xcd_barrier_post((unsigned*)(ws + WS_CTL) + CW_BAR, MISC + 8);
    const int lo = args.ph_lo, hi = args.ph_hi;
#define IN(k) (lo <= (k) && (k) < hi)
#define SEAM(k) do { if (IN(k) && IN((k) + 1)) xcd_barrier(bar); } while (0)

    const float* normg = args.in[I_NORMG];
    float* rstd0 = (float*)(ws + SM_RSTD0); float* rstd1 = (float*)(ws + SM_RSTD1); float* rstd4 = (float*)(ws + SM_RSTD4);
    float* LB = (float*)(ws + SM_LB); int* route = (int*)(ws + SM_ROUTE); int* cntg = (int*)(ws + SM_CNT); int* meta = (int*)(ws + SM_META);
    int* perm = (int*)(ws + SM_PERM); int* rinfo = (int*)(ws + SM_RINFO); float* ssp = (float*)(ws + SM_SSP);
    bf16_t* XA = (bf16_t*)(ws + WS_XA); bf16_t* XB = (bf16_t*)(ws + WS_XB); bf16_t* PB = (bf16_t*)(ws + WS_PB);
    unsigned char* R = ws + WS_R;
    const int gw = bx * NWAVES + wave, NGW = G * NWAVES;
    const int RPW = M / G;

    if (IN(0)) for (int rep_ = 0; rep_ < NREP(0); ++rep_) {
        LAS float* scr = (LAS float*)(lds + wave * 16384);
        constexpr int I1 = 16 * 80, I2 = 16 * 32, I3 = 16 * 176, I4 = 44 * 32, I5 = 16 * 128, I6 = 16 * 32, I7E = 16 * 224, I8E = 56 * 32, I9L = 4 * 32, I10L = 16 * 32;
        constexpr int NITEMS = I1 + I2 + I3 + I4 + I5 + I6 + 8 * I7E + 8 * I8E + 2 * I9L + 2 * I10L;
        for (int it = gw; it < NITEMS; it += NGW) {
            int r = it;
            if (r < I1) { transpose_item(args.in[I_WINAB], D, AB_IN, (bf16_t*)(ws + W_INAB), normg + 0 * D, 0, scr, r, lane); continue; } r -= I1;
            if (r < I2) { transpose_item(args.in[I_WOUTAB], D, D, (bf16_t*)(ws + W_OUTAB), nullptr, 0, scr, r, lane); continue; } r -= I2;
            if (r < I3) { transpose_item(args.in[I_FFNGU], D, 2 * FF, (bf16_t*)(ws + W_GU0), normg + 2 * D, FF, scr, r, lane); continue; } r -= I3;
            if (r < I4) { transpose_item(args.in[I_FFNDN], FF, D, (bf16_t*)(ws + W_DN0), nullptr, 0, scr, r, lane); continue; } r -= I4;
            if (r < I5) { transpose_item(args.in[I_WINC], D, 4 * CW, (bf16_t*)(ws + W_INC), normg + 4 * D, 0, scr, r, lane); continue; } r -= I5;
            if (r < I6) { transpose_item(args.in[I_WOUTC], CW, D, (bf16_t*)(ws + W_OUTC), nullptr, 0, scr, r, lane); continue; } r -= I6;
            if (r < 8 * I7E) { const int e = r / I7E; transpose_item(args.in[I_EGU] + (size_t)e * D * 2 * EFF, D, 2 * EFF, (bf16_t*)(ws + W_EGU) + (size_t)e * 2 * EFF * D, normg + 6 * D, EFF, scr, r % I7E, lane); continue; } r -= 8 * I7E;
            if (r < 8 * I8E) { const int e = r / I8E; transpose_item(args.in[I_EDN] + (size_t)e * EFF * D, EFF, D, (bf16_t*)(ws + W_EDN) + (size_t)e * D * EFF, nullptr, 0, scr, r % I8E, lane); continue; } r -= 8 * I8E;
            if (r < 2 * I9L) { const int l = r / I9L; transpose_item(args.in[I_PPROJ] + (size_t)l * PLE * D, PLE, D, (bf16_t*)(ws + W_PPROJ) + (size_t)l * D * PLE, nullptr, 0, scr, r % I9L, lane); continue; } r -= 2 * I9L;
            { const int l = r / I10L; transpose_item(args.in[I_PGATE] + (size_t)l * D * D, D, D, (bf16_t*)(ws + W_PGATE) + (size_t)l * D * D, nullptr, 0, scr, r % I10L, lane); }
        }
        for (int m = gw; m < M; m += NGW) { float v[16]; ld_row_f32(args.in[I_X] + (size_t)m * D, lane, v);
            const float ss = wave_sum(sumsq16(v)); st_row_bf16(XA + (size_t)m * D, lane, v); if (lane == 0) rstd0[m] = __builtin_amdgcn_rsqf(ss * (1.0f / D) + EPS); }
        { const float* p = args.in[I_P]; const size_t n8 = (size_t)2 * M * PLE / 8;
          for (size_t i = (size_t)bx * NTHR + tid; i < n8; i += (size_t)G * NTHR) { const f32x4 a = *(const f32x4*)(p + i * 8), b = *(const f32x4*)(p + i * 8 + 4);
              float v[8] = {a[0], a[1], a[2], a[3], b[0], b[1], b[2], b[3]}; *(u32x4*)(PB + i * 8) = pack8(v); } }
        if (bx == 0) for (int c = tid; c < CW; c += NTHR) { const float d = args.in[I_LBP][CW + c] - args.in[I_LBP][c]; LB[c] = 1.0f / (1.0f + expf(-d)); }
    }
    SEAM(0);

    if (IN(1)) for (int rep_ = 0; rep_ < NREP(1); ++rep_) { pg8::StaticOrder S; S.init(XA, (const bf16_t*)(ws + W_INAB), M, AB_IN, D, G, bx); pg8::EpiInAB E{(bf16_t*)(R + R_Z), rstd0};
        pg8::gemm_phase<pg8::EpiInAB, pg8::StaticOrder, false>(lds, D, S, E); }
    SEAM(1);

    if (IN(2)) for (int rep_ = 0; rep_ < NREP(2); ++rep_) {
        const bf16_t* Z = (const bf16_t*)(R + R_Z); bf16_t* Y = (bf16_t*)(R + R_Y);
        LAS float* vln = (LAS float*)lds;
        LAS float* wt = (LAS float*)(lds + 32768);
        for (int blk = bx; blk < M / 128; blk += G) {
            const int t0 = blk * 128;
            for (int h = 0; h < 8; ++h) {
                { const float* Wh = args.in[I_AWS] + (size_t)h * 128 * 128;
                  for (int e = tid; e < 128 * 128; e += NTHR) { const int i = e >> 7, j = e & 127; float w = Wh[e]; if ((j >> 6) > (i >> 6)) w = 0.f; wt[j * 128 + i] = w; } }
                { const int row = tid >> 2, dq = tid & 3; const bf16_t* vp = Z + (size_t)(t0 + row) * AB_IN + 512 + h * 64 + dq * 16; float v[16];
                  unpack8(*(const u32x4*)vp, v); unpack8(*(const u32x4*)(vp + 8), v + 8);
                  float s = 0.f;
#pragma unroll
                  for (int j = 0; j < 16; ++j) s += v[j];
                  s += __shfl_xor(s, 1); s += __shfl_xor(s, 2); const float mu = s * (1.0f / 64.0f); float q = 0.f;
#pragma unroll
                  for (int j = 0; j < 16; ++j) { v[j] -= mu; q += v[j] * v[j]; }
                  q += __shfl_xor(q, 1); q += __shfl_xor(q, 2); const float rs = __builtin_amdgcn_rsqf(q * (1.0f / 64.0f) + EPS);
#pragma unroll
                  for (int j = 0; j < 16; ++j) { const int c = h * 64 + dq * 16 + j; vln[row * 64 + dq * 16 + j] = v[j] * rs * args.in[I_ALNG][c] + args.in[I_ALNB][c]; } }
                __syncthreads();
                { const int d = tid & 63, ig = wave; const int jmax = ig < 4 ? 64 : 128; float a[16];
#pragma unroll
                  for (int ii = 0; ii < 16; ++ii) a[ii] = 0.f;
                  for (int j = 0; j < jmax; ++j) { const float vj = vln[j * 64 + d]; const LAS f32x4* wp = (const LAS f32x4*)(wt + j * 128 + ig * 16);
                      const f32x4 w0 = wp[0], w1 = wp[1], w2 = wp[2], w3 = wp[3];
#pragma unroll
                      for (int ii = 0; ii < 4; ++ii) { a[ii] += w0[ii] * vj; a[4 + ii] += w1[ii] * vj; a[8 + ii] += w2[ii] * vj; a[12 + ii] += w3[ii] * vj; } }
#pragma unroll
                  for (int ii = 0; ii < 16; ++ii) { const int i = ig * 16 + ii; const float f = a[ii] + args.in[I_ABS][h * 128 + i];
                      const float uu = bf2f(Z[(size_t)(t0 + i) * AB_IN + h * 64 + d]); Y[(size_t)(t0 + i) * D + h * 64 + d] = f2bf(uu * f); } }
                __syncthreads();
            }
            { const int c = tid; const float w0 = args.in[I_BCONV][c], w1 = args.in[I_BCONV][512 + c], w2 = args.in[I_BCONV][1024 + c];
              float p2 = 0.f, p1 = 0.f;
              if ((t0 % SEQ) != 0) { const bf16_t* z2 = Z + (size_t)(t0 - 2) * AB_IN; const bf16_t* z1 = Z + (size_t)(t0 - 1) * AB_IN;
                  p2 = bf2f(z2[1536 + c]) * bf2f(z2[1024 + c]); p1 = bf2f(z1[1536 + c]) * bf2f(z1[1024 + c]); }
              for (int t = 0; t < 128; ++t) { const bf16_t* z = Z + (size_t)(t0 + t) * AB_IN; const float p0 = bf2f(z[1536 + c]) * bf2f(z[1024 + c]);
                  Y[(size_t)(t0 + t) * D + 512 + c] = f2bf(bf2f(z[2048 + c]) * (w0 * p2 + w1 * p1 + w2 * p0)); p2 = p1; p1 = p0; } }
        }
    }
    SEAM(2);

    if (IN(3)) for (int rep_ = 0; rep_ < NREP(3); ++rep_) { pg8::StaticOrder S; S.init((const bf16_t*)(R + R_Y), (const bf16_t*)(ws + W_OUTAB), M, D, D, G, bx); pg8::EpiPlain E{(bf16_t*)(R + R_MIX), D};
        pg8::gemm_phase<pg8::EpiPlain, pg8::StaticOrder, false>(lds, D, S, E); }
    SEAM(3);

    if (IN(4)) for (int rep_ = 0; rep_ < NREP(4); ++rep_) { const bf16_t* MIX = (const bf16_t*)(R + R_MIX); float g[16]; ld_row_f32(normg + 1 * D, lane, g);
        for (int i = 0; i < RPW / NWAVES; ++i) { const int m = bx * RPW + wave * (RPW / NWAVES) + i; float mx[16], x[16]; ld_row_bf16(MIX + (size_t)m * D, lane, mx); ld_row_bf16(XA + (size_t)m * D, lane, x);
            const float rm = __builtin_amdgcn_rsqf(wave_sum(sumsq16(mx)) * (1.0f / D) + EPS);
#pragma unroll
            for (int j = 0; j < 16; ++j) x[j] += g[j] * mx[j] * rm;
            const float ss = wave_sum(sumsq16(x)); st_row_bf16(XB + (size_t)m * D, lane, x); if (lane == 0) rstd1[m] = __builtin_amdgcn_rsqf(ss * (1.0f / D) + EPS); } }
    SEAM(4);

    if (IN(5)) for (int rep_ = 0; rep_ < NREP(5); ++rep_) { pg8::StaticOrder S; S.init(XB, (const bf16_t*)(ws + W_GU0), M, 2 * FF, D, G, bx); pg8::EpiSwiGLU<false> E{(bf16_t*)(R + R_HF), FF, rstd1, nullptr};
        pg8::gemm_phase<pg8::EpiSwiGLU<false>, pg8::StaticOrder, false>(lds, D, S, E); }
    SEAM(5);

    if (IN(6)) for (int rep_ = 0; rep_ < NREP(6); ++rep_) { pg8::StaticOrder S; S.init((const bf16_t*)(R + R_HF), (const bf16_t*)(ws + W_DN0), M, D, FF, G, bx); pg8::EpiPlain E{(bf16_t*)(R + R_MIX), D};
        pg8::gemm_phase<pg8::EpiPlain, pg8::StaticOrder, false>(lds, FF, S, E); }
    SEAM(6);

    if (IN(7)) for (int rep_ = 0; rep_ < NREP(7); ++rep_) { const bf16_t* MIX = (const bf16_t*)(R + R_MIX); float g[16]; ld_row_f32(normg + 3 * D, lane, g);
        for (int i = 0; i < RPW / NWAVES; ++i) { const int m = bx * RPW + wave * (RPW / NWAVES) + i; float mx[16], x[16]; ld_row_bf16(MIX + (size_t)m * D, lane, mx); ld_row_bf16(XB + (size_t)m * D, lane, x);
            const float rm = __builtin_amdgcn_rsqf(wave_sum(sumsq16(mx)) * (1.0f / D) + EPS);
#pragma unroll
            for (int j = 0; j < 16; ++j) x[j] += g[j] * mx[j] * rm;
            st_row_bf16(XA + (size_t)m * D, lane, x); } }
    SEAM(7);

    if (IN(8)) for (int rep_ = 0; rep_ < NREP(8); ++rep_) { pg8::StaticOrder S; S.init(PB, (const bf16_t*)(ws + W_PPROJ), M, D, PLE, G, bx); pg8::EpiPlain E{(bf16_t*)(R + R_PP), D};
        pg8::gemm_phase<pg8::EpiPlain, pg8::StaticOrder, false>(lds, PLE, S, E); }
    SEAM(8);

    if (IN(9)) for (int rep_ = 0; rep_ < NREP(9); ++rep_) { pg8::StaticOrder S; S.init(XA, (const bf16_t*)(ws + W_PGATE), M, D, D, G, bx); pg8::EpiPleGate<false> E{XA, (const bf16_t*)(R + R_PP), XB, ssp, nullptr};
        pg8::gemm_phase<pg8::EpiPleGate<false>, pg8::StaticOrder, false>(lds, D, S, E); }
    SEAM(9);

    if (IN(10)) for (int rep_ = 0; rep_ < NREP(10); ++rep_) { pg8::StaticOrder S; S.init(XB, (const bf16_t*)(ws + W_INC), M, 4 * CW, D, G, bx); pg8::EpiInC E{(bf16_t*)(R + R_QFIG), ssp, LB};
        pg8::gemm_phase<pg8::EpiInC, pg8::StaticOrder, false>(lds, D, S, E); }
    SEAM(10);

    if (IN(11)) for (int rep_ = 0; rep_ < NREP(11); ++rep_) {
        const bf16_t* Qb = (const bf16_t*)(R + R_QFIG); const bf16_t* Fb = Qb + (size_t)M * CW; const bf16_t* Ib = Fb + (size_t)M * CW; const bf16_t* Gb = Ib + (size_t)M * CW;
        for (int item = bx; item < BATCH * 8 * 8; item += G) { if ((item & 7) == 7) continue;
            hg::run<1>(lds, Qb, Fb, Ib, Gb, args.in[I_ONORMG], (float*)(R + R_O), (float*)(ws + SM_DLOG), (bf16_t*)(R + R_OG), item); }
    }
    SEAM(11);

    if (IN(12)) for (int rep_ = 0; rep_ < NREP(12); ++rep_) {
        const bf16_t* Qb = (const bf16_t*)(R + R_QFIG); const bf16_t* Fb = Qb + (size_t)M * CW; const bf16_t* Ib = Fb + (size_t)M * CW; const bf16_t* Gb = Ib + (size_t)M * CW;
        for (int item = bx; item < BATCH * 8 * 8; item += G)
            hg::run<2>(lds, Qb, Fb, Ib, Gb, args.in[I_ONORMG], (float*)(R + R_O), (float*)(ws + SM_DLOG), (bf16_t*)(R + R_OG), item);
    }
    SEAM(12);

    if (IN(13)) for (int rep_ = 0; rep_ < NREP(13); ++rep_) { pg8::StaticOrder S; S.init((const bf16_t*)(R + R_OG), (const bf16_t*)(ws + W_OUTC), M, D, CW, G, bx); pg8::EpiPlain E{(bf16_t*)(R + R_MIX1), D};
        pg8::gemm_phase<pg8::EpiPlain, pg8::StaticOrder, false>(lds, CW, S, E); }
    SEAM(13);

    if (IN(14)) for (int rep_ = 0; rep_ < NREP(14); ++rep_) { const bf16_t* MIX = (const bf16_t*)(R + R_MIX1); float g[16], g2[16]; ld_row_f32(normg + 5 * D, lane, g); ld_row_f32(normg + 6 * D, lane, g2);
        LAS float* wrl = (LAS float*)lds;
        LAS int* lcnt = (LAS int*)(lds + 32768);
        for (int e = tid; e < D * NE; e += NTHR) wrl[e] = args.in[I_WROUTER][e];
        if (tid < NE) lcnt[tid] = 0;
        __syncthreads();
        for (int i = 0; i < RPW / NWAVES; ++i) { const int m = bx * RPW + wave * (RPW / NWAVES) + i; float mx[16], x[16]; ld_row_bf16(MIX + (size_t)m * D, lane, mx); ld_row_bf16(XB + (size_t)m * D, lane, x);
            const float rm = __builtin_amdgcn_rsqf(wave_sum(sumsq16(mx)) * (1.0f / D) + EPS);
#pragma unroll
            for (int j = 0; j < 16; ++j) x[j] += g[j] * mx[j] * rm;
            const float rs = __builtin_amdgcn_rsqf(wave_sum(sumsq16(x)) * (1.0f / D) + EPS);
            st_row_bf16(XA + (size_t)m * D, lane, x); if (lane == 0) rstd4[m] = rs;
            float lg[NE];
#pragma unroll
            for (int e = 0; e < NE; ++e) lg[e] = 0.f;
#pragma unroll
            for (int j = 0; j < 16; ++j) { const int col = (j < 8 ? 0 : 512) + lane * 8 + (j & 7); const float hn = x[j] * rs * g2[j];
                const LAS f32x4* wp = (const LAS f32x4*)(wrl + col * NE); const f32x4 w0 = wp[0], w1 = wp[1];
#pragma unroll
                for (int e = 0; e < 4; ++e) { lg[e] += hn * w0[e]; lg[4 + e] += hn * w1[e]; } }
#pragma unroll
            for (int e = 0; e < NE; ++e) lg[e] = wave_sum(lg[e]) + args.in[I_BROUTER][e];
            if (lane == 0) { int e1 = 0; float l1 = lg[0];
#pragma unroll
                for (int e = 1; e < NE; ++e) if (lg[e] > l1) { l1 = lg[e]; e1 = e; }
                int e2 = -1; float l2 = -3.0e38f;
#pragma unroll
                for (int e = 0; e < NE; ++e) if (e != e1 && lg[e] > l2) { l2 = lg[e]; e2 = e; }
                const float ex = expf(l2 - l1), w1 = 1.0f / (1.0f + ex), w2 = ex / (1.0f + ex);
                *(i32x4*)(route + (size_t)m * 4) = (i32x4){e1, e2, __float_as_int(w1), __float_as_int(w2)};
                atomicAdd((int*)(lcnt + e1), 1); atomicAdd((int*)(lcnt + e2), 1); } }
        __syncthreads();
        if (tid < NE) cntg[bx * NE + tid] = lcnt[tid];
    }
    SEAM(14);

    if (IN(15)) for (int rep_ = 0; rep_ < NREP(15); ++rep_) {
        LAS int* lc = (LAS int*)lds;
        LAS int* tot = (LAS int*)(lds + 32768);
        for (int e = tid; e < G * NE; e += NTHR) lc[e] = cntg[e];
        __syncthreads();
        if (tid < NE) { int t = 0, pre = 0; for (int w = 0; w < G; ++w) { if (w == bx) pre = t; t += lc[w * NE + tid]; } tot[tid] = t; tot[8 + tid] = pre; }
        __syncthreads();
        if (tid == 0) { int b = 0; for (int e = 0; e < NE; ++e) { tot[16 + e] = b; b += (tot[e] + 255) & ~255; } tot[24] = b; }
        __syncthreads();
        if (wave == 0) { int run[NE];
#pragma unroll
            for (int e = 0; e < NE; ++e) run[e] = 0;
            for (int it = 0; it < RPW / 64; ++it) { const int m = bx * RPW + it * 64 + lane; const i32x4 rt = *(const i32x4*)(route + (size_t)m * 4);
                const unsigned long long lt = (1ull << lane) - 1ull;
#pragma unroll
                for (int e = 0; e < NE; ++e) { const bool has = (rt[0] == e) || (rt[1] == e); const unsigned long long mask = __ballot(has);
                    if (has) { const int pos = tot[16 + e] + tot[8 + e] + run[e] + __popcll(mask & lt); const int slot = (rt[1] == e) ? 1 : 0;
                        perm[pos] = m; rinfo[2 * pos] = m * 2 + slot; rinfo[2 * pos + 1] = slot ? rt[3] : rt[2]; }
                    run[e] += __popcll(mask); } } }
        if (bx < NE) { const int e = bx; const int beg = tot[16 + e] + tot[e], end = tot[16 + e] + ((tot[e] + 255) & ~255);
            for (int p = beg + tid; p < end; p += NTHR) { perm[p] = 0; rinfo[2 * p] = -1; rinfo[2 * p + 1] = 0; } }
        if (bx == 0) { if (tid == 0) meta[0] = tot[24] / 256;
            for (int p = tid; p < tot[24] / 256; p += NTHR) { int e = 0;
#pragma unroll
                for (int k = 1; k < NE; ++k) if (p * 256 >= tot[16 + k]) e = k;
                meta[16 + p] = e; } }
        __syncthreads();
    }
    SEAM(15);

    if (IN(16)) for (int rep_ = 0; rep_ < NREP(16); ++rep_) { const int nP = __builtin_amdgcn_readfirstlane(meta[0]);
        pg8::MoeOrder<true> S; S.init(XA, (const bf16_t*)(ws + W_EGU), nP, 2 * EFF, D, G, bx, meta + 16, perm); pg8::EpiSwiGLU<true> E{(bf16_t*)(R + R_H), EFF, rstd4, perm};
        pg8::gemm_phase<pg8::EpiSwiGLU<true>, pg8::MoeOrder<true>, true>(lds, D, S, E); }
    SEAM(16);

    if (IN(17)) for (int rep_ = 0; rep_ < NREP(17); ++rep_) { const int nP = __builtin_amdgcn_readfirstlane(meta[0]);
        pg8::MoeOrder<false> S; S.init((const bf16_t*)(R + R_H), (const bf16_t*)(ws + W_EDN), nP, D, EFF, G, bx, meta + 16, perm); pg8::EpiMoeDown E{rinfo, (bf16_t*)args.out};
        pg8::gemm_phase<pg8::EpiMoeDown, pg8::MoeOrder<false>, false>(lds, EFF, S, E); }
    SEAM(17);

    if (IN(18)) for (int rep_ = 0; rep_ < NREP(18); ++rep_) { const bf16_t* S0 = (const bf16_t*)args.out; const bf16_t* S1 = S0 + (size_t)M * D; float g[16]; ld_row_f32(normg + 7 * D, lane, g);
        for (int i = 0; i < RPW / NWAVES; ++i) { const int m = bx * RPW + wave * (RPW / NWAVES) + i; float mx[16], m2[16], x[16]; ld_row_bf16(S0 + (size_t)m * D, lane, mx); ld_row_bf16(S1 + (size_t)m * D, lane, m2); ld_row_bf16(XA + (size_t)m * D, lane, x);
#pragma unroll
            for (int j = 0; j < 16; ++j) mx[j] += m2[j];
            const float rm = __builtin_amdgcn_rsqf(wave_sum(sumsq16(mx)) * (1.0f / D) + EPS);
#pragma unroll
            for (int j = 0; j < 16; ++j) x[j] += g[j] * mx[j] * rm;
            st_row_bf16(XB + (size_t)m * D, lane, x); } }
    SEAM(18);

    if (IN(19)) for (int rep_ = 0; rep_ < NREP(19); ++rep_) { pg8::StaticOrder S; S.init(PB + (size_t)M * PLE, (const bf16_t*)(ws + W_PPROJ) + (size_t)D * PLE, M, D, PLE, G, bx); pg8::EpiPlain E{(bf16_t*)(R + R_PP1), D};
        pg8::gemm_phase<pg8::EpiPlain, pg8::StaticOrder, false>(lds, PLE, S, E); }
    SEAM(19);

    if (IN(20)) for (int rep_ = 0; rep_ < NREP(20); ++rep_) { pg8::StaticOrder S; S.init(XB, (const bf16_t*)(ws + W_PGATE) + (size_t)D * D, M, D, D, G, bx); pg8::EpiPleGate<true> E{XB, (const bf16_t*)(R + R_PP1), nullptr, nullptr, args.out};
        pg8::gemm_phase<pg8::EpiPleGate<true>, pg8::StaticOrder, false>(lds, D, S, E); }
#undef IN
#undef SEAM
}

constexpr int N_PHASES = 21;
extern "C" void kernel_launch(void* const* d_in, const int* in_sizes, int n_in, void* d_out, int out_size, void* d_ws, size_t ws_size, hipStream_t stream) {
    static int grid = 0;
    if (grid == 0) {
        if (n_in != 22 || in_sizes[0] != M * D || out_size != M * D || ws_size < WS_END) { fprintf(stderr, "kernel_launch: unexpected shapes (n_in %d, in0 %d, out %d, ws %zu < %zu); nothing launched\n", n_in, n_in > 0 ? in_sizes[0] : -1, out_size, ws_size, (size_t)WS_END); grid = -1; return; }
        int dev = 0, cus = 0, per_cu = 0;
        if (hipGetDevice(&dev) != hipSuccess || hipDeviceGetAttribute(&cus, hipDeviceAttributeMultiprocessorCount, dev) != hipSuccess) { grid = -1; return; }
        if (hipFuncSetAttribute((const void*)trunk_fwd, hipFuncAttributeMaxDynamicSharedMemorySize, LDS_BYTES) != hipSuccess) { fprintf(stderr, "kernel_launch: hipFuncSetAttribute failed\n"); grid = -1; return; }
        if (hipOccupancyMaxActiveBlocksPerMultiprocessor(&per_cu, (const void*)trunk_fwd, NTHR, LDS_BYTES) != hipSuccess || per_cu < 1) { fprintf(stderr, "kernel_launch: occupancy query reports %d workgroups per CU\n", per_cu); }
        (void)hipGetLastError();
        grid = cus;
        if (grid > 1024 || (M % (grid * NWAVES)) != 0 || ((M / grid) % 64) != 0) { fprintf(stderr, "kernel_launch: unsupported CU count %d\n", grid); grid = -1; return; }
    }
    if (grid < 0) return;
    if (hipMemsetAsync((char*)d_ws + WS_CTL, 0, CTL_ZERO_BYTES, stream) != hipSuccess) return;
    Args a{};
    for (int i = 0; i < 22; ++i) a.in[i] = (const float*)d_in[i];
    a.out = (float*)d_out; a.ws = (unsigned char*)d_ws; a.pad = 0;
    if (MK_N_LAUNCHES == 1) { a.ph_lo = 0; a.ph_hi = N_PHASES; a.li = 0; hipLaunchKernelGGL(trunk_fwd, dim3(grid), dim3(NTHR), LDS_BYTES, stream, a); }
    else for (int ph = 0; ph < N_PHASES; ++ph) { a.ph_lo = ph; a.ph_hi = ph + 1; a.li = ph; hipLaunchKernelGGL(trunk_fwd, dim3(grid), dim3(NTHR), LDS_BYTES, stream, a); }
}
```

```cpp
#include <hip/hip_runtime.h>
#include <cstdio>
#include <cstdint>

#ifndef MK_N_LAUNCHES
#define MK_N_LAUNCHES 1
#endif

#ifndef PROBE_REP
#define PROBE_REP 0u
#endif
#define NREP(k) (1 + (int)((PROBE_REP >> (k)) & 1u))
#define GAS __attribute__((address_space(1)))
#define LAS __attribute__((address_space(3)))
typedef unsigned short bf16_t;
typedef short bf16x8 __attribute__((ext_vector_type(8)));
typedef float f32x4 __attribute__((ext_vector_type(4)));
typedef float f32x2 __attribute__((ext_vector_type(2)));
typedef unsigned u32x4 __attribute__((ext_vector_type(4)));
typedef unsigned u32x2 __attribute__((ext_vector_type(2)));
typedef int i32x4 __attribute__((ext_vector_type(4)));
typedef int i32x8 __attribute__((ext_vector_type(8)));

constexpr int D = 1024, BATCH = 4, SEQ = 8192, M = BATCH * SEQ;
constexpr int PLE = 256, AB_IN = 2560, FF = 2816, CW = 1024, NE = 8, EFF = 3584;
constexpr float EPS = 1e-6f;
constexpr int NWAVES = 8, NTHR = 512;
constexpr int MAXP = 264;

__device__ __forceinline__ float bflo(unsigned w) { return __uint_as_float(w << 16); }
__device__ __forceinline__ float bfhi(unsigned w) { return __uint_as_float(w & 0xffff0000u); }
__device__ __forceinline__ float bf2f(bf16_t b) { return __uint_as_float((unsigned)b << 16); }
__device__ __forceinline__ unsigned cvt_pk_bf16(float lo, float hi) { unsigned r; asm volatile("v_cvt_pk_bf16_f32 %0, %1, %2" : "=v"(r) : "v"(lo), "v"(hi)); return r; }
__device__ __forceinline__ bf16_t f2bf(float f) { return (bf16_t)(cvt_pk_bf16(f, 0.f) & 0xffffu); }
__device__ __forceinline__ unsigned pk4_fp8(float a, float b, float c, float d) { int w = __builtin_amdgcn_cvt_pk_fp8_f32(a, b, 0, false); w = __builtin_amdgcn_cvt_pk_fp8_f32(c, d, w, true); return (unsigned)w; }
__device__ __forceinline__ u32x2 pack8_fp8(const float* v) { u32x2 w; w.x = pk4_fp8(v[0], v[1], v[2], v[3]); w.y = pk4_fp8(v[4], v[5], v[6], v[7]); return w; }
constexpr float SC_GU = 64.0f, SC_DN = 64.0f;
__device__ __forceinline__ float fsigmoid(float x) { return __builtin_amdgcn_rcpf(1.0f + __builtin_amdgcn_exp2f(-1.4426950408889634f * x)); }
__device__ __forceinline__ float fsilu(float x) { return x * fsigmoid(x); }
__device__ __forceinline__ float fgelu_tanh(float x) { const float u = x + 0.044715f * x * x * x; return x * __builtin_amdgcn_rcpf(1.0f + __builtin_amdgcn_exp2f(-2.3022082f * u)); }
__device__ __forceinline__ int get_lane() { int t; asm volatile("v_and_b32 %0, 63, %1" : "=v"(t) : "v"(threadIdx.x)); return t; }
__device__ __forceinline__ int get_wave() { int t; asm volatile("v_lshrrev_b32 %0, 6, %1" : "=v"(t) : "v"(threadIdx.x)); return __builtin_amdgcn_readfirstlane(t); }
__device__ __forceinline__ float wave_sum(float v) {
#pragma unroll
    for (int o = 1; o < 64; o <<= 1) v += __shfl_xor(v, o);
    return v;
}
__device__ __forceinline__ void unpack8(const u32x4 a, float* v) { v[0] = bflo(a.x); v[1] = bfhi(a.x); v[2] = bflo(a.y); v[3] = bfhi(a.y); v[4] = bflo(a.z); v[5] = bfhi(a.z); v[6] = bflo(a.w); v[7] = bfhi(a.w); }
__device__ __forceinline__ u32x4 pack8(const float* v) { u32x4 w; w.x = cvt_pk_bf16(v[0], v[1]); w.y = cvt_pk_bf16(v[2], v[3]); w.z = cvt_pk_bf16(v[4], v[5]); w.w = cvt_pk_bf16(v[6], v[7]); return w; }

namespace pg8 {
constexpr int BM = 256, BK = 64, HALF = 128, HTB = HALF * BK * 2, STAGE_BYTES = 8 * HTB, NXCD = 8, WGM = 8;
__host__ __device__ __forceinline__ int lds_byte(int r, int c) { const int st = (r >> 4) * 2 + (c >> 5), rr = r & 15, cc = c & 31, ob = rr * 64 + cc * 2; return st * 1024 + (ob ^ (((ob >> 9) & 1) << 5)); }
__host__ __device__ __forceinline__ void stage_rc(int b, int& R, int& C) { const int st = b / 1024, sb = b % 1024, swz = sb ^ (((sb >> 9) & 1) << 5); R = (st >> 1) * 16 + swz / 64; C = (st & 1) * 32 + (swz % 64) / 2; }
__host__ __device__ __forceinline__ int perm32(int rho) { const int n = rho >> 4, i = rho & 15; return 8 * (i >> 2) + 4 * n + (i & 3); }

struct Unit { int pm, pn; const char* a; const char* b; };
__device__ __forceinline__ const char* uni(const char* p) { const unsigned long long v = (unsigned long long)p; const unsigned lo = __builtin_amdgcn_readfirstlane((unsigned)v), hi = __builtin_amdgcn_readfirstlane((unsigned)(v >> 32)); return (const char*)(((unsigned long long)hi << 32) | lo); }

__device__ __forceinline__ bool tile_of(int i, int G, int c, int nM, int nN, int& pm, int& pn) {
    const int nwg = nM * nN; const int L = i * G + c; if (L >= nwg) return false;
    int wgid = L; { const int q = nwg / NXCD, r = nwg % NXCD, xcd = wgid % NXCD, off = wgid / NXCD; wgid = (xcd < r ? xcd * (q + 1) : r * (q + 1) + (xcd - r) * q) + off; }
    const int nig = WGM * nN, gid = wgid / nig, fm = gid * WGM, gsz = (nM - fm) < WGM ? (nM - fm) : WGM;
    pm = fm + ((wgid % nig) % gsz); pn = (wgid % nig) / gsz; return true;
}
struct StaticOrder {
    int nM, nN, G, c; const char* A; const char* Bt; size_t tstep;
    __device__ __forceinline__ void init(const bf16_t* A_, const bf16_t* Bt_, int M_, int N_, int K_, int G_, int c_) { nM = M_ / BM; nN = N_ / BM; G = G_; c = c_; A = (const char*)A_; Bt = (const char*)Bt_; tstep = (size_t)BM * K_ * 2; }
    __device__ __forceinline__ const int* perm_of(const Unit&) const { return nullptr; }
    __device__ __forceinline__ bool next(int i, Unit& u) const { if (!tile_of(i, G, c, nM, nN, u.pm, u.pn)) return false; u.pm = __builtin_amdgcn_readfirstlane(u.pm); u.pn = __builtin_amdgcn_readfirstlane(u.pn); u.a = uni(A + (size_t)u.pm * tstep); u.b = uni(Bt + (size_t)u.pn * tstep); return true; }
    __device__ __forceinline__ int gather_tok(const Unit&, int) const { return 0; }
};
template <bool GATHER> struct MoeOrder {
    int nM, nN, G, c; const char* A; const char* Bt; size_t tstep, estride; int pb[7]; const int* perm;
    __device__ __forceinline__ void init(const void* A_, const void* Bt_, const int* meta, int N_, int rowB, int G_, int c_, const int* perm_) {
        nM = __builtin_amdgcn_readfirstlane(meta[0]); nN = N_ / BM; G = G_; c = c_; A = (const char*)A_; Bt = (const char*)Bt_; tstep = (size_t)BM * rowB; estride = (size_t)N_ * rowB; perm = perm_;
#pragma unroll
        for (int k = 0; k < 7; ++k) pb[k] = __builtin_amdgcn_readfirstlane(meta[2 + k]); }
    __device__ __forceinline__ bool next(int i, Unit& u) const { if (!tile_of(i, G, c, nM, nN, u.pm, u.pn)) return false;
        u.pm = __builtin_amdgcn_readfirstlane(u.pm); u.pn = __builtin_amdgcn_readfirstlane(u.pn); int e = 0;
#pragma unroll
        for (int k = 0; k < 7; ++k) e += (u.pm * BM >= pb[k]) ? 1 : 0;
        u.a = uni(GATHER ? A : A + (size_t)u.pm * tstep); u.b = uni(Bt + (size_t)e * estride + (size_t)u.pn * tstep); return true; }
    __device__ __forceinline__ int gather_tok(const Unit& u, int r) const { return perm[u.pm * BM + r]; }
    __device__ __forceinline__ const int* perm_of(const Unit& u) const { return perm + u.pm * BM; }
};

constexpr int PERMBUF_OFF = 131072 + 4096;
template <class Epi, class Sched, bool GATHER, bool FP8 = false>
__device__ __forceinline__ void gemm_phase(LAS unsigned char* lds, const int rowB, const Sched& S, const Epi& E) {
    const int tid = threadIdx.x, wid = __builtin_amdgcn_readfirstlane(tid >> 6), lane = tid & 63, wr = wid >> 2, wc = wid & 3, fr = lane & 15, fq = lane >> 4;
    const int nt = rowB / 128;
    const size_t kstep = (size_t)128;
    const size_t hstep = (size_t)HALF * rowB;
    const int fp8_one = 0x7F7F7F7F;
    unsigned voffB[2]; int sR[2], sC[2];
#pragma unroll
    for (int i = 0; i < 2; ++i) { int R, C; stage_rc(tid * 16 + i * 8192, R, C); const int Rb = (R & ~31) + perm32(R & 31); sR[i] = R; sC[i] = 2 * C; voffB[i] = (unsigned)(Rb * rowB + 2 * C); }
    const unsigned lbase = (unsigned)__builtin_amdgcn_readfirstlane((int)((unsigned)(size_t)lds + (unsigned)wid * 1024u));
    const int aoff = lds_byte(wr * 64 + fr, fq * 8), boff = lds_byte(wc * 32 + fr, fq * 8);
#define PG8_SA(b, h) (((b) * 2 + (h)) * HTB)
#define PG8_SB(b, h) ((4 + (b) * 2 + (h)) * HTB)
#define PG8_GLDS(ldsdst, voff, sbase) asm volatile("s_mov_b32 m0, %0\n\tglobal_load_lds_dwordx4 %1, %2" :: "s"(ldsdst), "v"(voff), "s"(sbase) : "memory", "m0")
#define PG8_STAGE_B(bufoff, gbase) do { _Pragma("unroll") for (int _i = 0; _i < 2; ++_i) PG8_GLDS(lbase + (unsigned)((bufoff) + _i * 8192), voffB[_i], (const char*)(gbase)); } while (0)
#define PG8_STAGE_A(bufoff, gbase, off, h) do { _Pragma("unroll") for (int _i = 0; _i < 2; ++_i) PG8_GLDS(lbase + (unsigned)((bufoff) + _i * 8192), (off)[GATHER ? (h) : 0][_i], GATHER ? (const char*)(gbase) : (const char*)(gbase) + (h) * hstep); } while (0)
#define PG8_LDA(dst, b, h) do { _Pragma("unroll") for (int m = 0; m < 4; ++m) _Pragma("unroll") for (int k = 0; k < 2; ++k) dst[m][k] = *(const LAS bf16x8*)(lds + PG8_SA(b, h) + aoff + m * 2048 + k * 1024); } while (0)
#define PG8_LDB(dst, b, h) do { _Pragma("unroll") for (int n = 0; n < 2; ++n) _Pragma("unroll") for (int k = 0; k < 2; ++k) dst[n][k] = *(const LAS bf16x8*)(lds + PG8_SB(b, h) + boff + n * 2048 + k * 1024); } while (0)
#define PG8_CAT(x, y) __builtin_shufflevector(__builtin_bit_cast(i32x4, (x)), __builtin_bit_cast(i32x4, (y)), 0, 1, 2, 3, 4, 5, 6, 7)
#define PG8_MMA(ai, bj, At, Bt) do { __builtin_amdgcn_s_setprio(1); _Pragma("unroll") for (int m = 0; m < 4; ++m) _Pragma("unroll") for (int n = 0; n < 2; ++n) { \
        if constexpr (FP8) acc[ai][bj][m][n] = __builtin_amdgcn_mfma_scale_f32_16x16x128_f8f6f4(PG8_CAT(Bt[n][0], Bt[n][1]), PG8_CAT(At[m][0], At[m][1]), acc[ai][bj][m][n], 0, 0, 0, fp8_one, 0, fp8_one); \
        else { _Pragma("unroll") for (int k = 0; k < 2; ++k) acc[ai][bj][m][n] = __builtin_amdgcn_mfma_f32_16x16x32_bf16(Bt[n][k], At[m][k], acc[ai][bj][m][n], 0, 0, 0); } } \
        __builtin_amdgcn_s_setprio(0); } while (0)
#define PG8_WAIT_V(n) asm volatile("s_waitcnt vmcnt(" #n ")" ::: "memory")
#define PG8_WAIT_L(n) asm volatile("s_waitcnt lgkmcnt(" #n ")" ::: "memory")
#define PG8_BAR __builtin_amdgcn_s_barrier()
#define PG8_SCHED __builtin_amdgcn_sched_barrier(0)
    Unit cur, nxt; int ui = 0;
    if (!S.next(0, cur)) return;
    unsigned coff[2][2];
#pragma unroll
    for (int h = 0; h < 2; ++h)
#pragma unroll
        for (int i = 0; i < 2; ++i) {
            if constexpr (GATHER) coff[h][i] = (unsigned)(S.gather_tok(cur, h * HALF + sR[i]) * rowB + sC[i]);
            else coff[h][i] = (unsigned)(sR[i] * rowB + sC[i]);
        }
    f32x4 acc[2][2][4][2];
#pragma unroll
    for (int a = 0; a < 2; ++a)
#pragma unroll
        for (int b = 0; b < 2; ++b)
#pragma unroll
            for (int m = 0; m < 4; ++m)
#pragma unroll
                for (int n = 0; n < 2; ++n) acc[a][b][m][n] = (f32x4){0.f, 0.f, 0.f, 0.f};
    bf16x8 At[4][2], B0[2][2], B1[2][2];
    const char* cA = cur.a; const char* cB = cur.b;
    PG8_STAGE_B(PG8_SB(0, 0), cB); PG8_STAGE_B(PG8_SB(0, 1), cB + hstep); PG8_STAGE_A(PG8_SA(0, 0), cA, coff, 0); PG8_STAGE_A(PG8_SA(0, 1), cA, coff, 1);
    if (wr == 1) PG8_BAR;
    PG8_WAIT_V(2); PG8_BAR;
    PG8_STAGE_B(PG8_SB(1, 0), cB + kstep); PG8_STAGE_A(PG8_SA(1, 0), cA + kstep, coff, 0); PG8_STAGE_B(PG8_SB(1, 1), cB + hstep + kstep);
    PG8_WAIT_V(6); PG8_BAR;
    for (;;) {
        const bool has_next = S.next(ui + 1, nxt);
        const char* nA = has_next ? nxt.a : cA; const char* nB = has_next ? nxt.b : cB;
        if constexpr (GATHER) {
            if (has_next) asm volatile("s_mov_b32 m0, %0\n\tglobal_load_lds_dword %1, %2" :: "s"((unsigned)__builtin_amdgcn_readfirstlane((int)((unsigned)(size_t)lds + (unsigned)(PERMBUF_OFF + wr * 1024 + (wid & 3) * 256)))), "v"((unsigned)(lane * 4)), "s"(uni((const char*)(S.perm_of(nxt) + (wid & 3) * 64))) : "memory", "m0");
        }
        for (int t = 0; t < nt; t += 2) {
            const bool last = (t == nt - 2);
            const char* a1 = cA + (size_t)(t + 1) * kstep;
            const char* a2 = last ? nA : cA + (size_t)(t + 2) * kstep; const char* b2 = last ? nB : cB + (size_t)(t + 2) * kstep;
            const char* a3 = a2 + kstep; const char* b3 = b2 + kstep;
            PG8_LDB(B0, 0, 0); PG8_LDB(B1, 0, 1); PG8_SCHED; PG8_LDA(At, 0, 0); PG8_STAGE_A(PG8_SA(1, 1), a1, coff, 1);
            if constexpr (GATHER) { if (last && has_next) {
                int t_ = tid; asm volatile("" : "+v"(t_));
#pragma unroll
                for (int i = 0; i < 2; ++i) { int R_, C_; stage_rc(t_ * 16 + i * 8192, R_, C_);
#pragma unroll
                    for (int h = 0; h < 2; ++h) { int tok; asm volatile("ds_read_b32 %0, %1" : "=v"(tok) : "v"((unsigned)(size_t)lds + (unsigned)(PERMBUF_OFF + wr * 1024 + (h * HALF + R_) * 4)) : "memory");
                        asm volatile("s_waitcnt lgkmcnt(0)" : "+v"(tok) :: "memory"); coff[h][i] = (unsigned)(tok * rowB + 2 * C_); } } } }
            PG8_WAIT_V(8); PG8_WAIT_L(0); PG8_BAR; PG8_MMA(0, 0, At, B0); PG8_MMA(0, 1, At, B1); PG8_BAR; PG8_SCHED;
            PG8_LDA(At, 0, 1); PG8_STAGE_B(PG8_SB(0, 0), b2); PG8_STAGE_B(PG8_SB(0, 1), b2 + hstep); PG8_STAGE_A(PG8_SA(0, 0), a2, coff, 0);
            PG8_WAIT_V(8); PG8_WAIT_L(0); PG8_BAR; PG8_MMA(1, 0, At, B0); PG8_MMA(1, 1, At, B1); PG8_BAR; PG8_SCHED;
            PG8_LDB(B0, 1, 0); PG8_LDB(B1, 1, 1); PG8_SCHED; PG8_LDA(At, 1, 0); PG8_STAGE_A(PG8_SA(0, 1), a2, coff, 1);
            PG8_WAIT_V(8); PG8_WAIT_L(0); PG8_BAR; PG8_MMA(0, 0, At, B0); PG8_MMA(0, 1, At, B1); PG8_BAR; PG8_SCHED;
            PG8_LDA(At, 1, 1); PG8_STAGE_B(PG8_SB(1, 0), b3); PG8_STAGE_B(PG8_SB(1, 1), b3 + hstep); PG8_STAGE_A(PG8_SA(1, 0), a3, coff, 0);
            PG8_WAIT_V(8); PG8_WAIT_L(0); PG8_BAR; PG8_MMA(1, 0, At, B0); PG8_MMA(1, 1, At, B1); PG8_BAR; PG8_SCHED;
        }
        if (wr == 0) PG8_BAR;
        { const int l2 = get_lane(); E(acc, cur, wr, wc, l2 & 15, l2 >> 4); }
        if (!has_next) break;
#pragma unroll
        for (int a = 0; a < 2; ++a)
#pragma unroll
            for (int b = 0; b < 2; ++b)
#pragma unroll
                for (int m = 0; m < 4; ++m)
#pragma unroll
                    for (int n = 0; n < 2; ++n) acc[a][b][m][n] = (f32x4){0.f, 0.f, 0.f, 0.f};
        cur = nxt; cA = nA; cB = nB; ++ui;
        if (wr == 1) PG8_BAR;
    }
    PG8_WAIT_V(0);
    PG8_BAR;
#undef PG8_SA
#undef PG8_SB
#undef PG8_STAGE_A
#undef PG8_STAGE_B
#undef PG8_LDA
#undef PG8_LDB
#undef PG8_MMA
#undef PG8_WAIT_V
#undef PG8_WAIT_L
#undef PG8_BAR
#undef PG8_SCHED
}

typedef f32x4 AccT[2][2][4][2];
#define EPI_ROWS_BEGIN const int row0 = u.pm * BM + wr * 64 + fr; const int colw = wc * 32 + 8 * fq; \
    _Pragma("unroll") for (int ai = 0; ai < 2; ++ai) _Pragma("unroll") for (int m = 0; m < 4; ++m) { const int r = row0 + ai * HALF + m * 16;
#define EPI_ROWS_END }

struct EpiInAB {
    bf16_t* Z; const float* rstd;
    __device__ __forceinline__ void operator()(const AccT& acc, const Unit& u, int wr, int wc, int fr, int fq) const {
        const bool act = u.pn < 4;
        EPI_ROWS_BEGIN
            const float rs = rstd[r]; bf16_t* rowp = Z + (size_t)r * AB_IN + u.pn * BM + colw;
#pragma unroll
            for (int bj = 0; bj < 2; ++bj) { float v[8];
#pragma unroll
                for (int j = 0; j < 4; ++j) { v[j] = acc[ai][bj][m][0][j] * rs; v[4 + j] = acc[ai][bj][m][1][j] * rs; }
                if (act) {
#pragma unroll
                    for (int j = 0; j < 8; ++j) v[j] = fgelu_tanh(v[j]); }
                *(u32x4*)(rowp + bj * HALF) = pack8(v); }
        EPI_ROWS_END
    }
};
struct EpiPlain {
    bf16_t* O; int ldc;
    __device__ __forceinline__ void operator()(const AccT& acc, const Unit& u, int wr, int wc, int fr, int fq) const {
        EPI_ROWS_BEGIN
            bf16_t* rowp = O + (size_t)r * ldc + u.pn * BM + colw;
#pragma unroll
            for (int bj = 0; bj < 2; ++bj) { float v[8];
#pragma unroll
                for (int j = 0; j < 4; ++j) { v[j] = acc[ai][bj][m][0][j]; v[4 + j] = acc[ai][bj][m][1][j]; }
                *(u32x4*)(rowp + bj * HALF) = pack8(v); }
        EPI_ROWS_END
    }
};
template <bool MOE> struct EpiSwiGLU {
    bf16_t* H; int ldh; const float* rstd; const int* perm;
    __device__ __forceinline__ void operator()(const AccT& acc, const Unit& u, int wr, int wc, int fr, int fq) const {
        EPI_ROWS_BEGIN
            const int tok = MOE ? perm[r] : r; const float rs = rstd[tok];
            float v[8];
#pragma unroll
            for (int n = 0; n < 2; ++n)
#pragma unroll
                for (int j = 0; j < 4; ++j) { const float g = acc[ai][0][m][n][j] * rs, up = acc[ai][1][m][n][j] * rs; v[4 * n + j] = fsilu(g) * up; }
            *(u32x4*)(H + (size_t)r * ldh + u.pn * HALF + colw) = pack8(v);
        EPI_ROWS_END
    }
};
struct EpiSwiGLU8 {
    unsigned char* H; int ldh;
    __device__ __forceinline__ void operator()(const AccT& acc, const Unit& u, int wr, int wc, int fr, int fq) const {
        EPI_ROWS_BEGIN
            float v[8];
#pragma unroll
            for (int n = 0; n < 2; ++n)
#pragma unroll
                for (int j = 0; j < 4; ++j) { const float g = acc[ai][0][m][n][j] * (1.0f / SC_GU), up = acc[ai][1][m][n][j] * (1.0f / SC_GU); v[4 * n + j] = fsilu(g) * up; }
            *(u32x2*)(H + (size_t)r * ldh + u.pn * HALF + colw) = pack8_fp8(v);
        EPI_ROWS_END
    }
};
struct EpiInC {
    bf16_t* QFIG; const float* ssp; const float* lb;
    __device__ __forceinline__ void operator()(const AccT& acc, const Unit& u, int wr, int wc, int fr, int fq) const {
        const int type = u.pn >> 2; const int colt = (u.pn & 3) * BM + wc * 32 + 8 * fq;
        bf16_t* base = QFIG + (size_t)type * M * CW;
        EPI_ROWS_BEGIN
            const f32x4* sp = (const f32x4*)(ssp + (size_t)r * 16); const f32x4 s0 = sp[0], s1 = sp[1], s2 = sp[2], s3 = sp[3];
            const float ss = ((s0[0] + s0[1]) + (s0[2] + s0[3])) + ((s1[0] + s1[1]) + (s1[2] + s1[3])) + ((s2[0] + s2[1]) + (s2[2] + s2[3])) + ((s3[0] + s3[1]) + (s3[2] + s3[3]));
            const float rs = __builtin_amdgcn_rsqf(ss * (1.0f / D) + EPS);
#pragma unroll
            for (int bj = 0; bj < 2; ++bj) { float v[8];
#pragma unroll
                for (int j = 0; j < 4; ++j) { v[j] = acc[ai][bj][m][0][j] * rs; v[4 + j] = acc[ai][bj][m][1][j] * rs; }
                if (type == 0 || type == 3) {
#pragma unroll
                    for (int j = 0; j < 8; ++j) v[j] = fsilu(v[j]);
                } else if (type == 1) {
                    const f32x4 l0 = *(const f32x4*)(lb + colt + bj * HALF), l1 = *(const f32x4*)(lb + colt + bj * HALF + 4);
#pragma unroll
                    for (int j = 0; j < 8; ++j) { const float l = j < 4 ? l0[j] : l1[j - 4]; v[j] = __builtin_amdgcn_logf(l + (1.0f - l) * fsigmoid(v[j])); }
                }
                *(u32x4*)(base + (size_t)r * CW + colt + bj * HALF) = pack8(v); }
        EPI_ROWS_END
    }
};
template <bool FINAL> struct EpiPleGate {
    const bf16_t* X; const bf16_t* PP; bf16_t* XO; float* ssp; float* OUT;
    __device__ __forceinline__ void operator()(const AccT& acc, const Unit& u, int wr, int wc, int fr, int fq) const {
        EPI_ROWS_BEGIN
            const size_t off = (size_t)r * D + u.pn * BM + colw; float ssq = 0.f;
#pragma unroll
            for (int bj = 0; bj < 2; ++bj) { float x[8], p[8];
                unpack8(*(const u32x4*)(X + off + bj * HALF), x); unpack8(*(const u32x4*)(PP + off + bj * HALF), p);
#pragma unroll
                for (int j = 0; j < 8; ++j) { const float a = j < 4 ? acc[ai][bj][m][0][j] : acc[ai][bj][m][1][j - 4]; x[j] = x[j] + fsigmoid(a) * p[j]; ssq += x[j] * x[j]; }
                if (FINAL) { *(f32x4*)(OUT + off + bj * HALF) = (f32x4){x[0], x[1], x[2], x[3]}; *(f32x4*)(OUT + off + bj * HALF + 4) = (f32x4){x[4], x[5], x[6], x[7]}; }
                else *(u32x4*)(XO + off + bj * HALF) = pack8(x); }
            if (!FINAL) { ssq += __shfl_xor(ssq, 16); ssq += __shfl_xor(ssq, 32); if (fq == 0) ssp[(size_t)r * 16 + u.pn * 4 + wc] = ssq; }
        EPI_ROWS_END
    }
};
struct EpiMoeDown {
    const int* rowinfo; bf16_t* slots;
    __device__ __forceinline__ void operator()(const AccT& acc, const Unit& u, int wr, int wc, int fr, int fq) const {
        EPI_ROWS_BEGIN
            const int info = rowinfo[2 * r]; const float w = __int_as_float(rowinfo[2 * r + 1]) * (1.0f / SC_DN);
            if (info >= 0) { bf16_t* rowp = slots + (size_t)(info & 1) * M * D + (size_t)(info >> 1) * D + u.pn * BM + colw;
#pragma unroll
                for (int bj = 0; bj < 2; ++bj) { float v[8];
#pragma unroll
                    for (int j = 0; j < 4; ++j) { v[j] = acc[ai][bj][m][0][j] * w; v[4 + j] = acc[ai][bj][m][1][j] * w; }
                    *(u32x4*)(rowp + bj * HALF) = pack8(v); } }
        EPI_ROWS_END
    }
};
}

constexpr size_t MiB = 1u << 20;
constexpr size_t WS_CTL = 0, CTL_ZERO_BYTES = 1 * MiB;
constexpr size_t WS_SMALL = 1 * MiB;
constexpr size_t SM_RSTD0 = WS_SMALL, SM_RSTD1 = SM_RSTD0 + 128 * 1024, SM_RSTD4 = SM_RSTD1 + 128 * 1024;
constexpr size_t SM_LB = SM_RSTD4 + 128 * 1024;
constexpr size_t SM_ROUTE = SM_LB + 4096;
constexpr size_t SM_CNT = SM_ROUTE + 512 * 1024;
constexpr size_t SM_META = SM_CNT + 32 * 1024;
constexpr size_t SM_PERM = SM_META + 4096;
constexpr size_t SM_RINFO = SM_PERM + 512 * 1024;
constexpr size_t SM_SSP = SM_RINFO + 1024 * 1024;
constexpr size_t SM_DLOG = SM_SSP + 2 * MiB;
static_assert(SM_DLOG + 128 * 1024 <= 9 * MiB, "small arrays");
constexpr size_t WS_W = 9 * MiB;
constexpr size_t W_INAB = WS_W, W_OUTAB = W_INAB + 5 * MiB, W_GU0 = W_OUTAB + 2 * MiB, W_DN0 = W_GU0 + 11 * MiB, W_INC = W_DN0 + 5 * MiB + 512 * 1024,
                 W_OUTC = W_INC + 8 * MiB, W_EGU8 = W_OUTC + 2 * MiB, W_EDN8 = W_EGU8 + 56 * MiB, W_PPROJ = W_EDN8 + 28 * MiB, W_PGATE = W_PPROJ + 1 * MiB, W_END = W_PGATE + 4 * MiB;
constexpr size_t WS_PB = W_END;
constexpr size_t WS_XA = WS_PB + 32 * MiB, WS_XB = WS_XA + 64 * MiB;
constexpr size_t WS_X8 = WS_XB + 64 * MiB;
constexpr size_t WS_R = WS_X8 + 32 * MiB;
constexpr size_t R_BYTES = (size_t)MAXP * 256 * EFF * 2;
constexpr size_t WS_END = WS_R + R_BYTES;
constexpr size_t R_Z = 0, R_Y = 160 * MiB, R_MIX = 224 * MiB, R_PP = 288 * MiB, R_HF = 0;
constexpr size_t R_QFIG = 0, R_O = 256 * MiB, R_OG = 384 * MiB, R_MIX1 = 0, R_H = 0, R_PP1 = 0;

constexpr int CW_BAR = 4096;

constexpr int RING_BYTES = 131072;
constexpr int LDSCTL_OFF = RING_BYTES, MISC_OFF = LDSCTL_OFF + 320;
constexpr int LDS_BYTES = 147456;

#define XB_TMO      128
#define XB_XCNT(j)  (256  + 64 * (j))
#define XB_XSUB(j)  (1280 + 64 * (j))
#define XB_XGEN(j)  (2304 + 64 * (j))
#define XB_TOP      3328
#define XB_TOPGEN   3392
#define XCD_BAR_WORDS 3456
#define XB_SPIN_CAP (1u << 18)
__device__ __forceinline__ unsigned xb_ld(unsigned* p)              { return __hip_atomic_load(p, __ATOMIC_RELAXED, __HIP_MEMORY_SCOPE_AGENT); }
__device__ __forceinline__ unsigned xb_add(unsigned* p, unsigned v) { return __hip_atomic_fetch_add(p, v, __ATOMIC_RELAXED, __HIP_MEMORY_SCOPE_AGENT); }
__device__ __forceinline__ unsigned xb_xcc_id() { return (unsigned)__builtin_amdgcn_s_getreg((3 << 11) | 20) & 0xFu; }
#define XB_SPIN(cond, bar) do { unsigned _sp = 0; while (cond) { __builtin_amdgcn_s_sleep(1); \
    if ((++_sp & 255u) == 0u) { if (xb_ld(&(bar)[XB_TMO])) break; if (_sp > XB_SPIN_CAP) { atomicAdd(&(bar)[XB_TMO], 1u); break; } } } } while (0)
struct XcdBarrier { unsigned* bar; unsigned x; volatile LAS unsigned* st; };
__device__ __forceinline__ XcdBarrier xcd_barrier_post(unsigned* bar, volatile LAS unsigned* st) {
    XcdBarrier b; b.bar = bar; b.x = xb_xcc_id(); b.st = st;
    if (threadIdx.x == 0) (void)xb_add(&bar[XB_XCNT(b.x)], 1u);
    return b;
}
__device__ __forceinline__ void xcd_barrier_complete(unsigned* bar, unsigned x, unsigned& nloc, unsigned& nx) {
    const unsigned G = gridDim.x * gridDim.y * gridDim.z;
    unsigned sum, cnt, mine, sp = 0u;
    for (;;) {
        sum = 0u; cnt = 0u; mine = 0u;
#pragma unroll
        for (unsigned j = 0; j < 16; ++j) { const unsigned c = xb_ld(&bar[XB_XCNT(j)]); sum += c; cnt += (c > 0u) ? 1u : 0u; mine = (j == x) ? c : mine; }
        if (sum == G) break;
        __builtin_amdgcn_s_sleep(1);
        if ((++sp & 255u) == 0u) { if (xb_ld(&bar[XB_TMO])) break; if (sp > XB_SPIN_CAP) { atomicAdd(&bar[XB_TMO], 1u); break; } }
    }
    nloc = mine > 0u ? mine : 1u; nx = cnt > 0u ? cnt : 1u;
}
__device__ __forceinline__ void xcd_barrier(const XcdBarrier& b) {
    asm volatile("s_waitcnt vmcnt(0)" ::: "memory");
    __syncthreads();
    if (threadIdx.x == 0) {
        unsigned* bar = b.bar;
        __builtin_amdgcn_s_waitcnt(0);
        unsigned nloc = b.st[0], nx = b.st[1];
        if (nloc == 0u) { xcd_barrier_complete(bar, b.x, nloc, nx); b.st[0] = nloc; b.st[1] = nx; }
        const unsigned old = xb_add(&bar[XB_XSUB(b.x)], 1u);
        const unsigned gen = old / nloc;
        if (old + 1u == (gen + 1u) * nloc) {
            __builtin_amdgcn_fence(__ATOMIC_RELEASE, "agent");
            asm volatile("s_waitcnt vmcnt(0)" ::: "memory");
            const unsigned og = xb_add(&bar[XB_TOP], 1u);
            const unsigned tg = og / nx;
            if (og + 1u == (tg + 1u) * nx) xb_add(&bar[XB_TOPGEN], 1u);
            else XB_SPIN(xb_ld(&bar[XB_TOPGEN]) == tg, bar);
            __builtin_amdgcn_fence(__ATOMIC_ACQUIRE, "agent");
            xb_add(&bar[XB_XGEN(b.x)], 1u);
            asm volatile("s_waitcnt vmcnt(0)" ::: "memory");
        } else {
            XB_SPIN(xb_ld(&bar[XB_XGEN(b.x)]) == gen, bar);
            __builtin_amdgcn_fence(__ATOMIC_ACQUIRE, "agent");
            asm volatile("s_waitcnt vmcnt(0)" ::: "memory");
        }
    }
    __syncthreads();
}


namespace hg {
constexpr int QS_OFF = 0, QS_RS = 272, KS_OFF = 17408, KS_RS = 288, IS_OFF = 35840, IS_RS = 288, PS_OFF = 54272, PS_RS = 144,
              TOT_OFF = 63488, RSC_OFF = 67584, DSC_OFF = 68096, RED_OFF = 68608;
typedef short s16x4 __attribute__((ext_vector_type(4)));
#define HG_MFMA(a, b, c) __builtin_amdgcn_mfma_f32_16x16x32_bf16((a), (b), (c), 0, 0, 0)
__device__ __forceinline__ bf16x8 rowfrag(const LAS unsigned char* img, int rs, int row, int step, int g) {
    const LAS s16x4* p = (const LAS s16x4*)(img + row * rs + (32 * step + 4 * g) * 2); const s16x4 lo = p[0], hi = p[4];
    return __builtin_shufflevector(lo, hi, 0, 1, 2, 3, 4, 5, 6, 7);
}
__device__ __forceinline__ bf16x8 trfrag(unsigned img_addr, int rs, int sb, int cb, int c, int g) {
    const unsigned a0 = img_addr + (unsigned)((32 * sb + 4 * g + (c >> 2)) * rs + 32 * cb + 8 * (c & 3)), a1 = a0 + (unsigned)(16 * rs);
    s16x4 lo, hi;
    asm volatile("ds_read_b64_tr_b16 %0, %2\n\tds_read_b64_tr_b16 %1, %3\n\ts_waitcnt lgkmcnt(0)" : "=&v"(lo), "=&v"(hi) : "v"(a0), "v"(a1) : "memory");
    return __builtin_shufflevector(lo, hi, 0, 1, 2, 3, 4, 5, 6, 7);
}
__device__ __forceinline__ bf16x8 pack_acc(const f32x4 a, const f32x4 b) {
    u32x4 p; p.x = cvt_pk_bf16(a[0], a[1]); p.y = cvt_pk_bf16(a[2], a[3]); p.z = cvt_pk_bf16(b[0], b[1]); p.w = cvt_pk_bf16(b[2], b[3]);
    return __builtin_bit_cast(bf16x8, p);
}
template <int PASS>
__device__ __forceinline__ void run(LAS unsigned char* lds, const bf16_t* Qb, const bf16_t* Fb, const bf16_t* Ib, const bf16_t* Gb,
                                    const float* onormg, float* Useg, float* Dlog, bf16_t* OG, int item) {
    const int tid = threadIdx.x, lane = tid & 63, w = __builtin_amdgcn_readfirstlane(tid >> 6), c = lane & 15, g = lane >> 4;
    const int b = item >> 6, h = (item >> 3) & 7, seg = item & 7;
    const size_t row0 = (size_t)b * SEQ + (size_t)seg * 1024;
    const int colh = h * 128;
    const int kp = lane, tg = w;
    const int isr = tid >> 3, ipc = tid & 7;
    const unsigned lds_addr = (unsigned)(size_t)lds;
    f32x4 S[8];
#pragma unroll
    for (int kt = 0; kt < 8; ++kt) S[kt] = (f32x4){0.f, 0.f, 0.f, 0.f};
    if (PASS == 2) {
        for (int j = 0; j < seg; ++j) { const int it = item - seg + j;
#pragma unroll
            for (int kt = 0; kt < 8; ++kt) { const f32x4 dl = *(const f32x4*)(Dlog + (size_t)it * 128 + 16 * kt + 4 * g);
                const f32x4 uu = *((const f32x4*)Useg + ((size_t)(it * 8 + w) * 8 + kt) * 64 + lane);
#pragma unroll
                for (int r = 0; r < 4; ++r) S[kt][r] = __builtin_amdgcn_exp2f(dl[r]) * S[kt][r] + uu[r]; } }
    }
    f32x4 og4 = (f32x4){0.f, 0.f, 0.f, 0.f}; if (PASS == 2) og4 = *(const f32x4*)(onormg + colh + 16 * w + 4 * g);
    float bsum0 = 0.f, bsum1 = 0.f;
    unsigned lfw[8], qw[8]; u32x4 iw0, iw1;
#pragma unroll
    for (int j = 0; j < 8; ++j) { const size_t r = row0 + 8 * tg + j; lfw[j] = *(const unsigned*)(Fb + r * CW + colh + 2 * kp); qw[j] = PASS == 2 ? *(const unsigned*)(Qb + r * CW + colh + 2 * kp) : 0u; }
    { const size_t r = row0 + isr; iw0 = *(const u32x4*)(Ib + r * CW + colh + ipc * 16); iw1 = *(const u32x4*)(Ib + r * CW + colh + ipc * 16 + 8); }
    for (int ch = 0; ch < 16; ++ch) {
        const size_t crow = row0 + (size_t)ch * 64;
        float b0[8], b1[8]; { float a0 = 0.f, a1 = 0.f;
#pragma unroll
            for (int j = 0; j < 8; ++j) { a0 += bflo(lfw[j]); a1 += bfhi(lfw[j]); b0[j] = a0; b1[j] = a1; }
            *(LAS f32x2*)(lds + TOT_OFF + (tg * 128 + 2 * kp) * 4) = (f32x2){a0, a1}; }
        u32x2 gw[4];
        if (PASS == 2) {
#pragma unroll
            for (int tt = 0; tt < 4; ++tt) gw[tt] = *(const u32x2*)(Gb + (crow + 16 * tt + c) * CW + colh + 16 * w + 4 * g); }
        __syncthreads();
        { float p0 = 0.f, p1 = 0.f, r0 = 0.f, r1 = 0.f, e0 = 0.f, e1 = 0.f;
#pragma unroll
          for (int t8 = 0; t8 < 8; ++t8) { const f32x2 tv = *(const LAS f32x2*)(lds + TOT_OFF + (t8 * 128 + 2 * kp) * 4);
              if (t8 < tg) { p0 += tv.x; p1 += tv.y; } if (t8 < 4) { r0 += tv.x; r1 += tv.y; } e0 += tv.x; e1 += tv.y; }
#pragma unroll
          for (int j = 0; j < 8; ++j) { const int t = 8 * tg + j; const float bb0 = b0[j] + p0, bb1 = b1[j] + p1;
              const float k0 = 1.0f - __builtin_amdgcn_exp2f(bflo(lfw[j])), k1 = 1.0f - __builtin_amdgcn_exp2f(bfhi(lfw[j]));
              *(LAS unsigned*)(lds + KS_OFF + t * KS_RS + kp * 4) = cvt_pk_bf16(k0 * __builtin_amdgcn_exp2f(r0 - bb0), k1 * __builtin_amdgcn_exp2f(r1 - bb1));
              if (PASS == 2) *(LAS unsigned*)(lds + QS_OFF + t * QS_RS + kp * 4) = cvt_pk_bf16(bflo(qw[j]) * __builtin_amdgcn_exp2f(bb0 - r0), bfhi(qw[j]) * __builtin_amdgcn_exp2f(bb1 - r1)); }
          if (tg == 0) { *(LAS f32x2*)(lds + RSC_OFF + kp * 8) = (f32x2){__builtin_amdgcn_exp2f(r0), __builtin_amdgcn_exp2f(r1)};
              *(LAS f32x2*)(lds + DSC_OFF + kp * 8) = (f32x2){__builtin_amdgcn_exp2f(e0 - r0), __builtin_amdgcn_exp2f(e1 - r1)}; bsum0 += e0; bsum1 += e1; }
          *(LAS u32x4*)(lds + IS_OFF + isr * IS_RS + ipc * 32) = iw0; *(LAS u32x4*)(lds + IS_OFF + isr * IS_RS + ipc * 32 + 16) = iw1; }
        { const size_t nrow = row0 + (size_t)(ch < 15 ? ch + 1 : ch) * 64;
#pragma unroll
          for (int j = 0; j < 8; ++j) { const size_t r = nrow + 8 * tg + j; lfw[j] = *(const unsigned*)(Fb + r * CW + colh + 2 * kp); if (PASS == 2) qw[j] = *(const unsigned*)(Qb + r * CW + colh + 2 * kp); }
          const size_t r = nrow + isr; iw0 = *(const u32x4*)(Ib + r * CW + colh + ipc * 16); iw1 = *(const u32x4*)(Ib + r * CW + colh + ipc * 16 + 8); }
        __syncthreads();
        if (PASS == 2) {
            const int st = w >> 1;
            bf16x8 Kf[4];
#pragma unroll
            for (int sp = 0; sp < 4; ++sp) Kf[sp] = rowfrag(lds + KS_OFF, KS_RS, 16 * st + c, sp, g);
#pragma unroll
            for (int i = 0; i < 2; ++i) { const int tt = 2 * (w & 1) + i; f32x4 acc = (f32x4){0.f, 0.f, 0.f, 0.f};
#pragma unroll
                for (int sp = 0; sp < 4; ++sp) acc = HG_MFMA(Kf[sp], rowfrag(lds + QS_OFF, QS_RS, 16 * tt + c, sp, g), acc);
                const int t = 16 * tt + c, s0 = 16 * st + 4 * g;
#pragma unroll
                for (int r = 0; r < 4; ++r) acc[r] = (s0 + r <= t) ? acc[r] : 0.f;
                u32x2 pw; pw.x = cvt_pk_bf16(acc[0], acc[1]); pw.y = cvt_pk_bf16(acc[2], acc[3]);
                *(LAS u32x2*)(lds + PS_OFF + t * PS_RS + s0 * 2) = pw; }
            __syncthreads();
        }
#pragma unroll
        for (int kt = 0; kt < 8; ++kt) { const f32x4 rs = *(const LAS f32x4*)(lds + RSC_OFF + (16 * kt + 4 * g) * 4); S[kt] = S[kt] * rs; }
        bf16x8 If[2];
#pragma unroll
        for (int sb = 0; sb < 2; ++sb) If[sb] = trfrag(lds_addr + IS_OFF, IS_RS, sb, w, c, g);
        f32x4 O[4];
        if (PASS == 2) {
            bf16x8 Sp[4];
#pragma unroll
            for (int sp = 0; sp < 4; ++sp) Sp[sp] = pack_acc(S[2 * sp], S[2 * sp + 1]);
#pragma unroll
            for (int tt = 0; tt < 4; ++tt) { f32x4 acc = (f32x4){0.f, 0.f, 0.f, 0.f};
#pragma unroll
                for (int sp = 0; sp < 4; ++sp) acc = HG_MFMA(Sp[sp], rowfrag(lds + QS_OFF, QS_RS, 16 * tt + c, sp, g), acc);
#pragma unroll
                for (int sb = 0; sb < 2; ++sb) if (32 * sb <= 16 * tt + 15) acc = HG_MFMA(If[sb], rowfrag(lds + PS_OFF, PS_RS, 16 * tt + c, sb, g), acc);
                O[tt] = acc; }
        }
#pragma unroll
        for (int kt = 0; kt < 8; ++kt) {
#pragma unroll
            for (int sb = 0; sb < 2; ++sb) S[kt] = HG_MFMA(trfrag(lds_addr + KS_OFF, KS_RS, sb, kt, c, g), If[sb], S[kt]);
            const f32x4 ds = *(const LAS f32x4*)(lds + DSC_OFF + (16 * kt + 4 * g) * 4); S[kt] = S[kt] * ds; }
        if (PASS == 2) {
#pragma unroll
            for (int tt = 0; tt < 4; ++tt) { float ss = (O[tt][0] * O[tt][0] + O[tt][1] * O[tt][1]) + (O[tt][2] * O[tt][2] + O[tt][3] * O[tt][3]);
                ss += __shfl_xor(ss, 16); ss += __shfl_xor(ss, 32); if (g == 0) *(LAS float*)(lds + RED_OFF + ((16 * tt + c) * 8 + w) * 4) = ss; }
            __syncthreads();
#pragma unroll
            for (int tt = 0; tt < 4; ++tt) { const LAS f32x4* rp = (const LAS f32x4*)(lds + RED_OFF + (16 * tt + c) * 32); const f32x4 ra = rp[0], rb = rp[1];
                const float tot = ((ra[0] + ra[1]) + (ra[2] + ra[3])) + ((rb[0] + rb[1]) + (rb[2] + rb[3]));
                const float rstd = __builtin_amdgcn_rsqf(tot * (1.0f / 128.0f) + EPS);
                const float o0 = O[tt][0] * rstd * og4[0] * bflo(gw[tt].x), o1 = O[tt][1] * rstd * og4[1] * bfhi(gw[tt].x), o2 = O[tt][2] * rstd * og4[2] * bflo(gw[tt].y), o3 = O[tt][3] * rstd * og4[3] * bfhi(gw[tt].y);
                u32x2 ow; ow.x = cvt_pk_bf16(o0, o1); ow.y = cvt_pk_bf16(o2, o3);
                *(u32x2*)(OG + (crow + 16 * tt + c) * CW + colh + 16 * w + 4 * g) = ow; }
        }
    }
    if (PASS == 1) {
#pragma unroll
        for (int kt = 0; kt < 8; ++kt) *((f32x4*)Useg + ((size_t)(item * 8 + w) * 8 + kt) * 64 + lane) = S[kt];
        if (tg == 0) *(f32x2*)(Dlog + (size_t)item * 128 + 2 * kp) = (f32x2){bsum0, bsum1};
    }
    __syncthreads();
}
}

struct Args { const float* in[22]; float* out; unsigned char* ws; int ph_lo, ph_hi, li, pad; };
enum { I_X = 0, I_P, I_NORMG, I_WINAB, I_ALNG, I_ALNB, I_AWS, I_ABS, I_BCONV, I_WOUTAB, I_FFNGU, I_FFNDN, I_WINC, I_LBP, I_ONORMG, I_WOUTC, I_WROUTER, I_BROUTER, I_EGU, I_EDN, I_PPROJ, I_PGATE };

template <bool F8> __device__ __forceinline__ void transpose_item(const float* W, int K, int N, void* WTv, const float* gain, int gu_ff, float scale, LAS float* scr, int item, int lane) {
    const int nblk = N / 32, kb = item / nblk, nb = item % nblk, k0 = 64 * kb, n0 = 32 * nb;
#pragma unroll 8
    for (int i = 0; i < 32; ++i) { const int kk = 2 * i + (lane >> 5); float w = W[(size_t)(k0 + kk) * N + n0 + (lane & 31)]; if (gain) w *= gain[k0 + kk]; if (F8) w *= scale; scr[kk * 33 + (lane & 31)] = w; }
    asm volatile("s_waitcnt lgkmcnt(0)" ::: "memory");
    int d0 = n0; if (gu_ff) { const int half = n0 >= gu_ff ? 1 : 0, j = n0 - half * gu_ff; d0 = (j / 128) * 256 + half * 128 + (j % 128); }
    const int c = lane & 7;
#pragma unroll
    for (int j = 0; j < 4; ++j) { const int n = (lane >> 3) + 8 * j; const LAS float* s = scr + (8 * c) * 33 + n;
        if (F8) { u32x2 o; o.x = pk4_fp8(s[0 * 33], s[1 * 33], s[2 * 33], s[3 * 33]); o.y = pk4_fp8(s[4 * 33], s[5 * 33], s[6 * 33], s[7 * 33]);
            *(u32x2*)((unsigned char*)WTv + (size_t)(d0 + n) * K + k0 + 8 * c) = o; }
        else { u32x4 o; o.x = cvt_pk_bf16(s[0 * 33], s[1 * 33]); o.y = cvt_pk_bf16(s[2 * 33], s[3 * 33]); o.z = cvt_pk_bf16(s[4 * 33], s[5 * 33]); o.w = cvt_pk_bf16(s[6 * 33], s[7 * 33]);
            *(u32x4*)((bf16_t*)WTv + (size_t)(d0 + n) * K + k0 + 8 * c) = o; } }
    asm volatile("s_waitcnt lgkmcnt(0)" ::: "memory");
}

__device__ __forceinline__ void ld_row_bf16(const bf16_t* row, int lane, float (&v)[16]) { unpack8(*(const u32x4*)(row + lane * 8), v); unpack8(*(const u32x4*)(row + 512 + lane * 8), v + 8); }
__device__ __forceinline__ void st_row_bf16(bf16_t* row, int lane, const float (&v)[16]) { *(u32x4*)(row + lane * 8) = pack8(v); *(u32x4*)(row + 512 + lane * 8) = pack8(v + 8); }
__device__ __forceinline__ void ld_row_f32(const float* row, int lane, float (&v)[16]) {
    const f32x4 a = *(const f32x4*)(row + lane * 8), b = *(const f32x4*)(row + lane * 8 + 4), c = *(const f32x4*)(row + 512 + lane * 8), d = *(const f32x4*)(row + 512 + lane * 8 + 4);
#pragma unroll
    for (int j = 0; j < 4; ++j) { v[j] = a[j]; v[4 + j] = b[j]; v[8 + j] = c[j]; v[12 + j] = d[j]; }
}
__device__ __forceinline__ float sumsq16(const float (&v)[16]) { float s = 0.f;
#pragma unroll
    for (int j = 0; j < 16; ++j) s += v[j] * v[j];
    return s; }

__global__ void __launch_bounds__(NTHR, 2) trunk_fwd(Args args) {
    extern __shared__ __attribute__((aligned(16))) unsigned char lds_raw[];
    LAS unsigned char* lds = (LAS unsigned char*)lds_raw;
    volatile LAS unsigned* MISC = (volatile LAS unsigned*)(lds + MISC_OFF);
    const int tid = threadIdx.x;
    const int G = gridDim.x, bx = blockIdx.x;
    unsigned char* ws = args.ws;
    for (int u = tid; u < (LDS_BYTES - LDSCTL_OFF) / 4; u += NTHR) ((LAS unsigned*)(lds + LDSCTL_OFF))[u] = 0u;
    __syncthreads();
    XcdBarrier bar; bar.bar = (unsigned*)(ws + WS_CTL) + CW_BAR; bar.x = 0; bar.st = nullptr;
    if (MK_N_LAUNCHES == 1) bar = xcd_barrier_post((unsigned*)(ws + WS_CTL) + CW_BAR, MISC + 8);
    const int lo = args.ph_lo, hi = args.ph_hi;
#define IN(k) (lo <= (k) && (k) < hi)
#define SEAM(k) do { if (IN(k) && IN((k) + 1)) xcd_barrier(bar); } while (0)

    const float* normg = args.in[I_NORMG];
    float* rstd0 = (float*)(ws + SM_RSTD0); float* rstd1 = (float*)(ws + SM_RSTD1); float* rstd4 = (float*)(ws + SM_RSTD4);
    float* LB = (float*)(ws + SM_LB); int* route = (int*)(ws + SM_ROUTE); int* cntg = (int*)(ws + SM_CNT); int* meta = (int*)(ws + SM_META);
    int* perm = (int*)(ws + SM_PERM); int* rinfo = (int*)(ws + SM_RINFO); float* ssp = (float*)(ws + SM_SSP);
    bf16_t* XA = (bf16_t*)(ws + WS_XA); bf16_t* XB = (bf16_t*)(ws + WS_XB); bf16_t* PB = (bf16_t*)(ws + WS_PB);
    unsigned char* R = ws + WS_R;
    const int NGW = G * NWAVES;
    const int RPW = M / G;

    if (IN(0)) for (int rep_ = 0; rep_ < NREP(0); ++rep_) { const int lane = get_lane(), wave = get_wave(); const int gw = bx * NWAVES + wave; (void)gw; (void)lane;
        LAS float* scr = (LAS float*)(lds + wave * 16384);
        constexpr int I1 = 16 * 80, I2 = 16 * 32, I3 = 16 * 176, I4 = 44 * 32, I5 = 16 * 128, I6 = 16 * 32, I7E = 16 * 224, I8E = 56 * 32, I9L = 4 * 32, I10L = 16 * 32;
        constexpr int NITEMS = I1 + I2 + I3 + I4 + I5 + I6 + 8 * I7E + 8 * I8E + 2 * I9L + 2 * I10L;
        for (int it = gw; it < NITEMS; it += NGW) {
            int r = it;
            if (r < I1) { transpose_item<false>(args.in[I_WINAB], D, AB_IN, (bf16_t*)(ws + W_INAB), normg + 0 * D, 0, 1.0f, scr, r, lane); continue; } r -= I1;
            if (r < I2) { transpose_item<false>(args.in[I_WOUTAB], D, D, (bf16_t*)(ws + W_OUTAB), nullptr, 0, 1.0f, scr, r, lane); continue; } r -= I2;
            if (r < I3) { transpose_item<false>(args.in[I_FFNGU], D, 2 * FF, (bf16_t*)(ws + W_GU0), normg + 2 * D, FF, 1.0f, scr, r, lane); continue; } r -= I3;
            if (r < I4) { transpose_item<false>(args.in[I_FFNDN], FF, D, (bf16_t*)(ws + W_DN0), nullptr, 0, 1.0f, scr, r, lane); continue; } r -= I4;
            if (r < I5) { transpose_item<false>(args.in[I_WINC], D, 4 * CW, (bf16_t*)(ws + W_INC), normg + 4 * D, 0, 1.0f, scr, r, lane); continue; } r -= I5;
            if (r < I6) { transpose_item<false>(args.in[I_WOUTC], CW, D, (bf16_t*)(ws + W_OUTC), nullptr, 0, 1.0f, scr, r, lane); continue; } r -= I6;
            if (r < 8 * I7E) { const int e = r / I7E; transpose_item<true>(args.in[I_EGU] + (size_t)e * D * 2 * EFF, D, 2 * EFF, ws + W_EGU8 + (size_t)e * 2 * EFF * D, normg + 6 * D, EFF, SC_GU, scr, r % I7E, lane); continue; } r -= 8 * I7E;
            if (r < 8 * I8E) { const int e = r / I8E; transpose_item<true>(args.in[I_EDN] + (size_t)e * EFF * D, EFF, D, ws + W_EDN8 + (size_t)e * D * EFF, nullptr, 0, SC_DN, scr, r % I8E, lane); continue; } r -= 8 * I8E;
            if (r < 2 * I9L) { const int l = r / I9L; transpose_item<false>(args.in[I_PPROJ] + (size_t)l * PLE * D, PLE, D, (bf16_t*)(ws + W_PPROJ) + (size_t)l * D * PLE, nullptr, 0, 1.0f, scr, r % I9L, lane); continue; } r -= 2 * I9L;
            { const int l = r / I10L; transpose_item<false>(args.in[I_PGATE] + (size_t)l * D * D, D, D, (bf16_t*)(ws + W_PGATE) + (size_t)l * D * D, nullptr, 0, 1.0f, scr, r % I10L, lane); }
        }
        for (int m = gw; m < M; m += NGW) { float v[16]; ld_row_f32(args.in[I_X] + (size_t)m * D, lane, v);
            const float ss = wave_sum(sumsq16(v)); st_row_bf16(XA + (size_t)m * D, lane, v); if (lane == 0) rstd0[m] = __builtin_amdgcn_rsqf(ss * (1.0f / D) + EPS); }
        { const float* p = args.in[I_P]; const size_t n8 = (size_t)2 * M * PLE / 8;
          for (size_t i = (size_t)bx * NTHR + tid; i < n8; i += (size_t)G * NTHR) { const f32x4 a = *(const f32x4*)(p + i * 8), b = *(const f32x4*)(p + i * 8 + 4);
              float v[8] = {a[0], a[1], a[2], a[3], b[0], b[1], b[2], b[3]}; *(u32x4*)(PB + i * 8) = pack8(v); } }
        if (bx == 0) for (int c = tid; c < CW; c += NTHR) { const float d = args.in[I_LBP][CW + c] - args.in[I_LBP][c]; LB[c] = 1.0f / (1.0f + expf(-d)); }
    }
    SEAM(0);

    if (IN(1)) for (int rep_ = 0; rep_ < NREP(1); ++rep_) { pg8::StaticOrder S; S.init(XA, (const bf16_t*)(ws + W_INAB), M, AB_IN, D, G, bx); pg8::EpiInAB E{(bf16_t*)(R + R_Z), rstd0};
        pg8::gemm_phase<pg8::EpiInAB, pg8::StaticOrder, false>(lds, 2 * D, S, E); }
    SEAM(1);

    if (IN(2)) for (int rep_ = 0; rep_ < NREP(2); ++rep_) { const int lane = get_lane(), wave = get_wave(); const int gw = bx * NWAVES + wave; (void)gw; (void)lane;
        const bf16_t* Z = (const bf16_t*)(R + R_Z); bf16_t* Y = (bf16_t*)(R + R_Y);
        LAS float* vln = (LAS float*)lds;
        LAS float* wt = (LAS float*)(lds + 32768);
        for (int blk = bx; blk < M / 128; blk += G) {
            const int t0 = blk * 128;
            for (int h = 0; h < 8; ++h) {
                { const float* Wh = args.in[I_AWS] + (size_t)h * 128 * 128;
                  for (int e = tid; e < 128 * 128; e += NTHR) { const int i = e >> 7, j = e & 127; float w = Wh[e]; if ((j >> 6) > (i >> 6)) w = 0.f; wt[j * 128 + i] = w; } }
                { const int row = tid >> 2, dq = tid & 3; const bf16_t* vp = Z + (size_t)(t0 + row) * AB_IN + 512 + h * 64 + dq * 16; float v[16];
                  unpack8(*(const u32x4*)vp, v); unpack8(*(const u32x4*)(vp + 8), v + 8);
                  float s = 0.f;
#pragma unroll
                  for (int j = 0; j < 16; ++j) s += v[j];
                  s += __shfl_xor(s, 1); s += __shfl_xor(s, 2); const float mu = s * (1.0f / 64.0f); float q = 0.f;
#pragma unroll
                  for (int j = 0; j < 16; ++j) { v[j] -= mu; q += v[j] * v[j]; }
                  q += __shfl_xor(q, 1); q += __shfl_xor(q, 2); const float rs = __builtin_amdgcn_rsqf(q * (1.0f / 64.0f) + EPS);
#pragma unroll
                  for (int j = 0; j < 16; ++j) { const int c = h * 64 + dq * 16 + j; vln[row * 64 + dq * 16 + j] = v[j] * rs * args.in[I_ALNG][c] + args.in[I_ALNB][c]; } }
                __syncthreads();
                { const int d = tid & 63, ig = wave; const int jmax = ig < 4 ? 64 : 128; float a[16];
#pragma unroll
                  for (int ii = 0; ii < 16; ++ii) a[ii] = 0.f;
                  for (int j = 0; j < jmax; ++j) { const float vj = vln[j * 64 + d]; const LAS f32x4* wp = (const LAS f32x4*)(wt + j * 128 + ig * 16);
                      const f32x4 w0 = wp[0], w1 = wp[1], w2 = wp[2], w3 = wp[3];
#pragma unroll
                      for (int ii = 0; ii < 4; ++ii) { a[ii] += w0[ii] * vj; a[4 + ii] += w1[ii] * vj; a[8 + ii] += w2[ii] * vj; a[12 + ii] += w3[ii] * vj; } }
#pragma unroll
                  for (int ii = 0; ii < 16; ++ii) { const int i = ig * 16 + ii; const float f = a[ii] + args.in[I_ABS][h * 128 + i];
                      const float uu = bf2f(Z[(size_t)(t0 + i) * AB_IN + h * 64 + d]); Y[(size_t)(t0 + i) * D + h * 64 + d] = f2bf(uu * f); } }
                __syncthreads();
            }
            { const int c = tid; const float w0 = args.in[I_BCONV][c], w1 = args.in[I_BCONV][512 + c], w2 = args.in[I_BCONV][1024 + c];
              float p2 = 0.f, p1 = 0.f;
              if ((t0 % SEQ) != 0) { const bf16_t* z2 = Z + (size_t)(t0 - 2) * AB_IN; const bf16_t* z1 = Z + (size_t)(t0 - 1) * AB_IN;
                  p2 = bf2f(z2[1536 + c]) * bf2f(z2[1024 + c]); p1 = bf2f(z1[1536 + c]) * bf2f(z1[1024 + c]); }
              for (int t = 0; t < 128; ++t) { const bf16_t* z = Z + (size_t)(t0 + t) * AB_IN; const float p0 = bf2f(z[1536 + c]) * bf2f(z[1024 + c]);
                  Y[(size_t)(t0 + t) * D + 512 + c] = f2bf(bf2f(z[2048 + c]) * (w0 * p2 + w1 * p1 + w2 * p0)); p2 = p1; p1 = p0; } }
        }
    }
    SEAM(2);

    if (IN(3)) for (int rep_ = 0; rep_ < NREP(3); ++rep_) { pg8::StaticOrder S; S.init((const bf16_t*)(R + R_Y), (const bf16_t*)(ws + W_OUTAB), M, D, D, G, bx); pg8::EpiPlain E{(bf16_t*)(R + R_MIX), D};
        pg8::gemm_phase<pg8::EpiPlain, pg8::StaticOrder, false>(lds, 2 * D, S, E); }
    SEAM(3);

    if (IN(4)) for (int rep_ = 0; rep_ < NREP(4); ++rep_) { const int lane = get_lane(), wave = get_wave(); const int gw = bx * NWAVES + wave; (void)gw; (void)lane; const bf16_t* MIX = (const bf16_t*)(R + R_MIX); float g[16]; ld_row_f32(normg + 1 * D, lane, g);
        for (int i = 0; i < RPW / NWAVES; ++i) { const int m = bx * RPW + wave * (RPW / NWAVES) + i; float mx[16], x[16]; ld_row_bf16(MIX + (size_t)m * D, lane, mx); ld_row_bf16(XA + (size_t)m * D, lane, x);
            const float rm = __builtin_amdgcn_rsqf(wave_sum(sumsq16(mx)) * (1.0f / D) + EPS);
#pragma unroll
            for (int j = 0; j < 16; ++j) x[j] += g[j] * mx[j] * rm;
            const float ss = wave_sum(sumsq16(x)); st_row_bf16(XB + (size_t)m * D, lane, x); if (lane == 0) rstd1[m] = __builtin_amdgcn_rsqf(ss * (1.0f / D) + EPS); } }
    SEAM(4);

    if (IN(5)) for (int rep_ = 0; rep_ < NREP(5); ++rep_) { pg8::StaticOrder S; S.init(XB, (const bf16_t*)(ws + W_GU0), M, 2 * FF, D, G, bx); pg8::EpiSwiGLU<false> E{(bf16_t*)(R + R_HF), FF, rstd1, nullptr};
        pg8::gemm_phase<pg8::EpiSwiGLU<false>, pg8::StaticOrder, false>(lds, 2 * D, S, E); }
    SEAM(5);

    if (IN(6)) for (int rep_ = 0; rep_ < NREP(6); ++rep_) { pg8::StaticOrder S; S.init((const bf16_t*)(R + R_HF), (const bf16_t*)(ws + W_DN0), M, D, FF, G, bx); pg8::EpiPlain E{(bf16_t*)(R + R_MIX), D};
        pg8::gemm_phase<pg8::EpiPlain, pg8::StaticOrder, false>(lds, 2 * FF, S, E); }
    SEAM(6);

    if (IN(7)) for (int rep_ = 0; rep_ < NREP(7); ++rep_) { const int lane = get_lane(), wave = get_wave(); const int gw = bx * NWAVES + wave; (void)gw; (void)lane; const bf16_t* MIX = (const bf16_t*)(R + R_MIX); float g[16]; ld_row_f32(normg + 3 * D, lane, g);
        for (int i = 0; i < RPW / NWAVES; ++i) { const int m = bx * RPW + wave * (RPW / NWAVES) + i; float mx[16], x[16]; ld_row_bf16(MIX + (size_t)m * D, lane, mx); ld_row_bf16(XB + (size_t)m * D, lane, x);
            const float rm = __builtin_amdgcn_rsqf(wave_sum(sumsq16(mx)) * (1.0f / D) + EPS);
#pragma unroll
            for (int j = 0; j < 16; ++j) x[j] += g[j] * mx[j] * rm;
            st_row_bf16(XA + (size_t)m * D, lane, x); } }
    SEAM(7);

    if (IN(8)) for (int rep_ = 0; rep_ < NREP(8); ++rep_) { pg8::StaticOrder S; S.init(PB, (const bf16_t*)(ws + W_PPROJ), M, D, PLE, G, bx); pg8::EpiPlain E{(bf16_t*)(R + R_PP), D};
        pg8::gemm_phase<pg8::EpiPlain, pg8::StaticOrder, false>(lds, 2 * PLE, S, E); }
    SEAM(8);

    if (IN(9)) for (int rep_ = 0; rep_ < NREP(9); ++rep_) { pg8::StaticOrder S; S.init(XA, (const bf16_t*)(ws + W_PGATE), M, D, D, G, bx); pg8::EpiPleGate<false> E{XA, (const bf16_t*)(R + R_PP), XB, ssp, nullptr};
        pg8::gemm_phase<pg8::EpiPleGate<false>, pg8::StaticOrder, false>(lds, 2 * D, S, E); }
    SEAM(9);

    if (IN(10)) for (int rep_ = 0; rep_ < NREP(10); ++rep_) { pg8::StaticOrder S; S.init(XB, (const bf16_t*)(ws + W_INC), M, 4 * CW, D, G, bx); pg8::EpiInC E{(bf16_t*)(R + R_QFIG), ssp, LB};
        pg8::gemm_phase<pg8::EpiInC, pg8::StaticOrder, false>(lds, 2 * D, S, E); }
    SEAM(10);

    if (IN(11)) for (int rep_ = 0; rep_ < NREP(11); ++rep_) {
        const bf16_t* Qb = (const bf16_t*)(R + R_QFIG); const bf16_t* Fb = Qb + (size_t)M * CW; const bf16_t* Ib = Fb + (size_t)M * CW; const bf16_t* Gb = Ib + (size_t)M * CW;
        for (int item = bx; item < BATCH * 8 * 8; item += G) { if ((item & 7) == 7) continue;
            hg::run<1>(lds, Qb, Fb, Ib, Gb, args.in[I_ONORMG], (float*)(R + R_O), (float*)(ws + SM_DLOG), (bf16_t*)(R + R_OG), item); }
    }
    SEAM(11);

    if (IN(12)) for (int rep_ = 0; rep_ < NREP(12); ++rep_) {
        const bf16_t* Qb = (const bf16_t*)(R + R_QFIG); const bf16_t* Fb = Qb + (size_t)M * CW; const bf16_t* Ib = Fb + (size_t)M * CW; const bf16_t* Gb = Ib + (size_t)M * CW;
        for (int item = bx; item < BATCH * 8 * 8; item += G)
            hg::run<2>(lds, Qb, Fb, Ib, Gb, args.in[I_ONORMG], (float*)(R + R_O), (float*)(ws + SM_DLOG), (bf16_t*)(R + R_OG), item);
    }
    SEAM(12);

    if (IN(13)) for (int rep_ = 0; rep_ < NREP(13); ++rep_) { pg8::StaticOrder S; S.init((const bf16_t*)(R + R_OG), (const bf16_t*)(ws + W_OUTC), M, D, CW, G, bx); pg8::EpiPlain E{(bf16_t*)(R + R_MIX1), D};
        pg8::gemm_phase<pg8::EpiPlain, pg8::StaticOrder, false>(lds, 2 * CW, S, E); }
    SEAM(13);

    if (IN(14)) for (int rep_ = 0; rep_ < NREP(14); ++rep_) { const int lane = get_lane(), wave = get_wave(); const int gw = bx * NWAVES + wave; (void)gw; (void)lane; const bf16_t* MIX = (const bf16_t*)(R + R_MIX1); float g[16], g2[16]; ld_row_f32(normg + 5 * D, lane, g); ld_row_f32(normg + 6 * D, lane, g2);
        LAS float* wrl = (LAS float*)lds;
        LAS int* lcnt = (LAS int*)(lds + 32768);
        for (int e = tid; e < D * NE; e += NTHR) wrl[e] = args.in[I_WROUTER][e];
        if (tid < NE) lcnt[tid] = 0;
        __syncthreads();
        for (int i = 0; i < RPW / NWAVES; ++i) { const int m = bx * RPW + wave * (RPW / NWAVES) + i; float mx[16], x[16]; ld_row_bf16(MIX + (size_t)m * D, lane, mx); ld_row_bf16(XB + (size_t)m * D, lane, x);
            const float rm = __builtin_amdgcn_rsqf(wave_sum(sumsq16(mx)) * (1.0f / D) + EPS);
#pragma unroll
            for (int j = 0; j < 16; ++j) x[j] += g[j] * mx[j] * rm;
            const float rs = __builtin_amdgcn_rsqf(wave_sum(sumsq16(x)) * (1.0f / D) + EPS);
            st_row_bf16(XA + (size_t)m * D, lane, x); if (lane == 0) rstd4[m] = rs;
            { float xn[16];
#pragma unroll
              for (int j = 0; j < 16; ++j) xn[j] = x[j] * rs;
              unsigned char* x8 = ws + WS_X8 + (size_t)m * D; *(u32x2*)(x8 + lane * 8) = pack8_fp8(xn); *(u32x2*)(x8 + 512 + lane * 8) = pack8_fp8(xn + 8); }
            float lg[NE];
#pragma unroll
            for (int e = 0; e < NE; ++e) lg[e] = 0.f;
#pragma unroll
            for (int j = 0; j < 16; ++j) { const int col = (j < 8 ? 0 : 512) + lane * 8 + (j & 7); const float hn = x[j] * rs * g2[j];
                const LAS f32x4* wp = (const LAS f32x4*)(wrl + col * NE); const f32x4 w0 = wp[0], w1 = wp[1];
#pragma unroll
                for (int e = 0; e < 4; ++e) { lg[e] += hn * w0[e]; lg[4 + e] += hn * w1[e]; } }
#pragma unroll
            for (int e = 0; e < NE; ++e) lg[e] = wave_sum(lg[e]) + args.in[I_BROUTER][e];
            if (lane == 0) { int e1 = 0; float l1 = lg[0];
#pragma unroll
                for (int e = 1; e < NE; ++e) if (lg[e] > l1) { l1 = lg[e]; e1 = e; }
                int e2 = -1; float l2 = -3.0e38f;
#pragma unroll
                for (int e = 0; e < NE; ++e) if (e != e1 && lg[e] > l2) { l2 = lg[e]; e2 = e; }
                const float ex = expf(l2 - l1), w1 = 1.0f / (1.0f + ex), w2 = ex / (1.0f + ex);
                *(i32x4*)(route + (size_t)m * 4) = (i32x4){e1, e2, __float_as_int(w1), __float_as_int(w2)};
                atomicAdd((int*)(lcnt + e1), 1); atomicAdd((int*)(lcnt + e2), 1); } }
        __syncthreads();
        if (tid < NE) cntg[bx * NE + tid] = lcnt[tid];
    }
    SEAM(14);

    if (IN(15)) for (int rep_ = 0; rep_ < NREP(15); ++rep_) { const int lane = get_lane(), wave = get_wave(); const int gw = bx * NWAVES + wave; (void)gw; (void)lane;
        LAS int* lc = (LAS int*)lds;
        LAS int* tot = (LAS int*)(lds + 32768);
        for (int e = tid; e < G * NE; e += NTHR) lc[e] = cntg[e];
        __syncthreads();
        if (tid < NE) { int t = 0, pre = 0; for (int w = 0; w < G; ++w) { if (w == bx) pre = t; t += lc[w * NE + tid]; } tot[tid] = t; tot[8 + tid] = pre; }
        __syncthreads();
        if (tid == 0) { int b = 0; for (int e = 0; e < NE; ++e) { tot[16 + e] = b; b += (tot[e] + 255) & ~255; } tot[24] = b; }
        __syncthreads();
        if (wave == 0) { int run[NE];
#pragma unroll
            for (int e = 0; e < NE; ++e) run[e] = 0;
            for (int it = 0; it < RPW / 64; ++it) { const int m = bx * RPW + it * 64 + lane; const i32x4 rt = *(const i32x4*)(route + (size_t)m * 4);
                const unsigned long long lt = (1ull << lane) - 1ull;
#pragma unroll
                for (int e = 0; e < NE; ++e) { const bool has = (rt[0] == e) || (rt[1] == e); const unsigned long long mask = __ballot(has);
                    if (has) { const int pos = tot[16 + e] + tot[8 + e] + run[e] + __popcll(mask & lt); const int slot = (rt[1] == e) ? 1 : 0;
                        perm[pos] = m; rinfo[2 * pos] = m * 2 + slot; rinfo[2 * pos + 1] = slot ? rt[3] : rt[2]; }
                    run[e] += __popcll(mask); } } }
        if (bx < NE) { const int e = bx; const int beg = tot[16 + e] + tot[e], end = tot[16 + e] + ((tot[e] + 255) & ~255);
            for (int p = beg + tid; p < end; p += NTHR) { perm[p] = 0; rinfo[2 * p] = -1; rinfo[2 * p + 1] = 0; } }
        if (bx == 0) { if (tid == 0) meta[0] = tot[24] / 256; if (tid < NE) meta[1 + tid] = tot[16 + tid];
            for (int p = tid; p < tot[24] / 256; p += NTHR) { int e = 0;
#pragma unroll
                for (int k = 1; k < NE; ++k) if (p * 256 >= tot[16 + k]) e = k;
                meta[16 + p] = e; } }
        __syncthreads();
    }
    SEAM(15);

    if (IN(16)) for (int rep_ = 0; rep_ < NREP(16); ++rep_) {
        pg8::MoeOrder<true> S; S.init(ws + WS_X8, ws + W_EGU8, meta, 2 * EFF, D, G, bx, perm); pg8::EpiSwiGLU8 E{R + R_H, EFF};
        pg8::gemm_phase<pg8::EpiSwiGLU8, pg8::MoeOrder<true>, true, true>(lds, D, S, E); }
    SEAM(16);

    if (IN(17)) for (int rep_ = 0; rep_ < NREP(17); ++rep_) {
        pg8::MoeOrder<false> S; S.init(R + R_H, ws + W_EDN8, meta, D, EFF, G, bx, perm); pg8::EpiMoeDown E{rinfo, (bf16_t*)args.out};
        pg8::gemm_phase<pg8::EpiMoeDown, pg8::MoeOrder<false>, false, true>(lds, EFF, S, E); }
    SEAM(17);

    if (IN(18)) for (int rep_ = 0; rep_ < NREP(18); ++rep_) { const int lane = get_lane(), wave = get_wave(); const int gw = bx * NWAVES + wave; (void)gw; (void)lane; const bf16_t* S0 = (const bf16_t*)args.out; const bf16_t* S1 = S0 + (size_t)M * D; float g[16]; ld_row_f32(normg + 7 * D, lane, g);
        for (int i = 0; i < RPW / NWAVES; ++i) { const int m = bx * RPW + wave * (RPW / NWAVES) + i; float mx[16], m2[16], x[16]; ld_row_bf16(S0 + (size_t)m * D, lane, mx); ld_row_bf16(S1 + (size_t)m * D, lane, m2); ld_row_bf16(XA + (size_t)m * D, lane, x);
#pragma unroll
            for (int j = 0; j < 16; ++j) mx[j] += m2[j];
            const float rm = __builtin_amdgcn_rsqf(wave_sum(sumsq16(mx)) * (1.0f / D) + EPS);
#pragma unroll
            for (int j = 0; j < 16; ++j) x[j] += g[j] * mx[j] * rm;
            st_row_bf16(XB + (size_t)m * D, lane, x); } }
    SEAM(18);

    if (IN(19)) for (int rep_ = 0; rep_ < NREP(19); ++rep_) { pg8::StaticOrder S; S.init(PB + (size_t)M * PLE, (const bf16_t*)(ws + W_PPROJ) + (size_t)D * PLE, M, D, PLE, G, bx); pg8::EpiPlain E{(bf16_t*)(R + R_PP1), D};
        pg8::gemm_phase<pg8::EpiPlain, pg8::StaticOrder, false>(lds, 2 * PLE, S, E); }
    SEAM(19);

    if (IN(20)) for (int rep_ = 0; rep_ < NREP(20); ++rep_) { pg8::StaticOrder S; S.init(XB, (const bf16_t*)(ws + W_PGATE) + (size_t)D * D, M, D, D, G, bx); pg8::EpiPleGate<true> E{XB, (const bf16_t*)(R + R_PP1), nullptr, nullptr, args.out};
        pg8::gemm_phase<pg8::EpiPleGate<true>, pg8::StaticOrder, false>(lds, 2 * D, S, E); }
#undef IN
#undef SEAM
}

constexpr int N_PHASES = 21;
extern "C" void kernel_launch(void* const* d_in, const int* in_sizes, int n_in, void* d_out, int out_size, void* d_ws, size_t ws_size, hipStream_t stream) {
    static int grid = 0;
    if (grid == 0) {
        if (n_in != 22 || in_sizes[0] != M * D || out_size != M * D || ws_size < WS_END) { fprintf(stderr, "kernel_launch: unexpected shapes (n_in %d, in0 %d, out %d, ws %zu < %zu); nothing launched\n", n_in, n_in > 0 ? in_sizes[0] : -1, out_size, ws_size, (size_t)WS_END); grid = -1; return; }
        int dev = 0, cus = 0, per_cu = 0;
        if (hipGetDevice(&dev) != hipSuccess || hipDeviceGetAttribute(&cus, hipDeviceAttributeMultiprocessorCount, dev) != hipSuccess) { grid = -1; return; }
        if (hipFuncSetAttribute((const void*)trunk_fwd, hipFuncAttributeMaxDynamicSharedMemorySize, LDS_BYTES) != hipSuccess) { fprintf(stderr, "kernel_launch: hipFuncSetAttribute failed\n"); grid = -1; return; }
        if (hipOccupancyMaxActiveBlocksPerMultiprocessor(&per_cu, (const void*)trunk_fwd, NTHR, LDS_BYTES) != hipSuccess || per_cu < 1) { fprintf(stderr, "kernel_launch: occupancy query reports %d workgroups per CU\n", per_cu); }
        (void)hipGetLastError();
        grid = cus;
        if (grid > 1024 || (M % (grid * NWAVES)) != 0 || ((M / grid) % 64) != 0) { fprintf(stderr, "kernel_launch: unsupported CU count %d\n", grid); grid = -1; return; }
    }
    if (grid < 0) return;
    if (hipMemsetAsync((char*)d_ws + WS_CTL, 0, CTL_ZERO_BYTES, stream) != hipSuccess) return;
    Args a{};
    for (int i = 0; i < 22; ++i) a.in[i] = (const float*)d_in[i];
    a.out = (float*)d_out; a.ws = (unsigned char*)d_ws; a.pad = 0;
    if (MK_N_LAUNCHES == 1) { a.ph_lo = 0; a.ph_hi = N_PHASES; a.li = 0; hipLaunchKernelGGL(trunk_fwd, dim3(grid), dim3(NTHR), LDS_BYTES, stream, a); }
    else for (int ph = 0; ph < N_PHASES; ++ph) { a.ph_lo = ph; a.ph_hi = ph + 1; a.li = ph; hipLaunchKernelGGL(trunk_fwd, dim3(grid), dim3(NTHR), LDS_BYTES, stream, a); }
}
```

```cpp
#include <hip/hip_runtime.h>
#include <cstdio>
#include <cstdint>

#ifndef MK_N_LAUNCHES
#define MK_N_LAUNCHES 1
#endif

#ifndef PROBE_REP
#define PROBE_REP 0u
#endif
#define NREP(k) (1 + (int)((PROBE_REP >> (k)) & 1u))
#define GAS __attribute__((address_space(1)))
#define LAS __attribute__((address_space(3)))
typedef unsigned short bf16_t;
typedef short bf16x8 __attribute__((ext_vector_type(8)));
typedef float f32x4 __attribute__((ext_vector_type(4)));
typedef float f32x2 __attribute__((ext_vector_type(2)));
typedef unsigned u32x4 __attribute__((ext_vector_type(4)));
typedef unsigned u32x2 __attribute__((ext_vector_type(2)));
typedef int i32x4 __attribute__((ext_vector_type(4)));
typedef int i32x8 __attribute__((ext_vector_type(8)));

constexpr int D = 1024, BATCH = 4, SEQ = 8192, M = BATCH * SEQ;
constexpr int PLE = 256, AB_IN = 2560, FF = 2816, CW = 1024, NE = 8, EFF = 3584;
constexpr float EPS = 1e-6f;
constexpr int NWAVES = 8, NTHR = 512;
constexpr int MAXP = 264;

__device__ __forceinline__ float bflo(unsigned w) { return __uint_as_float(w << 16); }
__device__ __forceinline__ float bfhi(unsigned w) { return __uint_as_float(w & 0xffff0000u); }
__device__ __forceinline__ float bf2f(bf16_t b) { return __uint_as_float((unsigned)b << 16); }
__device__ __forceinline__ unsigned cvt_pk_bf16(float lo, float hi) { unsigned r; asm volatile("v_cvt_pk_bf16_f32 %0, %1, %2" : "=v"(r) : "v"(lo), "v"(hi)); return r; }
__device__ __forceinline__ bf16_t f2bf(float f) { return (bf16_t)(cvt_pk_bf16(f, 0.f) & 0xffffu); }
__device__ __forceinline__ unsigned pk4_fp8(float a, float b, float c, float d) { int w = __builtin_amdgcn_cvt_pk_fp8_f32(a, b, 0, false); w = __builtin_amdgcn_cvt_pk_fp8_f32(c, d, w, true); return (unsigned)w; }
__device__ __forceinline__ u32x2 pack8_fp8(const float* v) { u32x2 w; w.x = pk4_fp8(v[0], v[1], v[2], v[3]); w.y = pk4_fp8(v[4], v[5], v[6], v[7]); return w; }
constexpr float SC_GU = 64.0f, SC_DN = 64.0f;
__device__ __forceinline__ float fsigmoid(float x) { return __builtin_amdgcn_rcpf(1.0f + __builtin_amdgcn_exp2f(-1.4426950408889634f * x)); }
__device__ __forceinline__ float fsilu(float x) { return x * fsigmoid(x); }
__device__ __forceinline__ float fgelu_tanh(float x) { const float u = x + 0.044715f * x * x * x; return x * __builtin_amdgcn_rcpf(1.0f + __builtin_amdgcn_exp2f(-2.3022082f * u)); }
__device__ __forceinline__ int get_lane() { int t; asm volatile("v_and_b32 %0, 63, %1" : "=v"(t) : "v"(threadIdx.x)); return t; }
__device__ __forceinline__ int get_wave() { int t; asm volatile("v_lshrrev_b32 %0, 6, %1" : "=v"(t) : "v"(threadIdx.x)); return __builtin_amdgcn_readfirstlane(t); }
__device__ __forceinline__ float wave_sum(float v) {
#pragma unroll
    for (int o = 1; o < 64; o <<= 1) v += __shfl_xor(v, o);
    return v;
}
__device__ __forceinline__ void unpack8(const u32x4 a, float* v) { v[0] = bflo(a.x); v[1] = bfhi(a.x); v[2] = bflo(a.y); v[3] = bfhi(a.y); v[4] = bflo(a.z); v[5] = bfhi(a.z); v[6] = bflo(a.w); v[7] = bfhi(a.w); }
__device__ __forceinline__ u32x4 pack8(const float* v) { u32x4 w; w.x = cvt_pk_bf16(v[0], v[1]); w.y = cvt_pk_bf16(v[2], v[3]); w.z = cvt_pk_bf16(v[4], v[5]); w.w = cvt_pk_bf16(v[6], v[7]); return w; }

namespace pg8 {
constexpr int BM = 256, BK = 64, HALF = 128, HTB = HALF * BK * 2, STAGE_BYTES = 8 * HTB, NXCD = 8, WGM = 8;
__host__ __device__ __forceinline__ int lds_byte(int r, int c) { const int st = (r >> 4) * 2 + (c >> 5), rr = r & 15, cc = c & 31, ob = rr * 64 + cc * 2; return st * 1024 + (ob ^ (((ob >> 9) & 1) << 5)); }
__host__ __device__ __forceinline__ void stage_rc(int b, int& R, int& C) { const int st = b / 1024, sb = b % 1024, swz = sb ^ (((sb >> 9) & 1) << 5); R = (st >> 1) * 16 + swz / 64; C = (st & 1) * 32 + (swz % 64) / 2; }
__host__ __device__ __forceinline__ int perm32(int rho) { const int n = rho >> 4, i = rho & 15; return 8 * (i >> 2) + 4 * n + (i & 3); }

struct Unit { int pm, pn; const char* a; const char* b; };
__device__ __forceinline__ const char* uni(const char* p) { const unsigned long long v = (unsigned long long)p; const unsigned lo = __builtin_amdgcn_readfirstlane((unsigned)v), hi = __builtin_amdgcn_readfirstlane((unsigned)(v >> 32)); return (const char*)(((unsigned long long)hi << 32) | lo); }

__device__ __forceinline__ bool tile_of(int i, int G, int c, int nM, int nN, int& pm, int& pn) {
    const int nwg = nM * nN; const int L = i * G + c; if (L >= nwg) return false;
    int wgid = L; { const int q = nwg / NXCD, r = nwg % NXCD, xcd = wgid % NXCD, off = wgid / NXCD; wgid = (xcd < r ? xcd * (q + 1) : r * (q + 1) + (xcd - r) * q) + off; }
    const int nig = WGM * nN, gid = wgid / nig, fm = gid * WGM, gsz = (nM - fm) < WGM ? (nM - fm) : WGM;
    pm = fm + ((wgid % nig) % gsz); pn = (wgid % nig) / gsz; return true;
}
struct StaticOrder {
    int nM, nN, G, c; const char* A; const char* Bt; size_t tstep;
    __device__ __forceinline__ void init(const bf16_t* A_, const bf16_t* Bt_, int M_, int N_, int K_, int G_, int c_) { nM = M_ / BM; nN = N_ / BM; G = G_; c = c_; A = (const char*)A_; Bt = (const char*)Bt_; tstep = (size_t)BM * K_ * 2; }
    __device__ __forceinline__ const int* perm_of(const Unit&) const { return nullptr; }
    __device__ __forceinline__ bool next(int i, Unit& u) const { if (!tile_of(i, G, c, nM, nN, u.pm, u.pn)) return false; u.pm = __builtin_amdgcn_readfirstlane(u.pm); u.pn = __builtin_amdgcn_readfirstlane(u.pn); u.a = uni(A + (size_t)u.pm * tstep); u.b = uni(Bt + (size_t)u.pn * tstep); return true; }
    __device__ __forceinline__ int gather_tok(const Unit&, int) const { return 0; }
};
template <bool GATHER> struct MoeOrder {
    int nM, nN, G, c; const char* A; const char* Bt; size_t tstep, estride; int pb[7]; const int* perm;
    __device__ __forceinline__ void init(const void* A_, const void* Bt_, const int* meta, int N_, int rowB, int G_, int c_, const int* perm_) {
        nM = __builtin_amdgcn_readfirstlane(meta[0]); nN = N_ / BM; G = G_; c = c_; A = (const char*)A_; Bt = (const char*)Bt_; tstep = (size_t)BM * rowB; estride = (size_t)N_ * rowB; perm = perm_;
#pragma unroll
        for (int k = 0; k < 7; ++k) pb[k] = __builtin_amdgcn_readfirstlane(meta[2 + k]); }
    __device__ __forceinline__ bool next(int i, Unit& u) const { if (!tile_of(i, G, c, nM, nN, u.pm, u.pn)) return false;
        u.pm = __builtin_amdgcn_readfirstlane(u.pm); u.pn = __builtin_amdgcn_readfirstlane(u.pn); int e = 0;
#pragma unroll
        for (int k = 0; k < 7; ++k) e += (u.pm * BM >= pb[k]) ? 1 : 0;
        u.a = uni(GATHER ? A : A + (size_t)u.pm * tstep); u.b = uni(Bt + (size_t)e * estride + (size_t)u.pn * tstep); return true; }
    __device__ __forceinline__ int gather_tok(const Unit& u, int r) const { return perm[u.pm * BM + r]; }
    __device__ __forceinline__ const int* perm_of(const Unit& u) const { return perm + u.pm * BM; }
};

constexpr int PERMBUF_OFF = 131072 + 4096;
template <class Epi, class Sched, bool GATHER, bool FP8 = false>
__device__ __forceinline__ void gemm_phase(LAS unsigned char* lds, const int rowB, const Sched& S, const Epi& E) {
    const int tid = threadIdx.x, wid = __builtin_amdgcn_readfirstlane(tid >> 6), lane = tid & 63, wr = wid >> 2, wc = wid & 3, fr = lane & 15, fq = lane >> 4;
    const int nt = rowB / 128;
    const size_t kstep = (size_t)128;
    const size_t hstep = (size_t)HALF * rowB;
    const int fp8_one = 0x7F7F7F7F;
    unsigned voffB[2]; int sR[2], sC[2];
#pragma unroll
    for (int i = 0; i < 2; ++i) { int R, C; stage_rc(tid * 16 + i * 8192, R, C); const int Rb = (R & ~31) + perm32(R & 31); sR[i] = R; sC[i] = 2 * C; voffB[i] = (unsigned)(Rb * rowB + 2 * C); }
    const unsigned lbase = (unsigned)__builtin_amdgcn_readfirstlane((int)((unsigned)(size_t)lds + (unsigned)wid * 1024u));
    const int aoff = lds_byte(wr * 64 + fr, fq * 8), boff = lds_byte(wc * 32 + fr, fq * 8);
#define PG8_SA(b, h) (((b) * 2 + (h)) * HTB)
#define PG8_SB(b, h) ((4 + (b) * 2 + (h)) * HTB)
#define PG8_GLDS(ldsdst, voff, sbase) asm volatile("s_mov_b32 m0, %0\n\tglobal_load_lds_dwordx4 %1, %2" :: "s"(ldsdst), "v"(voff), "s"(sbase) : "memory", "m0")
#define PG8_STAGE_B(bufoff, gbase) do { _Pragma("unroll") for (int _i = 0; _i < 2; ++_i) PG8_GLDS(lbase + (unsigned)((bufoff) + _i * 8192), voffB[_i], (const char*)(gbase)); } while (0)
#define PG8_STAGE_A(bufoff, gbase, off, h) do { _Pragma("unroll") for (int _i = 0; _i < 2; ++_i) PG8_GLDS(lbase + (unsigned)((bufoff) + _i * 8192), (off)[GATHER ? (h) : 0][_i], GATHER ? (const char*)(gbase) : (const char*)(gbase) + (h) * hstep); } while (0)
#define PG8_LDA(dst, b, h) do { _Pragma("unroll") for (int m = 0; m < 4; ++m) _Pragma("unroll") for (int k = 0; k < 2; ++k) dst[m][k] = *(const LAS bf16x8*)(lds + PG8_SA(b, h) + aoff + m * 2048 + k * 1024); } while (0)
#define PG8_LDB(dst, b, h) do { _Pragma("unroll") for (int n = 0; n < 2; ++n) _Pragma("unroll") for (int k = 0; k < 2; ++k) dst[n][k] = *(const LAS bf16x8*)(lds + PG8_SB(b, h) + boff + n * 2048 + k * 1024); } while (0)
#define PG8_CAT(x, y) __builtin_shufflevector(__builtin_bit_cast(i32x4, (x)), __builtin_bit_cast(i32x4, (y)), 0, 1, 2, 3, 4, 5, 6, 7)
#define PG8_MMA(ai, bj, At, Bt) do { __builtin_amdgcn_s_setprio(1); _Pragma("unroll") for (int m = 0; m < 4; ++m) _Pragma("unroll") for (int n = 0; n < 2; ++n) { \
        if constexpr (FP8) acc[ai][bj][m][n] = __builtin_amdgcn_mfma_scale_f32_16x16x128_f8f6f4(PG8_CAT(Bt[n][0], Bt[n][1]), PG8_CAT(At[m][0], At[m][1]), acc[ai][bj][m][n], 0, 0, 0, fp8_one, 0, fp8_one); \
        else { _Pragma("unroll") for (int k = 0; k < 2; ++k) acc[ai][bj][m][n] = __builtin_amdgcn_mfma_f32_16x16x32_bf16(Bt[n][k], At[m][k], acc[ai][bj][m][n], 0, 0, 0); } } \
        __builtin_amdgcn_s_setprio(0); } while (0)
#define PG8_WAIT_V(n) asm volatile("s_waitcnt vmcnt(" #n ")" ::: "memory")
#define PG8_WAIT_L(n) asm volatile("s_waitcnt lgkmcnt(" #n ")" ::: "memory")
#define PG8_BAR __builtin_amdgcn_s_barrier()
#define PG8_SCHED __builtin_amdgcn_sched_barrier(0)
    Unit cur, nxt; int ui = 0;
    if (!S.next(0, cur)) return;
    unsigned coff[2][2];
#pragma unroll
    for (int h = 0; h < 2; ++h)
#pragma unroll
        for (int i = 0; i < 2; ++i) {
            if constexpr (GATHER) coff[h][i] = (unsigned)(S.gather_tok(cur, h * HALF + sR[i]) * rowB + sC[i]);
            else coff[h][i] = (unsigned)(sR[i] * rowB + sC[i]);
        }
    f32x4 acc[2][2][4][2];
#pragma unroll
    for (int a = 0; a < 2; ++a)
#pragma unroll
        for (int b = 0; b < 2; ++b)
#pragma unroll
            for (int m = 0; m < 4; ++m)
#pragma unroll
                for (int n = 0; n < 2; ++n) acc[a][b][m][n] = (f32x4){0.f, 0.f, 0.f, 0.f};
    bf16x8 At[4][2], B0[2][2], B1[2][2];
    const char* cA = cur.a; const char* cB = cur.b;
    PG8_STAGE_B(PG8_SB(0, 0), cB); PG8_STAGE_B(PG8_SB(0, 1), cB + hstep); PG8_STAGE_A(PG8_SA(0, 0), cA, coff, 0); PG8_STAGE_A(PG8_SA(0, 1), cA, coff, 1);
    if (wr == 1) PG8_BAR;
    PG8_WAIT_V(2); PG8_BAR;
    PG8_STAGE_B(PG8_SB(1, 0), cB + kstep); PG8_STAGE_A(PG8_SA(1, 0), cA + kstep, coff, 0); PG8_STAGE_B(PG8_SB(1, 1), cB + hstep + kstep);
    PG8_WAIT_V(6); PG8_BAR;
    for (;;) {
        const bool has_next = S.next(ui + 1, nxt);
        const char* nA = has_next ? nxt.a : cA; const char* nB = has_next ? nxt.b : cB;
        if constexpr (GATHER) {
            if (has_next) asm volatile("s_mov_b32 m0, %0\n\tglobal_load_lds_dword %1, %2" :: "s"((unsigned)__builtin_amdgcn_readfirstlane((int)((unsigned)(size_t)lds + (unsigned)(PERMBUF_OFF + wr * 1024 + (wid & 3) * 256)))), "v"((unsigned)(lane * 4)), "s"(uni((const char*)(S.perm_of(nxt) + (wid & 3) * 64))) : "memory", "m0");
        }
        for (int t = 0; t < nt; t += 2) {
            const bool last = (t == nt - 2);
            const char* a1 = cA + (size_t)(t + 1) * kstep;
            const char* a2 = last ? nA : cA + (size_t)(t + 2) * kstep; const char* b2 = last ? nB : cB + (size_t)(t + 2) * kstep;
            const char* a3 = a2 + kstep; const char* b3 = b2 + kstep;
            PG8_LDB(B0, 0, 0); PG8_LDB(B1, 0, 1); PG8_SCHED; PG8_LDA(At, 0, 0); PG8_STAGE_A(PG8_SA(1, 1), a1, coff, 1);
            if constexpr (GATHER) { if (last && has_next) {
                int t_ = tid; asm volatile("" : "+v"(t_));
#pragma unroll
                for (int i = 0; i < 2; ++i) { int R_, C_; stage_rc(t_ * 16 + i * 8192, R_, C_);
#pragma unroll
                    for (int h = 0; h < 2; ++h) { int tok; asm volatile("ds_read_b32 %0, %1" : "=v"(tok) : "v"((unsigned)(size_t)lds + (unsigned)(PERMBUF_OFF + wr * 1024 + (h * HALF + R_) * 4)) : "memory");
                        asm volatile("s_waitcnt lgkmcnt(0)" : "+v"(tok) :: "memory"); coff[h][i] = (unsigned)(tok * rowB + 2 * C_); } } } }
            PG8_WAIT_V(8); PG8_WAIT_L(0); PG8_BAR; PG8_MMA(0, 0, At, B0); PG8_MMA(0, 1, At, B1); PG8_BAR; PG8_SCHED;
            PG8_LDA(At, 0, 1); PG8_STAGE_B(PG8_SB(0, 0), b2); PG8_STAGE_B(PG8_SB(0, 1), b2 + hstep); PG8_STAGE_A(PG8_SA(0, 0), a2, coff, 0);
            PG8_WAIT_V(8); PG8_WAIT_L(0); PG8_BAR; PG8_MMA(1, 0, At, B0); PG8_MMA(1, 1, At, B1); PG8_BAR; PG8_SCHED;
            PG8_LDB(B0, 1, 0); PG8_LDB(B1, 1, 1); PG8_SCHED; PG8_LDA(At, 1, 0); PG8_STAGE_A(PG8_SA(0, 1), a2, coff, 1);
            PG8_WAIT_V(8); PG8_WAIT_L(0); PG8_BAR; PG8_MMA(0, 0, At, B0); PG8_MMA(0, 1, At, B1); PG8_BAR; PG8_SCHED;
            PG8_LDA(At, 1, 1); PG8_STAGE_B(PG8_SB(1, 0), b3); PG8_STAGE_B(PG8_SB(1, 1), b3 + hstep); PG8_STAGE_A(PG8_SA(1, 0), a3, coff, 0);
            PG8_WAIT_V(8); PG8_WAIT_L(0); PG8_BAR; PG8_MMA(1, 0, At, B0); PG8_MMA(1, 1, At, B1); PG8_BAR; PG8_SCHED;
        }
        if (wr == 0) PG8_BAR;
        { const int l2 = get_lane(); E(acc, cur, wr, wc, l2 & 15, l2 >> 4); }
        if (!has_next) break;
#pragma unroll
        for (int a = 0; a < 2; ++a)
#pragma unroll
            for (int b = 0; b < 2; ++b)
#pragma unroll
                for (int m = 0; m < 4; ++m)
#pragma unroll
                    for (int n = 0; n < 2; ++n) acc[a][b][m][n] = (f32x4){0.f, 0.f, 0.f, 0.f};
        cur = nxt; cA = nA; cB = nB; ++ui;
        if (wr == 1) PG8_BAR;
    }
    PG8_WAIT_V(0);
    PG8_BAR;
#undef PG8_SA
#undef PG8_SB
#undef PG8_STAGE_A
#undef PG8_STAGE_B
#undef PG8_LDA
#undef PG8_LDB
#undef PG8_MMA
#undef PG8_WAIT_V
#undef PG8_WAIT_L
#undef PG8_BAR
#undef PG8_SCHED
}

typedef f32x4 AccT[2][2][4][2];
#define EPI_ROWS_BEGIN const int row0 = u.pm * BM + wr * 64 + fr; const int colw = wc * 32 + 8 * fq; \
    _Pragma("unroll") for (int ai = 0; ai < 2; ++ai) _Pragma("unroll") for (int m = 0; m < 4; ++m) { const int r = row0 + ai * HALF + m * 16;
#define EPI_ROWS_END }

struct EpiInAB {
    bf16_t* Z; const float* rstd;
    __device__ __forceinline__ void operator()(const AccT& acc, const Unit& u, int wr, int wc, int fr, int fq) const {
        const bool act = u.pn < 4;
        EPI_ROWS_BEGIN
            const float rs = rstd[r]; bf16_t* rowp = Z + (size_t)r * AB_IN + u.pn * BM + colw;
#pragma unroll
            for (int bj = 0; bj < 2; ++bj) { float v[8];
#pragma unroll
                for (int j = 0; j < 4; ++j) { v[j] = acc[ai][bj][m][0][j] * rs; v[4 + j] = acc[ai][bj][m][1][j] * rs; }
                if (act) {
#pragma unroll
                    for (int j = 0; j < 8; ++j) v[j] = fgelu_tanh(v[j]); }
                *(u32x4*)(rowp + bj * HALF) = pack8(v); }
        EPI_ROWS_END
    }
};
struct EpiPlain {
    bf16_t* O; int ldc;
    __device__ __forceinline__ void operator()(const AccT& acc, const Unit& u, int wr, int wc, int fr, int fq) const {
        EPI_ROWS_BEGIN
            bf16_t* rowp = O + (size_t)r * ldc + u.pn * BM + colw;
#pragma unroll
            for (int bj = 0; bj < 2; ++bj) { float v[8];
#pragma unroll
                for (int j = 0; j < 4; ++j) { v[j] = acc[ai][bj][m][0][j]; v[4 + j] = acc[ai][bj][m][1][j]; }
                *(u32x4*)(rowp + bj * HALF) = pack8(v); }
        EPI_ROWS_END
    }
};
template <bool MOE> struct EpiSwiGLU {
    bf16_t* H; int ldh; const float* rstd; const int* perm;
    __device__ __forceinline__ void operator()(const AccT& acc, const Unit& u, int wr, int wc, int fr, int fq) const {
        EPI_ROWS_BEGIN
            const int tok = MOE ? perm[r] : r; const float rs = rstd[tok];
            float v[8];
#pragma unroll
            for (int n = 0; n < 2; ++n)
#pragma unroll
                for (int j = 0; j < 4; ++j) { const float g = acc[ai][0][m][n][j] * rs, up = acc[ai][1][m][n][j] * rs; v[4 * n + j] = fsilu(g) * up; }
            *(u32x4*)(H + (size_t)r * ldh + u.pn * HALF + colw) = pack8(v);
        EPI_ROWS_END
    }
};
struct EpiSwiGLU8 {
    unsigned char* H; int ldh;
    __device__ __forceinline__ void operator()(const AccT& acc, const Unit& u, int wr, int wc, int fr, int fq) const {
        EPI_ROWS_BEGIN
            float v[8];
#pragma unroll
            for (int n = 0; n < 2; ++n)
#pragma unroll
                for (int j = 0; j < 4; ++j) { const float g = acc[ai][0][m][n][j] * (1.0f / SC_GU), up = acc[ai][1][m][n][j] * (1.0f / SC_GU); v[4 * n + j] = fsilu(g) * up; }
            *(u32x2*)(H + (size_t)r * ldh + u.pn * HALF + colw) = pack8_fp8(v);
        EPI_ROWS_END
    }
};
struct EpiInC {
    bf16_t* QFIG; const float* ssp; const float* lb;
    __device__ __forceinline__ void operator()(const AccT& acc, const Unit& u, int wr, int wc, int fr, int fq) const {
        const int type = u.pn >> 2; const int colt = (u.pn & 3) * BM + wc * 32 + 8 * fq;
        bf16_t* base = QFIG + (size_t)type * M * CW;
        EPI_ROWS_BEGIN
            const f32x4* sp = (const f32x4*)(ssp + (size_t)r * 16); const f32x4 s0 = sp[0], s1 = sp[1], s2 = sp[2], s3 = sp[3];
            const float ss = ((s0[0] + s0[1]) + (s0[2] + s0[3])) + ((s1[0] + s1[1]) + (s1[2] + s1[3])) + ((s2[0] + s2[1]) + (s2[2] + s2[3])) + ((s3[0] + s3[1]) + (s3[2] + s3[3]));
            const float rs = __builtin_amdgcn_rsqf(ss * (1.0f / D) + EPS);
#pragma unroll
            for (int bj = 0; bj < 2; ++bj) { float v[8];
#pragma unroll
                for (int j = 0; j < 4; ++j) { v[j] = acc[ai][bj][m][0][j] * rs; v[4 + j] = acc[ai][bj][m][1][j] * rs; }
                if (type == 0 || type == 3) {
#pragma unroll
                    for (int j = 0; j < 8; ++j) v[j] = fsilu(v[j]);
                } else if (type == 1) {
                    const f32x4 l0 = *(const f32x4*)(lb + colt + bj * HALF), l1 = *(const f32x4*)(lb + colt + bj * HALF + 4);
#pragma unroll
                    for (int j = 0; j < 8; ++j) { const float l = j < 4 ? l0[j] : l1[j - 4]; v[j] = __builtin_amdgcn_logf(l + (1.0f - l) * fsigmoid(v[j])); }
                }
                *(u32x4*)(base + (size_t)r * CW + colt + bj * HALF) = pack8(v); }
        EPI_ROWS_END
    }
};
template <bool FINAL> struct EpiPleGate {
    const bf16_t* X; const bf16_t* PP; bf16_t* XO; float* ssp; float* OUT;
    __device__ __forceinline__ void operator()(const AccT& acc, const Unit& u, int wr, int wc, int fr, int fq) const {
        EPI_ROWS_BEGIN
            const size_t off = (size_t)r * D + u.pn * BM + colw; float ssq = 0.f;
#pragma unroll
            for (int bj = 0; bj < 2; ++bj) { float x[8], p[8];
                unpack8(*(const u32x4*)(X + off + bj * HALF), x); unpack8(*(const u32x4*)(PP + off + bj * HALF), p);
#pragma unroll
                for (int j = 0; j < 8; ++j) { const float a = j < 4 ? acc[ai][bj][m][0][j] : acc[ai][bj][m][1][j - 4]; x[j] = x[j] + fsigmoid(a) * p[j]; ssq += x[j] * x[j]; }
                if (FINAL) { *(f32x4*)(OUT + off + bj * HALF) = (f32x4){x[0], x[1], x[2], x[3]}; *(f32x4*)(OUT + off + bj * HALF + 4) = (f32x4){x[4], x[5], x[6], x[7]}; }
                else *(u32x4*)(XO + off + bj * HALF) = pack8(x); }
            if (!FINAL) { ssq += __shfl_xor(ssq, 16); ssq += __shfl_xor(ssq, 32); if (fq == 0) ssp[(size_t)r * 16 + u.pn * 4 + wc] = ssq; }
        EPI_ROWS_END
    }
};
struct EpiMoeDown {
    const int* rowinfo; bf16_t* slots;
    __device__ __forceinline__ void operator()(const AccT& acc, const Unit& u, int wr, int wc, int fr, int fq) const {
        EPI_ROWS_BEGIN
            const int info = rowinfo[2 * r]; const float w = __int_as_float(rowinfo[2 * r + 1]) * (1.0f / SC_DN);
            if (info >= 0) { bf16_t* rowp = slots + (size_t)(info & 1) * M * D + (size_t)(info >> 1) * D + u.pn * BM + colw;
#pragma unroll
                for (int bj = 0; bj < 2; ++bj) { float v[8];
#pragma unroll
                    for (int j = 0; j < 4; ++j) { v[j] = acc[ai][bj][m][0][j] * w; v[4 + j] = acc[ai][bj][m][1][j] * w; }
                    *(u32x4*)(rowp + bj * HALF) = pack8(v); } }
        EPI_ROWS_END
    }
};
}

constexpr size_t MiB = 1u << 20;
constexpr size_t WS_CTL = 0, CTL_ZERO_BYTES = 1 * MiB;
constexpr size_t WS_SMALL = 1 * MiB;
constexpr size_t SM_RSTD0 = WS_SMALL, SM_RSTD1 = SM_RSTD0 + 128 * 1024, SM_RSTD4 = SM_RSTD1 + 128 * 1024;
constexpr size_t SM_LB = SM_RSTD4 + 128 * 1024;
constexpr size_t SM_ROUTE = SM_LB + 4096;
constexpr size_t SM_CNT = SM_ROUTE + 512 * 1024;
constexpr size_t SM_META = SM_CNT + 32 * 1024;
constexpr size_t SM_PERM = SM_META + 4096;
constexpr size_t SM_RINFO = SM_PERM + 512 * 1024;
constexpr size_t SM_SSP = SM_RINFO + 1024 * 1024;
constexpr size_t SM_DLOG = SM_SSP + 2 * MiB;
constexpr size_t SM_W16 = SM_DLOG + 128 * 1024;
static_assert(SM_W16 + 256 * 1024 <= 9 * MiB, "small arrays");
constexpr size_t WS_W = 9 * MiB;
constexpr size_t W_INAB = WS_W, W_OUTAB = W_INAB + 5 * MiB, W_GU0 = W_OUTAB + 2 * MiB, W_DN0 = W_GU0 + 11 * MiB, W_INC = W_DN0 + 5 * MiB + 512 * 1024,
                 W_OUTC = W_INC + 8 * MiB, W_EGU8 = W_OUTC + 2 * MiB, W_EDN8 = W_EGU8 + 56 * MiB, W_PPROJ = W_EDN8 + 28 * MiB, W_PGATE = W_PPROJ + 1 * MiB, W_END = W_PGATE + 4 * MiB;
constexpr size_t WS_PB = W_END;
constexpr size_t WS_XA = WS_PB + 32 * MiB, WS_XB = WS_XA + 64 * MiB;
constexpr size_t WS_X8 = WS_XB + 64 * MiB;
constexpr size_t WS_R = WS_X8 + 32 * MiB;
constexpr size_t R_BYTES = (size_t)MAXP * 256 * EFF * 2;
constexpr size_t WS_END = WS_R + R_BYTES;
constexpr size_t R_Z = 0, R_Y = 160 * MiB, R_MIX = 224 * MiB, R_PP = 288 * MiB, R_HF = 0;
constexpr size_t R_QFIG = 0, R_O = 256 * MiB, R_OG = 384 * MiB, R_MIX1 = 0, R_H = 0, R_PP1 = 0;

constexpr int CW_BAR = 4096;

constexpr int RING_BYTES = 131072;
constexpr int LDSCTL_OFF = RING_BYTES, MISC_OFF = LDSCTL_OFF + 320;
constexpr int LDS_BYTES = 147456;

#define XB_TMO      128
#define XB_XCNT(j)  (256  + 64 * (j))
#define XB_XSUB(j)  (1280 + 64 * (j))
#define XB_XGEN(j)  (2304 + 64 * (j))
#define XB_TOP      3328
#define XB_TOPGEN   3392
#define XCD_BAR_WORDS 3456
#define XB_SPIN_CAP (1u << 18)
__device__ __forceinline__ unsigned xb_ld(unsigned* p)              { return __hip_atomic_load(p, __ATOMIC_RELAXED, __HIP_MEMORY_SCOPE_AGENT); }
__device__ __forceinline__ unsigned xb_add(unsigned* p, unsigned v) { return __hip_atomic_fetch_add(p, v, __ATOMIC_RELAXED, __HIP_MEMORY_SCOPE_AGENT); }
__device__ __forceinline__ unsigned xb_xcc_id() { return (unsigned)__builtin_amdgcn_s_getreg((3 << 11) | 20) & 0xFu; }
#define XB_SPIN(cond, bar) do { unsigned _sp = 0; while (cond) { __builtin_amdgcn_s_sleep(1); \
    if ((++_sp & 255u) == 0u) { if (xb_ld(&(bar)[XB_TMO])) break; if (_sp > XB_SPIN_CAP) { atomicAdd(&(bar)[XB_TMO], 1u); break; } } } } while (0)
struct XcdBarrier { unsigned* bar; unsigned x; volatile LAS unsigned* st; };
__device__ __forceinline__ XcdBarrier xcd_barrier_post(unsigned* bar, volatile LAS unsigned* st) {
    XcdBarrier b; b.bar = bar; b.x = xb_xcc_id(); b.st = st;
    if (threadIdx.x == 0) (void)xb_add(&bar[XB_XCNT(b.x)], 1u);
    return b;
}
__device__ __forceinline__ void xcd_barrier_complete(unsigned* bar, unsigned x, unsigned& nloc, unsigned& nx) {
    const unsigned G = gridDim.x * gridDim.y * gridDim.z;
    unsigned sum, cnt, mine, sp = 0u;
    for (;;) {
        sum = 0u; cnt = 0u; mine = 0u;
#pragma unroll
        for (unsigned j = 0; j < 16; ++j) { const unsigned c = xb_ld(&bar[XB_XCNT(j)]); sum += c; cnt += (c > 0u) ? 1u : 0u; mine = (j == x) ? c : mine; }
        if (sum == G) break;
        __builtin_amdgcn_s_sleep(1);
        if ((++sp & 255u) == 0u) { if (xb_ld(&bar[XB_TMO])) break; if (sp > XB_SPIN_CAP) { atomicAdd(&bar[XB_TMO], 1u); break; } }
    }
    nloc = mine > 0u ? mine : 1u; nx = cnt > 0u ? cnt : 1u;
}
__device__ __forceinline__ void xcd_barrier(const XcdBarrier& b) {
    asm volatile("s_waitcnt vmcnt(0)" ::: "memory");
    __syncthreads();
    if (threadIdx.x == 0) {
        unsigned* bar = b.bar;
        __builtin_amdgcn_s_waitcnt(0);
        unsigned nloc = b.st[0], nx = b.st[1];
        if (nloc == 0u) { xcd_barrier_complete(bar, b.x, nloc, nx); b.st[0] = nloc; b.st[1] = nx; }
        const unsigned old = xb_add(&bar[XB_XSUB(b.x)], 1u);
        const unsigned gen = old / nloc;
        if (old + 1u == (gen + 1u) * nloc) {
            __builtin_amdgcn_fence(__ATOMIC_RELEASE, "agent");
            asm volatile("s_waitcnt vmcnt(0)" ::: "memory");
            const unsigned og = xb_add(&bar[XB_TOP], 1u);
            const unsigned tg = og / nx;
            if (og + 1u == (tg + 1u) * nx) xb_add(&bar[XB_TOPGEN], 1u);
            else XB_SPIN(xb_ld(&bar[XB_TOPGEN]) == tg, bar);
            __builtin_amdgcn_fence(__ATOMIC_ACQUIRE, "agent");
            xb_add(&bar[XB_XGEN(b.x)], 1u);
            asm volatile("s_waitcnt vmcnt(0)" ::: "memory");
        } else {
            XB_SPIN(xb_ld(&bar[XB_XGEN(b.x)]) == gen, bar);
            __builtin_amdgcn_fence(__ATOMIC_ACQUIRE, "agent");
            asm volatile("s_waitcnt vmcnt(0)" ::: "memory");
        }
    }
    __syncthreads();
}


namespace hg {
constexpr int QS_OFF = 0, QS_RS = 272, KS_OFF = 17408, KS_RS = 288, IS_OFF = 35840, IS_RS = 288, PS_OFF = 54272, PS_RS = 144,
              TOT_OFF = 63488, RSC_OFF = 67584, DSC_OFF = 68096, RED_OFF = 68608;
typedef short s16x4 __attribute__((ext_vector_type(4)));
#define HG_MFMA(a, b, c) __builtin_amdgcn_mfma_f32_16x16x32_bf16((a), (b), (c), 0, 0, 0)
__device__ __forceinline__ bf16x8 rowfrag(const LAS unsigned char* img, int rs, int row, int step, int g) {
    const LAS s16x4* p = (const LAS s16x4*)(img + row * rs + (32 * step + 4 * g) * 2); const s16x4 lo = p[0], hi = p[4];
    return __builtin_shufflevector(lo, hi, 0, 1, 2, 3, 4, 5, 6, 7);
}
__device__ __forceinline__ bf16x8 trfrag(unsigned img_addr, int rs, int sb, int cb, int c, int g) {
    const unsigned a0 = img_addr + (unsigned)((32 * sb + 4 * g + (c >> 2)) * rs + 32 * cb + 8 * (c & 3)), a1 = a0 + (unsigned)(16 * rs);
    s16x4 lo, hi;
    asm volatile("ds_read_b64_tr_b16 %0, %2\n\tds_read_b64_tr_b16 %1, %3\n\ts_waitcnt lgkmcnt(0)" : "=&v"(lo), "=&v"(hi) : "v"(a0), "v"(a1) : "memory");
    return __builtin_shufflevector(lo, hi, 0, 1, 2, 3, 4, 5, 6, 7);
}
__device__ __forceinline__ bf16x8 pack_acc(const f32x4 a, const f32x4 b) {
    u32x4 p; p.x = cvt_pk_bf16(a[0], a[1]); p.y = cvt_pk_bf16(a[2], a[3]); p.z = cvt_pk_bf16(b[0], b[1]); p.w = cvt_pk_bf16(b[2], b[3]);
    return __builtin_bit_cast(bf16x8, p);
}
template <int PASS>
__device__ __forceinline__ void run(LAS unsigned char* lds, const bf16_t* Qb, const bf16_t* Fb, const bf16_t* Ib, const bf16_t* Gb,
                                    const float* onormg, float* Useg, float* Dlog, bf16_t* OG, int item) {
    const int tid = threadIdx.x, lane = tid & 63, w = __builtin_amdgcn_readfirstlane(tid >> 6), c = lane & 15, g = lane >> 4;
    const int b = item >> 6, h = (item >> 3) & 7, seg = item & 7;
    const size_t row0 = (size_t)b * SEQ + (size_t)seg * 1024;
    const int colh = h * 128;
    const int kp = lane, tg = w;
    const int isr = tid >> 3, ipc = tid & 7;
    const unsigned lds_addr = (unsigned)(size_t)lds;
    f32x4 S[8];
#pragma unroll
    for (int kt = 0; kt < 8; ++kt) S[kt] = (f32x4){0.f, 0.f, 0.f, 0.f};
    if (PASS == 2) {
        for (int j = 0; j < seg; ++j) { const int it = item - seg + j;
#pragma unroll
            for (int kt = 0; kt < 8; ++kt) { const f32x4 dl = *(const f32x4*)(Dlog + (size_t)it * 128 + 16 * kt + 4 * g);
                const f32x4 uu = *((const f32x4*)Useg + ((size_t)(it * 8 + w) * 8 + kt) * 64 + lane);
#pragma unroll
                for (int r = 0; r < 4; ++r) S[kt][r] = __builtin_amdgcn_exp2f(dl[r]) * S[kt][r] + uu[r]; } }
    }
    f32x4 og4 = (f32x4){0.f, 0.f, 0.f, 0.f}; if (PASS == 2) og4 = *(const f32x4*)(onormg + colh + 16 * w + 4 * g);
    float bsum0 = 0.f, bsum1 = 0.f;
    unsigned lfw[8], qw[8]; u32x4 iw0, iw1;
#pragma unroll
    for (int j = 0; j < 8; ++j) { const size_t r = row0 + 8 * tg + j; lfw[j] = *(const unsigned*)(Fb + r * CW + colh + 2 * kp); qw[j] = PASS == 2 ? *(const unsigned*)(Qb + r * CW + colh + 2 * kp) : 0u; }
    { const size_t r = row0 + isr; iw0 = *(const u32x4*)(Ib + r * CW + colh + ipc * 16); iw1 = *(const u32x4*)(Ib + r * CW + colh + ipc * 16 + 8); }
    for (int ch = 0; ch < 16; ++ch) {
        const size_t crow = row0 + (size_t)ch * 64;
        float b0[8], b1[8]; { float a0 = 0.f, a1 = 0.f;
#pragma unroll
            for (int j = 0; j < 8; ++j) { a0 += bflo(lfw[j]); a1 += bfhi(lfw[j]); b0[j] = a0; b1[j] = a1; }
            *(LAS f32x2*)(lds + TOT_OFF + (tg * 128 + 2 * kp) * 4) = (f32x2){a0, a1}; }
        u32x2 gw[4];
        if (PASS == 2) {
#pragma unroll
            for (int tt = 0; tt < 4; ++tt) gw[tt] = *(const u32x2*)(Gb + (crow + 16 * tt + c) * CW + colh + 16 * w + 4 * g); }
        __syncthreads();
        { float p0 = 0.f, p1 = 0.f, r0 = 0.f, r1 = 0.f, e0 = 0.f, e1 = 0.f;
#pragma unroll
          for (int t8 = 0; t8 < 8; ++t8) { const f32x2 tv = *(const LAS f32x2*)(lds + TOT_OFF + (t8 * 128 + 2 * kp) * 4);
              if (t8 < tg) { p0 += tv.x; p1 += tv.y; } if (t8 < 4) { r0 += tv.x; r1 += tv.y; } e0 += tv.x; e1 += tv.y; }
#pragma unroll
          for (int j = 0; j < 8; ++j) { const int t = 8 * tg + j; const float bb0 = b0[j] + p0, bb1 = b1[j] + p1;
              const float k0 = 1.0f - __builtin_amdgcn_exp2f(bflo(lfw[j])), k1 = 1.0f - __builtin_amdgcn_exp2f(bfhi(lfw[j]));
              *(LAS unsigned*)(lds + KS_OFF + t * KS_RS + kp * 4) = cvt_pk_bf16(k0 * __builtin_amdgcn_exp2f(r0 - bb0), k1 * __builtin_amdgcn_exp2f(r1 - bb1));
              if (PASS == 2) *(LAS unsigned*)(lds + QS_OFF + t * QS_RS + kp * 4) = cvt_pk_bf16(bflo(qw[j]) * __builtin_amdgcn_exp2f(bb0 - r0), bfhi(qw[j]) * __builtin_amdgcn_exp2f(bb1 - r1)); }
          if (tg == 0) { *(LAS f32x2*)(lds + RSC_OFF + kp * 8) = (f32x2){__builtin_amdgcn_exp2f(r0), __builtin_amdgcn_exp2f(r1)};
              *(LAS f32x2*)(lds + DSC_OFF + kp * 8) = (f32x2){__builtin_amdgcn_exp2f(e0 - r0), __builtin_amdgcn_exp2f(e1 - r1)}; bsum0 += e0; bsum1 += e1; }
          *(LAS u32x4*)(lds + IS_OFF + isr * IS_RS + ipc * 32) = iw0; *(LAS u32x4*)(lds + IS_OFF + isr * IS_RS + ipc * 32 + 16) = iw1; }
        { const size_t nrow = row0 + (size_t)(ch < 15 ? ch + 1 : ch) * 64;
#pragma unroll
          for (int j = 0; j < 8; ++j) { const size_t r = nrow + 8 * tg + j; lfw[j] = *(const unsigned*)(Fb + r * CW + colh + 2 * kp); if (PASS == 2) qw[j] = *(const unsigned*)(Qb + r * CW + colh + 2 * kp); }
          const size_t r = nrow + isr; iw0 = *(const u32x4*)(Ib + r * CW + colh + ipc * 16); iw1 = *(const u32x4*)(Ib + r * CW + colh + ipc * 16 + 8); }
        __syncthreads();
        if (PASS == 2) {
            const int st = w >> 1;
            bf16x8 Kf[4];
#pragma unroll
            for (int sp = 0; sp < 4; ++sp) Kf[sp] = rowfrag(lds + KS_OFF, KS_RS, 16 * st + c, sp, g);
#pragma unroll
            for (int i = 0; i < 2; ++i) { const int tt = 2 * (w & 1) + i; f32x4 acc = (f32x4){0.f, 0.f, 0.f, 0.f};
#pragma unroll
                for (int sp = 0; sp < 4; ++sp) acc = HG_MFMA(Kf[sp], rowfrag(lds + QS_OFF, QS_RS, 16 * tt + c, sp, g), acc);
                const int t = 16 * tt + c, s0 = 16 * st + 4 * g;
#pragma unroll
                for (int r = 0; r < 4; ++r) acc[r] = (s0 + r <= t) ? acc[r] : 0.f;
                u32x2 pw; pw.x = cvt_pk_bf16(acc[0], acc[1]); pw.y = cvt_pk_bf16(acc[2], acc[3]);
                *(LAS u32x2*)(lds + PS_OFF + t * PS_RS + s0 * 2) = pw; }
            __syncthreads();
        }
#pragma unroll
        for (int kt = 0; kt < 8; ++kt) { const f32x4 rs = *(const LAS f32x4*)(lds + RSC_OFF + (16 * kt + 4 * g) * 4); S[kt] = S[kt] * rs; }
        bf16x8 If[2];
#pragma unroll
        for (int sb = 0; sb < 2; ++sb) If[sb] = trfrag(lds_addr + IS_OFF, IS_RS, sb, w, c, g);
        f32x4 O[4];
        if (PASS == 2) {
            bf16x8 Sp[4];
#pragma unroll
            for (int sp = 0; sp < 4; ++sp) Sp[sp] = pack_acc(S[2 * sp], S[2 * sp + 1]);
#pragma unroll
            for (int tt = 0; tt < 4; ++tt) { f32x4 acc = (f32x4){0.f, 0.f, 0.f, 0.f};
#pragma unroll
                for (int sp = 0; sp < 4; ++sp) acc = HG_MFMA(Sp[sp], rowfrag(lds + QS_OFF, QS_RS, 16 * tt + c, sp, g), acc);
#pragma unroll
                for (int sb = 0; sb < 2; ++sb) if (32 * sb <= 16 * tt + 15) acc = HG_MFMA(If[sb], rowfrag(lds + PS_OFF, PS_RS, 16 * tt + c, sb, g), acc);
                O[tt] = acc; }
        }
#pragma unroll
        for (int kt = 0; kt < 8; ++kt) {
#pragma unroll
            for (int sb = 0; sb < 2; ++sb) S[kt] = HG_MFMA(trfrag(lds_addr + KS_OFF, KS_RS, sb, kt, c, g), If[sb], S[kt]);
            const f32x4 ds = *(const LAS f32x4*)(lds + DSC_OFF + (16 * kt + 4 * g) * 4); S[kt] = S[kt] * ds; }
        if (PASS == 2) {
#pragma unroll
            for (int tt = 0; tt < 4; ++tt) { float ss = (O[tt][0] * O[tt][0] + O[tt][1] * O[tt][1]) + (O[tt][2] * O[tt][2] + O[tt][3] * O[tt][3]);
                ss += __shfl_xor(ss, 16); ss += __shfl_xor(ss, 32); if (g == 0) *(LAS float*)(lds + RED_OFF + ((16 * tt + c) * 8 + w) * 4) = ss; }
            __syncthreads();
#pragma unroll
            for (int tt = 0; tt < 4; ++tt) { const LAS f32x4* rp = (const LAS f32x4*)(lds + RED_OFF + (16 * tt + c) * 32); const f32x4 ra = rp[0], rb = rp[1];
                const float tot = ((ra[0] + ra[1]) + (ra[2] + ra[3])) + ((rb[0] + rb[1]) + (rb[2] + rb[3]));
                const float rstd = __builtin_amdgcn_rsqf(tot * (1.0f / 128.0f) + EPS);
                const float o0 = O[tt][0] * rstd * og4[0] * bflo(gw[tt].x), o1 = O[tt][1] * rstd * og4[1] * bfhi(gw[tt].x), o2 = O[tt][2] * rstd * og4[2] * bflo(gw[tt].y), o3 = O[tt][3] * rstd * og4[3] * bfhi(gw[tt].y);
                u32x2 ow; ow.x = cvt_pk_bf16(o0, o1); ow.y = cvt_pk_bf16(o2, o3);
                *(u32x2*)(OG + (crow + 16 * tt + c) * CW + colh + 16 * w + 4 * g) = ow; }
        }
    }
    if (PASS == 1) {
#pragma unroll
        for (int kt = 0; kt < 8; ++kt) *((f32x4*)Useg + ((size_t)(item * 8 + w) * 8 + kt) * 64 + lane) = S[kt];
        if (tg == 0) *(f32x2*)(Dlog + (size_t)item * 128 + 2 * kp) = (f32x2){bsum0, bsum1};
    }
    __syncthreads();
}
}

struct Args { const float* in[22]; float* out; unsigned char* ws; int ph_lo, ph_hi, li, pad; };
enum { I_X = 0, I_P, I_NORMG, I_WINAB, I_ALNG, I_ALNB, I_AWS, I_ABS, I_BCONV, I_WOUTAB, I_FFNGU, I_FFNDN, I_WINC, I_LBP, I_ONORMG, I_WOUTC, I_WROUTER, I_BROUTER, I_EGU, I_EDN, I_PPROJ, I_PGATE };

template <bool F8> __device__ __forceinline__ void transpose_item(const float* W, int K, int N, void* WTv, const float* gain, int gu_ff, float scale, LAS float* scr, int item, int lane) {
    const int nblk = N / 32, kb = item / nblk, nb = item % nblk, k0 = 64 * kb, n0 = 32 * nb;
#pragma unroll 8
    for (int i = 0; i < 32; ++i) { const int kk = 2 * i + (lane >> 5); float w = W[(size_t)(k0 + kk) * N + n0 + (lane & 31)]; if (gain) w *= gain[k0 + kk]; if (F8) w *= scale; scr[kk * 33 + (lane & 31)] = w; }
    asm volatile("s_waitcnt lgkmcnt(0)" ::: "memory");
    int d0 = n0; if (gu_ff) { const int half = n0 >= gu_ff ? 1 : 0, j = n0 - half * gu_ff; d0 = (j / 128) * 256 + half * 128 + (j % 128); }
    const int c = lane & 7;
#pragma unroll
    for (int j = 0; j < 4; ++j) { const int n = (lane >> 3) + 8 * j; const LAS float* s = scr + (8 * c) * 33 + n;
        if (F8) { u32x2 o; o.x = pk4_fp8(s[0 * 33], s[1 * 33], s[2 * 33], s[3 * 33]); o.y = pk4_fp8(s[4 * 33], s[5 * 33], s[6 * 33], s[7 * 33]);
            *(u32x2*)((unsigned char*)WTv + (size_t)(d0 + n) * K + k0 + 8 * c) = o; }
        else { u32x4 o; o.x = cvt_pk_bf16(s[0 * 33], s[1 * 33]); o.y = cvt_pk_bf16(s[2 * 33], s[3 * 33]); o.z = cvt_pk_bf16(s[4 * 33], s[5 * 33]); o.w = cvt_pk_bf16(s[6 * 33], s[7 * 33]);
            *(u32x4*)((bf16_t*)WTv + (size_t)(d0 + n) * K + k0 + 8 * c) = o; } }
    asm volatile("s_waitcnt lgkmcnt(0)" ::: "memory");
}

__device__ __forceinline__ void ld_row_bf16(const bf16_t* row, int lane, float (&v)[16]) { unpack8(*(const u32x4*)(row + lane * 8), v); unpack8(*(const u32x4*)(row + 512 + lane * 8), v + 8); }
__device__ __forceinline__ void st_row_bf16(bf16_t* row, int lane, const float (&v)[16]) { *(u32x4*)(row + lane * 8) = pack8(v); *(u32x4*)(row + 512 + lane * 8) = pack8(v + 8); }
__device__ __forceinline__ void ld_row_f32(const float* row, int lane, float (&v)[16]) {
    const f32x4 a = *(const f32x4*)(row + lane * 8), b = *(const f32x4*)(row + lane * 8 + 4), c = *(const f32x4*)(row + 512 + lane * 8), d = *(const f32x4*)(row + 512 + lane * 8 + 4);
#pragma unroll
    for (int j = 0; j < 4; ++j) { v[j] = a[j]; v[4 + j] = b[j]; v[8 + j] = c[j]; v[12 + j] = d[j]; }
}
__device__ __forceinline__ float sumsq16(const float (&v)[16]) { float s = 0.f;
#pragma unroll
    for (int j = 0; j < 16; ++j) s += v[j] * v[j];
    return s; }


template <int NSRC, bool WRITE_RSTD>
__device__ __forceinline__ void thin_resid(const bf16_t* mix0, const bf16_t* mix1, const bf16_t* xin, bf16_t* xout, float* rstd_out, const float* gain, int m0, int nrows, int lane) {
    float g[16]; ld_row_f32(gain, lane, g);
    for (int i0 = 0; i0 < nrows; i0 += 4) {
        float mx[4][16], x[4][16];
#pragma unroll
        for (int r = 0; r < 4; ++r) { const size_t m = (size_t)(m0 + i0 + r); ld_row_bf16(mix0 + m * D, lane, mx[r]); ld_row_bf16(xin + m * D, lane, x[r]);
            if (NSRC == 2) { float m2[16]; ld_row_bf16(mix1 + m * D, lane, m2);
#pragma unroll
                for (int j = 0; j < 16; ++j) mx[r][j] += m2[j]; } }
#pragma unroll
        for (int r = 0; r < 4; ++r) { const size_t m = (size_t)(m0 + i0 + r);
            const float rm = __builtin_amdgcn_rsqf(wave_sum(sumsq16(mx[r])) * (1.0f / D) + EPS);
#pragma unroll
            for (int j = 0; j < 16; ++j) x[r][j] += g[j] * mx[r][j] * rm;
            st_row_bf16(xout + m * D, lane, x[r]);
            if (WRITE_RSTD) { const float ss = wave_sum(sumsq16(x[r])); if (lane == 0) rstd_out[m] = __builtin_amdgcn_rsqf(ss * (1.0f / D) + EPS); } }
    }
}

__global__ void __launch_bounds__(NTHR, 2) trunk_fwd(Args args) {
    extern __shared__ __attribute__((aligned(16))) unsigned char lds_raw[];
    LAS unsigned char* lds = (LAS unsigned char*)lds_raw;
    volatile LAS unsigned* MISC = (volatile LAS unsigned*)(lds + MISC_OFF);
    const int tid = threadIdx.x;
    const int G = gridDim.x, bx = blockIdx.x;
    unsigned char* ws = args.ws;
    for (int u = tid; u < (LDS_BYTES - LDSCTL_OFF) / 4; u += NTHR) ((LAS unsigned*)(lds + LDSCTL_OFF))[u] = 0u;
    __syncthreads();
    XcdBarrier bar; bar.bar = (unsigned*)(ws + WS_CTL) + CW_BAR; bar.x = 0; bar.st = nullptr;
    if (MK_N_LAUNCHES == 1) bar = xcd_barrier_post((unsigned*)(ws + WS_CTL) + CW_BAR, MISC + 8);
    const int lo = args.ph_lo, hi = args.ph_hi;
#define IN(k) (lo <= (k) && (k) < hi)
#define SEAM(k) do { if (IN(k) && IN((k) + 1)) xcd_barrier(bar); } while (0)

    const float* normg = args.in[I_NORMG];
    float* rstd0 = (float*)(ws + SM_RSTD0); float* rstd1 = (float*)(ws + SM_RSTD1); float* rstd4 = (float*)(ws + SM_RSTD4);
    float* LB = (float*)(ws + SM_LB); int* route = (int*)(ws + SM_ROUTE); int* cntg = (int*)(ws + SM_CNT); int* meta = (int*)(ws + SM_META);
    int* perm = (int*)(ws + SM_PERM); int* rinfo = (int*)(ws + SM_RINFO); float* ssp = (float*)(ws + SM_SSP);
    bf16_t* XA = (bf16_t*)(ws + WS_XA); bf16_t* XB = (bf16_t*)(ws + WS_XB); bf16_t* PB = (bf16_t*)(ws + WS_PB);
    unsigned char* R = ws + WS_R;
    const int NGW = G * NWAVES;
    const int RPW = M / G;

    if (IN(0)) for (int rep_ = 0; rep_ < NREP(0); ++rep_) { const int lane = get_lane(), wave = get_wave(); const int gw = bx * NWAVES + wave; (void)gw; (void)lane;
        LAS float* scr = (LAS float*)(lds + wave * 16384);
        constexpr int I1 = 16 * 80, I2 = 16 * 32, I3 = 16 * 176, I4 = 44 * 32, I5 = 16 * 128, I6 = 16 * 32, I7E = 16 * 224, I8E = 56 * 32, I9L = 4 * 32, I10L = 16 * 32;
        constexpr int NITEMS = I1 + I2 + I3 + I4 + I5 + I6 + 8 * I7E + 8 * I8E + 2 * I9L + 2 * I10L;
        for (int it = gw; it < NITEMS; it += NGW) {
            int r = it;
            if (r < I1) { transpose_item<false>(args.in[I_WINAB], D, AB_IN, (bf16_t*)(ws + W_INAB), normg + 0 * D, 0, 1.0f, scr, r, lane); continue; } r -= I1;
            if (r < I2) { transpose_item<false>(args.in[I_WOUTAB], D, D, (bf16_t*)(ws + W_OUTAB), nullptr, 0, 1.0f, scr, r, lane); continue; } r -= I2;
            if (r < I3) { transpose_item<false>(args.in[I_FFNGU], D, 2 * FF, (bf16_t*)(ws + W_GU0), normg + 2 * D, FF, 1.0f, scr, r, lane); continue; } r -= I3;
            if (r < I4) { transpose_item<false>(args.in[I_FFNDN], FF, D, (bf16_t*)(ws + W_DN0), nullptr, 0, 1.0f, scr, r, lane); continue; } r -= I4;
            if (r < I5) { transpose_item<false>(args.in[I_WINC], D, 4 * CW, (bf16_t*)(ws + W_INC), normg + 4 * D, 0, 1.0f, scr, r, lane); continue; } r -= I5;
            if (r < I6) { transpose_item<false>(args.in[I_WOUTC], CW, D, (bf16_t*)(ws + W_OUTC), nullptr, 0, 1.0f, scr, r, lane); continue; } r -= I6;
            if (r < 8 * I7E) { const int e = r / I7E; transpose_item<true>(args.in[I_EGU] + (size_t)e * D * 2 * EFF, D, 2 * EFF, ws + W_EGU8 + (size_t)e * 2 * EFF * D, normg + 6 * D, EFF, SC_GU, scr, r % I7E, lane); continue; } r -= 8 * I7E;
            if (r < 8 * I8E) { const int e = r / I8E; transpose_item<true>(args.in[I_EDN] + (size_t)e * EFF * D, EFF, D, ws + W_EDN8 + (size_t)e * D * EFF, nullptr, 0, SC_DN, scr, r % I8E, lane); continue; } r -= 8 * I8E;
            if (r < 2 * I9L) { const int l = r / I9L; transpose_item<false>(args.in[I_PPROJ] + (size_t)l * PLE * D, PLE, D, (bf16_t*)(ws + W_PPROJ) + (size_t)l * D * PLE, nullptr, 0, 1.0f, scr, r % I9L, lane); continue; } r -= 2 * I9L;
            { const int l = r / I10L; transpose_item<false>(args.in[I_PGATE] + (size_t)l * D * D, D, D, (bf16_t*)(ws + W_PGATE) + (size_t)l * D * D, nullptr, 0, 1.0f, scr, r % I10L, lane); }
        }
        for (int m = gw; m < M; m += NGW) { float v[16]; ld_row_f32(args.in[I_X] + (size_t)m * D, lane, v);
            const float ss = wave_sum(sumsq16(v)); st_row_bf16(XA + (size_t)m * D, lane, v); if (lane == 0) rstd0[m] = __builtin_amdgcn_rsqf(ss * (1.0f / D) + EPS); }
        { const float* p = args.in[I_P]; const size_t n8 = (size_t)2 * M * PLE / 8;
          for (size_t i = (size_t)bx * NTHR + tid; i < n8; i += (size_t)G * NTHR) { const f32x4 a = *(const f32x4*)(p + i * 8), b = *(const f32x4*)(p + i * 8 + 4);
              float v[8] = {a[0], a[1], a[2], a[3], b[0], b[1], b[2], b[3]}; *(u32x4*)(PB + i * 8) = pack8(v); } }
        { bf16_t* W16 = (bf16_t*)(ws + SM_W16); for (int e = bx * NTHR + tid; e < 8 * 128 * 128; e += G * NTHR) W16[e] = f2bf(args.in[I_AWS][e]); }
        if (bx == 0) for (int c = tid; c < CW; c += NTHR) { const float d = args.in[I_LBP][CW + c] - args.in[I_LBP][c]; LB[c] = 1.0f / (1.0f + expf(-d)); }
    }
    SEAM(0);

    if (IN(1)) for (int rep_ = 0; rep_ < NREP(1); ++rep_) { pg8::StaticOrder S; S.init(XA, (const bf16_t*)(ws + W_INAB), M, AB_IN, D, G, bx); pg8::EpiInAB E{(bf16_t*)(R + R_Z), rstd0};
        pg8::gemm_phase<pg8::EpiInAB, pg8::StaticOrder, false>(lds, 2 * D, S, E); }
    SEAM(1);

    if (IN(2)) for (int rep_ = 0; rep_ < NREP(2); ++rep_) { const int lane = get_lane(), wave = get_wave();
        const bf16_t* Z = (const bf16_t*)(R + R_Z); bf16_t* Y = (bf16_t*)(R + R_Y); const bf16_t* W16 = (const bf16_t*)(ws + SM_W16);
        constexpr int IRS = 544;
        const unsigned lds_addr = (unsigned)(size_t)lds; const int c = lane & 15, g = lane >> 4;
        for (int blk = bx; blk < M / 128; blk += G) {
            const int t0 = blk * 128;
            for (int hg2 = 0; hg2 < 2; ++hg2) {
                { const int row = tid >> 2, dq = tid & 3;
#pragma unroll 1
                  for (int hh = 0; hh < 4; ++hh) { const int h = hg2 * 4 + hh; const bf16_t* vp = Z + (size_t)(t0 + row) * AB_IN + 512 + h * 64 + dq * 16; float v[16];
                      unpack8(*(const u32x4*)vp, v); unpack8(*(const u32x4*)(vp + 8), v + 8);
                      float sm = 0.f;
#pragma unroll
                      for (int j = 0; j < 16; ++j) sm += v[j];
                      sm += __shfl_xor(sm, 1); sm += __shfl_xor(sm, 2); const float mu = sm * (1.0f / 64.0f); float q = 0.f;
#pragma unroll
                      for (int j = 0; j < 16; ++j) { v[j] -= mu; q += v[j] * v[j]; }
                      q += __shfl_xor(q, 1); q += __shfl_xor(q, 2); const float rs = __builtin_amdgcn_rsqf(q * (1.0f / 64.0f) + EPS);
                      const float* lg = args.in[I_ALNG] + h * 64 + dq * 16; const float* lb = args.in[I_ALNB] + h * 64 + dq * 16;
#pragma unroll
                      for (int j4 = 0; j4 < 4; ++j4) { const f32x4 gg = *(const f32x4*)(lg + 4 * j4), bb = *(const f32x4*)(lb + 4 * j4);
#pragma unroll
                          for (int j = 0; j < 4; ++j) v[4 * j4 + j] = v[4 * j4 + j] * rs * gg[j] + bb[j]; }
                      LAS unsigned char* ip = lds + row * IRS + (hh * 64 + dq * 16) * 2; *(LAS u32x4*)ip = pack8(v); *(LAS u32x4*)(ip + 16) = pack8(v + 8); } }
                __syncthreads();
                { const int nks = wave < 4 ? 2 : 4; const int i = 16 * wave + c;
#pragma unroll 1
                  for (int hh = 0; hh < 4; ++hh) { const int h = hg2 * 4 + hh; const bf16_t* wrow = W16 + ((size_t)h * 128 + i) * 128 + 4 * g; bf16x8 Bf[4];
#pragma unroll
                      for (int ks = 0; ks < 4; ++ks) { if (ks < nks) { const hg::s16x4 lo = *(const hg::s16x4*)(wrow + 32 * ks), hi = *(const hg::s16x4*)(wrow + 32 * ks + 16); Bf[ks] = __builtin_shufflevector(lo, hi, 0, 1, 2, 3, 4, 5, 6, 7); } else Bf[ks] = Bf[0]; }
                      const float bsv = args.in[I_ABS][h * 128 + i];
#pragma unroll
                      for (int dt = 0; dt < 4; ++dt) { f32x4 acc = (f32x4){0.f, 0.f, 0.f, 0.f};
#pragma unroll
                          for (int ks = 0; ks < 4; ++ks) if (ks < nks) acc = HG_MFMA(hg::trfrag(lds_addr, IRS, ks, hh * 4 + dt, c, g), Bf[ks], acc);
                          const int col = h * 64 + 16 * dt + 4 * g; const u32x2 uw = *(const u32x2*)(Z + (size_t)(t0 + i) * AB_IN + col);
                          u32x2 yw; yw.x = cvt_pk_bf16(bflo(uw.x) * (acc[0] + bsv), bfhi(uw.x) * (acc[1] + bsv)); yw.y = cvt_pk_bf16(bflo(uw.y) * (acc[2] + bsv), bfhi(uw.y) * (acc[3] + bsv));
                          *(u32x2*)(Y + (size_t)(t0 + i) * D + col) = yw; } } }
                __syncthreads();
            }
            { const int cg8 = lane * 8, r0 = t0 + 16 * wave; float w0[8], w1[8], w2[8], p2[8], p1[8];
              { const float* bc = args.in[I_BCONV];
#pragma unroll
                for (int j4 = 0; j4 < 2; ++j4) { const f32x4 a = *(const f32x4*)(bc + cg8 + 4 * j4), b = *(const f32x4*)(bc + 512 + cg8 + 4 * j4), cc = *(const f32x4*)(bc + 1024 + cg8 + 4 * j4);
#pragma unroll
                    for (int j = 0; j < 4; ++j) { w0[4 * j4 + j] = a[j]; w1[4 * j4 + j] = b[j]; w2[4 * j4 + j] = cc[j]; } } }
              if ((r0 % SEQ) != 0) { float xa[8], ca[8], xb2[8], cb2[8];
                  unpack8(*(const u32x4*)(Z + (size_t)(r0 - 2) * AB_IN + 1024 + cg8), xa); unpack8(*(const u32x4*)(Z + (size_t)(r0 - 2) * AB_IN + 1536 + cg8), ca);
                  unpack8(*(const u32x4*)(Z + (size_t)(r0 - 1) * AB_IN + 1024 + cg8), xb2); unpack8(*(const u32x4*)(Z + (size_t)(r0 - 1) * AB_IN + 1536 + cg8), cb2);
#pragma unroll
                  for (int j = 0; j < 8; ++j) { p2[j] = xa[j] * ca[j]; p1[j] = xb2[j] * cb2[j]; } }
              else {
#pragma unroll
                  for (int j = 0; j < 8; ++j) { p2[j] = 0.f; p1[j] = 0.f; } }
              for (int tb = 0; tb < 16; tb += 8) { u32x4 xw[8], cw[8], bw[8];
#pragma unroll
                  for (int t = 0; t < 8; ++t) { const bf16_t* z = Z + (size_t)(r0 + tb + t) * AB_IN + cg8; xw[t] = *(const u32x4*)(z + 1024); cw[t] = *(const u32x4*)(z + 1536); bw[t] = *(const u32x4*)(z + 2048); }
#pragma unroll
                  for (int t = 0; t < 8; ++t) { float xv[8], cv[8], bv[8], o[8]; unpack8(xw[t], xv); unpack8(cw[t], cv); unpack8(bw[t], bv);
#pragma unroll
                      for (int j = 0; j < 8; ++j) { const float p0 = xv[j] * cv[j]; o[j] = bv[j] * (w0[j] * p2[j] + w1[j] * p1[j] + w2[j] * p0); p2[j] = p1[j]; p1[j] = p0; }
                      *(u32x4*)(Y + (size_t)(r0 + tb + t) * D + 512 + cg8) = pack8(o); } } }
        }
    }
    SEAM(2);

    if (IN(3)) for (int rep_ = 0; rep_ < NREP(3); ++rep_) { pg8::StaticOrder S; S.init((const bf16_t*)(R + R_Y), (const bf16_t*)(ws + W_OUTAB), M, D, D, G, bx); pg8::EpiPlain E{(bf16_t*)(R + R_MIX), D};
        pg8::gemm_phase<pg8::EpiPlain, pg8::StaticOrder, false>(lds, 2 * D, S, E); }
    SEAM(3);

    if (IN(4)) for (int rep_ = 0; rep_ < NREP(4); ++rep_) { const int lane = get_lane(), wave = get_wave(); const int gw = bx * NWAVES + wave; (void)gw; (void)lane;
        thin_resid<1, true>((const bf16_t*)(R + R_MIX), nullptr, XA, XB, rstd1, normg + 1 * D, bx * RPW + wave * (RPW / NWAVES), RPW / NWAVES, lane); }
    SEAM(4);

    if (IN(5)) for (int rep_ = 0; rep_ < NREP(5); ++rep_) { pg8::StaticOrder S; S.init(XB, (const bf16_t*)(ws + W_GU0), M, 2 * FF, D, G, bx); pg8::EpiSwiGLU<false> E{(bf16_t*)(R + R_HF), FF, rstd1, nullptr};
        pg8::gemm_phase<pg8::EpiSwiGLU<false>, pg8::StaticOrder, false>(lds, 2 * D, S, E); }
    SEAM(5);

    if (IN(6)) for (int rep_ = 0; rep_ < NREP(6); ++rep_) { pg8::StaticOrder S; S.init((const bf16_t*)(R + R_HF), (const bf16_t*)(ws + W_DN0), M, D, FF, G, bx); pg8::EpiPlain E{(bf16_t*)(R + R_MIX), D};
        pg8::gemm_phase<pg8::EpiPlain, pg8::StaticOrder, false>(lds, 2 * FF, S, E); }
    SEAM(6);

    if (IN(7)) for (int rep_ = 0; rep_ < NREP(7); ++rep_) { const int lane = get_lane(), wave = get_wave(); const int gw = bx * NWAVES + wave; (void)gw; (void)lane;
        thin_resid<1, false>((const bf16_t*)(R + R_MIX), nullptr, XB, XA, nullptr, normg + 3 * D, bx * RPW + wave * (RPW / NWAVES), RPW / NWAVES, lane); }
    SEAM(7);

    if (IN(8)) for (int rep_ = 0; rep_ < NREP(8); ++rep_) { pg8::StaticOrder S; S.init(PB, (const bf16_t*)(ws + W_PPROJ), M, D, PLE, G, bx); pg8::EpiPlain E{(bf16_t*)(R + R_PP), D};
        pg8::gemm_phase<pg8::EpiPlain, pg8::StaticOrder, false>(lds, 2 * PLE, S, E); }
    SEAM(8);

    if (IN(9)) for (int rep_ = 0; rep_ < NREP(9); ++rep_) { pg8::StaticOrder S; S.init(XA, (const bf16_t*)(ws + W_PGATE), M, D, D, G, bx); pg8::EpiPleGate<false> E{XA, (const bf16_t*)(R + R_PP), XB, ssp, nullptr};
        pg8::gemm_phase<pg8::EpiPleGate<false>, pg8::StaticOrder, false>(lds, 2 * D, S, E); }
    SEAM(9);

    if (IN(10)) for (int rep_ = 0; rep_ < NREP(10); ++rep_) { pg8::StaticOrder S; S.init(XB, (const bf16_t*)(ws + W_INC), M, 4 * CW, D, G, bx); pg8::EpiInC E{(bf16_t*)(R + R_QFIG), ssp, LB};
        pg8::gemm_phase<pg8::EpiInC, pg8::StaticOrder, false>(lds, 2 * D, S, E); }
    SEAM(10);

    if (IN(11)) for (int rep_ = 0; rep_ < NREP(11); ++rep_) {
        const bf16_t* Qb = (const bf16_t*)(R + R_QFIG); const bf16_t* Fb = Qb + (size_t)M * CW; const bf16_t* Ib = Fb + (size_t)M * CW; const bf16_t* Gb = Ib + (size_t)M * CW;
        for (int item = bx; item < BATCH * 8 * 8; item += G) { if ((item & 7) == 7) continue;
            hg::run<1>(lds, Qb, Fb, Ib, Gb, args.in[I_ONORMG], (float*)(R + R_O), (float*)(ws + SM_DLOG), (bf16_t*)(R + R_OG), item); }
    }
    SEAM(11);

    if (IN(12)) for (int rep_ = 0; rep_ < NREP(12); ++rep_) {
        const bf16_t* Qb = (const bf16_t*)(R + R_QFIG); const bf16_t* Fb = Qb + (size_t)M * CW; const bf16_t* Ib = Fb + (size_t)M * CW; const bf16_t* Gb = Ib + (size_t)M * CW;
        for (int item = bx; item < BATCH * 8 * 8; item += G)
            hg::run<2>(lds, Qb, Fb, Ib, Gb, args.in[I_ONORMG], (float*)(R + R_O), (float*)(ws + SM_DLOG), (bf16_t*)(R + R_OG), item);
    }
    SEAM(12);

    if (IN(13)) for (int rep_ = 0; rep_ < NREP(13); ++rep_) { pg8::StaticOrder S; S.init((const bf16_t*)(R + R_OG), (const bf16_t*)(ws + W_OUTC), M, D, CW, G, bx); pg8::EpiPlain E{(bf16_t*)(R + R_MIX1), D};
        pg8::gemm_phase<pg8::EpiPlain, pg8::StaticOrder, false>(lds, 2 * CW, S, E); }
    SEAM(13);

    if (IN(14)) for (int rep_ = 0; rep_ < NREP(14); ++rep_) { const int lane = get_lane(), wave = get_wave(); const int gw = bx * NWAVES + wave; (void)gw; (void)lane; const bf16_t* MIX = (const bf16_t*)(R + R_MIX1); float g[16], g2[16]; ld_row_f32(normg + 5 * D, lane, g); ld_row_f32(normg + 6 * D, lane, g2);
        LAS float* wrl = (LAS float*)lds;
        LAS int* lcnt = (LAS int*)(lds + 32768);
        for (int e = tid; e < D * NE; e += NTHR) wrl[e] = args.in[I_WROUTER][e];
        if (tid < NE) lcnt[tid] = 0;
        __syncthreads();
        for (int i = 0; i < RPW / NWAVES; ++i) { const int m = bx * RPW + wave * (RPW / NWAVES) + i; float mx[16], x[16]; ld_row_bf16(MIX + (size_t)m * D, lane, mx); ld_row_bf16(XB + (size_t)m * D, lane, x);
            const float rm = __builtin_amdgcn_rsqf(wave_sum(sumsq16(mx)) * (1.0f / D) + EPS);
#pragma unroll
            for (int j = 0; j < 16; ++j) x[j] += g[j] * mx[j] * rm;
            const float rs = __builtin_amdgcn_rsqf(wave_sum(sumsq16(x)) * (1.0f / D) + EPS);
            st_row_bf16(XA + (size_t)m * D, lane, x); if (lane == 0) rstd4[m] = rs;
            { float xn[16];
#pragma unroll
              for (int j = 0; j < 16; ++j) xn[j] = x[j] * rs;
              unsigned char* x8 = ws + WS_X8 + (size_t)m * D; *(u32x2*)(x8 + lane * 8) = pack8_fp8(xn); *(u32x2*)(x8 + 512 + lane * 8) = pack8_fp8(xn + 8); }
            float lg[NE];
#pragma unroll
            for (int e = 0; e < NE; ++e) lg[e] = 0.f;
#pragma unroll
            for (int j = 0; j < 16; ++j) { const int col = (j < 8 ? 0 : 512) + lane * 8 + (j & 7); const float hn = x[j] * rs * g2[j];
                const LAS f32x4* wp = (const LAS f32x4*)(wrl + col * NE); const f32x4 w0 = wp[0], w1 = wp[1];
#pragma unroll
                for (int e = 0; e < 4; ++e) { lg[e] += hn * w0[e]; lg[4 + e] += hn * w1[e]; } }
#pragma unroll
            for (int e = 0; e < NE; ++e) lg[e] = wave_sum(lg[e]) + args.in[I_BROUTER][e];
            if (lane == 0) { int e1 = 0; float l1 = lg[0];
#pragma unroll
                for (int e = 1; e < NE; ++e) if (lg[e] > l1) { l1 = lg[e]; e1 = e; }
                int e2 = -1; float l2 = -3.0e38f;
#pragma unroll
                for (int e = 0; e < NE; ++e) if (e != e1 && lg[e] > l2) { l2 = lg[e]; e2 = e; }
                const float ex = expf(l2 - l1), w1 = 1.0f / (1.0f + ex), w2 = ex / (1.0f + ex);
                *(i32x4*)(route + (size_t)m * 4) = (i32x4){e1, e2, __float_as_int(w1), __float_as_int(w2)};
                atomicAdd((int*)(lcnt + e1), 1); atomicAdd((int*)(lcnt + e2), 1); } }
        __syncthreads();
        if (tid < NE) cntg[bx * NE + tid] = lcnt[tid];
    }
    SEAM(14);

    if (IN(15)) for (int rep_ = 0; rep_ < NREP(15); ++rep_) { const int lane = get_lane(), wave = get_wave(); const int gw = bx * NWAVES + wave; (void)gw; (void)lane;
        LAS int* lc = (LAS int*)lds;
        LAS int* tot = (LAS int*)(lds + 32768);
        for (int e = tid; e < G * NE; e += NTHR) lc[e] = cntg[e];
        __syncthreads();
        if (tid < NE) { int t = 0, pre = 0; for (int w = 0; w < G; ++w) { if (w == bx) pre = t; t += lc[w * NE + tid]; } tot[tid] = t; tot[8 + tid] = pre; }
        __syncthreads();
        if (tid == 0) { int b = 0; for (int e = 0; e < NE; ++e) { tot[16 + e] = b; b += (tot[e] + 255) & ~255; } tot[24] = b; }
        __syncthreads();
        if (wave == 0) { int run[NE];
#pragma unroll
            for (int e = 0; e < NE; ++e) run[e] = 0;
            for (int it = 0; it < RPW / 64; ++it) { const int m = bx * RPW + it * 64 + lane; const i32x4 rt = *(const i32x4*)(route + (size_t)m * 4);
                const unsigned long long lt = (1ull << lane) - 1ull;
#pragma unroll
                for (int e = 0; e < NE; ++e) { const bool has = (rt[0] == e) || (rt[1] == e); const unsigned long long mask = __ballot(has);
                    if (has) { const int pos = tot[16 + e] + tot[8 + e] + run[e] + __popcll(mask & lt); const int slot = (rt[1] == e) ? 1 : 0;
                        perm[pos] = m; rinfo[2 * pos] = m * 2 + slot; rinfo[2 * pos + 1] = slot ? rt[3] : rt[2]; }
                    run[e] += __popcll(mask); } } }
        if (bx < NE) { const int e = bx; const int beg = tot[16 + e] + tot[e], end = tot[16 + e] + ((tot[e] + 255) & ~255);
            for (int p = beg + tid; p < end; p += NTHR) { perm[p] = 0; rinfo[2 * p] = -1; rinfo[2 * p + 1] = 0; } }
        if (bx == 0) { if (tid == 0) meta[0] = tot[24] / 256; if (tid < NE) meta[1 + tid] = tot[16 + tid];
            for (int p = tid; p < tot[24] / 256; p += NTHR) { int e = 0;
#pragma unroll
                for (int k = 1; k < NE; ++k) if (p * 256 >= tot[16 + k]) e = k;
                meta[16 + p] = e; } }
        __syncthreads();
    }
    SEAM(15);

    if (IN(16)) for (int rep_ = 0; rep_ < NREP(16); ++rep_) {
        pg8::MoeOrder<true> S; S.init(ws + WS_X8, ws + W_EGU8, meta, 2 * EFF, D, G, bx, perm); pg8::EpiSwiGLU8 E{R + R_H, EFF};
        pg8::gemm_phase<pg8::EpiSwiGLU8, pg8::MoeOrder<true>, true, true>(lds, D, S, E); }
    SEAM(16);

    if (IN(17)) for (int rep_ = 0; rep_ < NREP(17); ++rep_) {
        pg8::MoeOrder<false> S; S.init(R + R_H, ws + W_EDN8, meta, D, EFF, G, bx, perm); pg8::EpiMoeDown E{rinfo, (bf16_t*)args.out};
        pg8::gemm_phase<pg8::EpiMoeDown, pg8::MoeOrder<false>, false, true>(lds, EFF, S, E); }
    SEAM(17);

    if (IN(18)) for (int rep_ = 0; rep_ < NREP(18); ++rep_) { const int lane = get_lane(), wave = get_wave(); const int gw = bx * NWAVES + wave; (void)gw; (void)lane;
        thin_resid<2, false>((const bf16_t*)args.out, (const bf16_t*)args.out + (size_t)M * D, XA, XB, nullptr, normg + 7 * D, bx * RPW + wave * (RPW / NWAVES), RPW / NWAVES, lane); }
    SEAM(18);

    if (IN(19)) for (int rep_ = 0; rep_ < NREP(19); ++rep_) { pg8::StaticOrder S; S.init(PB + (size_t)M * PLE, (const bf16_t*)(ws + W_PPROJ) + (size_t)D * PLE, M, D, PLE, G, bx); pg8::EpiPlain E{(bf16_t*)(R + R_PP1), D};
        pg8::gemm_phase<pg8::EpiPlain, pg8::StaticOrder, false>(lds, 2 * PLE, S, E); }
    SEAM(19);

    if (IN(20)) for (int rep_ = 0; rep_ < NREP(20); ++rep_) { pg8::StaticOrder S; S.init(XB, (const bf16_t*)(ws + W_PGATE) + (size_t)D * D, M, D, D, G, bx); pg8::EpiPleGate<true> E{XB, (const bf16_t*)(R + R_PP1), nullptr, nullptr, args.out};
        pg8::gemm_phase<pg8::EpiPleGate<true>, pg8::StaticOrder, false>(lds, 2 * D, S, E); }
#undef IN
#undef SEAM
}

constexpr int N_PHASES = 21;
extern "C" void kernel_launch(void* const* d_in, const int* in_sizes, int n_in, void* d_out, int out_size, void* d_ws, size_t ws_size, hipStream_t stream) {
    static int grid = 0;
    if (grid == 0) {
        if (n_in != 22 || in_sizes[0] != M * D || out_size != M * D || ws_size < WS_END) { fprintf(stderr, "kernel_launch: unexpected shapes (n_in %d, in0 %d, out %d, ws %zu < %zu); nothing launched\n", n_in, n_in > 0 ? in_sizes[0] : -1, out_size, ws_size, (size_t)WS_END); grid = -1; return; }
        int dev = 0, cus = 0, per_cu = 0;
        if (hipGetDevice(&dev) != hipSuccess || hipDeviceGetAttribute(&cus, hipDeviceAttributeMultiprocessorCount, dev) != hipSuccess) { grid = -1; return; }
        if (hipFuncSetAttribute((const void*)trunk_fwd, hipFuncAttributeMaxDynamicSharedMemorySize, LDS_BYTES) != hipSuccess) { fprintf(stderr, "kernel_launch: hipFuncSetAttribute failed\n"); grid = -1; return; }
        if (hipOccupancyMaxActiveBlocksPerMultiprocessor(&per_cu, (const void*)trunk_fwd, NTHR, LDS_BYTES) != hipSuccess || per_cu < 1) { fprintf(stderr, "kernel_launch: occupancy query reports %d workgroups per CU\n", per_cu); }
        (void)hipGetLastError();
        grid = cus;
        if (grid > 1024 || (M % (grid * NWAVES)) != 0 || ((M / grid) % 64) != 0) { fprintf(stderr, "kernel_launch: unsupported CU count %d\n", grid); grid = -1; return; }
    }
    if (grid < 0) return;
    if (hipMemsetAsync((char*)d_ws + WS_CTL, 0, CTL_ZERO_BYTES, stream) != hipSuccess) return;
    Args a{};
    for (int i = 0; i < 22; ++i) a.in[i] = (const float*)d_in[i];
    a.out = (float*)d_out; a.ws = (unsigned char*)d_ws; a.pad = 0;
    if (MK_N_LAUNCHES == 1) { a.ph_lo = 0; a.ph_hi = N_PHASES; a.li = 0; hipLaunchKernelGGL(trunk_fwd, dim3(grid), dim3(NTHR), LDS_BYTES, stream, a); }
    else for (int ph = 0; ph < N_PHASES; ++ph) { a.ph_lo = ph; a.ph_hi = ph + 1; a.li = ph; hipLaunchKernelGGL(trunk_fwd, dim3(grid), dim3(NTHR), LDS_BYTES, stream, a); }
}
```

```cpp
#include <hip/hip_runtime.h>
#include <cstdio>
#include <cstdint>

#ifndef MK_N_LAUNCHES
#define MK_N_LAUNCHES 1
#endif

#ifndef PROBE_REP
#define PROBE_REP 0u
#endif
#define NREP(k) (1 + (int)((PROBE_REP >> (k)) & 1u))
#define GAS __attribute__((address_space(1)))
#define LAS __attribute__((address_space(3)))
typedef unsigned short bf16_t;
typedef short bf16x8 __attribute__((ext_vector_type(8)));
typedef float f32x4 __attribute__((ext_vector_type(4)));
typedef float f32x2 __attribute__((ext_vector_type(2)));
typedef unsigned u32x4 __attribute__((ext_vector_type(4)));
typedef unsigned u32x2 __attribute__((ext_vector_type(2)));
typedef int i32x4 __attribute__((ext_vector_type(4)));
typedef int i32x8 __attribute__((ext_vector_type(8)));

constexpr int D = 1024, BATCH = 4, SEQ = 8192, M = BATCH * SEQ;
constexpr int PLE = 256, AB_IN = 2560, FF = 2816, CW = 1024, NE = 8, EFF = 3584;
constexpr float EPS = 1e-6f;
constexpr int NWAVES = 8, NTHR = 512;
constexpr int MAXP = 264;

__device__ __forceinline__ float bflo(unsigned w) { return __uint_as_float(w << 16); }
__device__ __forceinline__ float bfhi(unsigned w) { return __uint_as_float(w & 0xffff0000u); }
__device__ __forceinline__ float bf2f(bf16_t b) { return __uint_as_float((unsigned)b << 16); }
__device__ __forceinline__ unsigned cvt_pk_bf16(float lo, float hi) { unsigned r; asm volatile("v_cvt_pk_bf16_f32 %0, %1, %2" : "=v"(r) : "v"(lo), "v"(hi)); return r; }
__device__ __forceinline__ bf16_t f2bf(float f) { return (bf16_t)(cvt_pk_bf16(f, 0.f) & 0xffffu); }
__device__ __forceinline__ unsigned pk4_fp8(float a, float b, float c, float d) { int w = __builtin_amdgcn_cvt_pk_fp8_f32(a, b, 0, false); w = __builtin_amdgcn_cvt_pk_fp8_f32(c, d, w, true); return (unsigned)w; }
__device__ __forceinline__ u32x2 pack8_fp8(const float* v) { u32x2 w; w.x = pk4_fp8(v[0], v[1], v[2], v[3]); w.y = pk4_fp8(v[4], v[5], v[6], v[7]); return w; }
constexpr float SC_GU = 64.0f, SC_DN = 64.0f;
__device__ __forceinline__ float fsigmoid(float x) { return __builtin_amdgcn_rcpf(1.0f + __builtin_amdgcn_exp2f(-1.4426950408889634f * x)); }
__device__ __forceinline__ float fsilu(float x) { return x * fsigmoid(x); }
__device__ __forceinline__ float fgelu_tanh(float x) { const float u = x + 0.044715f * x * x * x; return x * __builtin_amdgcn_rcpf(1.0f + __builtin_amdgcn_exp2f(-2.3022082f * u)); }
__device__ __forceinline__ int get_lane() { int t; asm volatile("v_and_b32 %0, 63, %1" : "=v"(t) : "v"(threadIdx.x)); return t; }
__device__ __forceinline__ int get_wave() { int t; asm volatile("v_lshrrev_b32 %0, 6, %1" : "=v"(t) : "v"(threadIdx.x)); return __builtin_amdgcn_readfirstlane(t); }
__device__ __forceinline__ float wave_sum(float v) {
#pragma unroll
    for (int o = 1; o < 64; o <<= 1) v += __shfl_xor(v, o);
    return v;
}
__device__ __forceinline__ void unpack8(const u32x4 a, float* v) { v[0] = bflo(a.x); v[1] = bfhi(a.x); v[2] = bflo(a.y); v[3] = bfhi(a.y); v[4] = bflo(a.z); v[5] = bfhi(a.z); v[6] = bflo(a.w); v[7] = bfhi(a.w); }
__device__ __forceinline__ u32x4 pack8(const float* v) { u32x4 w; w.x = cvt_pk_bf16(v[0], v[1]); w.y = cvt_pk_bf16(v[2], v[3]); w.z = cvt_pk_bf16(v[4], v[5]); w.w = cvt_pk_bf16(v[6], v[7]); return w; }

namespace pg8 {
constexpr int BM = 256, BK = 64, HALF = 128, HTB = HALF * BK * 2, STAGE_BYTES = 8 * HTB, NXCD = 8, WGM = 8;
__host__ __device__ __forceinline__ int lds_byte(int r, int c) { const int st = (r >> 4) * 2 + (c >> 5), rr = r & 15, cc = c & 31, ob = rr * 64 + cc * 2; return st * 1024 + (ob ^ (((ob >> 9) & 1) << 5)); }
__host__ __device__ __forceinline__ void stage_rc(int b, int& R, int& C) { const int st = b / 1024, sb = b % 1024, swz = sb ^ (((sb >> 9) & 1) << 5); R = (st >> 1) * 16 + swz / 64; C = (st & 1) * 32 + (swz % 64) / 2; }
__host__ __device__ __forceinline__ int perm32(int rho) { const int n = rho >> 4, i = rho & 15; return 8 * (i >> 2) + 4 * n + (i & 3); }

struct Unit { int pm, pn; const char* a; const char* b; };
__device__ __forceinline__ const char* uni(const char* p) { const unsigned long long v = (unsigned long long)p; const unsigned lo = __builtin_amdgcn_readfirstlane((unsigned)v), hi = __builtin_amdgcn_readfirstlane((unsigned)(v >> 32)); return (const char*)(((unsigned long long)hi << 32) | lo); }

__device__ __forceinline__ bool tile_of(int i, int G, int c, int nM, int nN, int& pm, int& pn) {
    const int nwg = nM * nN; const int L = i * G + c; if (L >= nwg) return false;
    int wgid = L; { const int q = nwg / NXCD, r = nwg % NXCD, xcd = wgid % NXCD, off = wgid / NXCD; wgid = (xcd < r ? xcd * (q + 1) : r * (q + 1) + (xcd - r) * q) + off; }
    const int nig = WGM * nN, gid = wgid / nig, fm = gid * WGM, gsz = (nM - fm) < WGM ? (nM - fm) : WGM;
    pm = fm + ((wgid % nig) % gsz); pn = (wgid % nig) / gsz; return true;
}
struct StaticOrder {
    int nM, nN, G, c; const char* A; const char* Bt; size_t tstep;
    __device__ __forceinline__ void init(const bf16_t* A_, const bf16_t* Bt_, int M_, int N_, int K_, int G_, int c_) { nM = M_ / BM; nN = N_ / BM; G = G_; c = c_; A = (const char*)A_; Bt = (const char*)Bt_; tstep = (size_t)BM * K_ * 2; }
    __device__ __forceinline__ const int* perm_of(const Unit&) const { return nullptr; }
    __device__ __forceinline__ bool next(int i, Unit& u) const { if (!tile_of(i, G, c, nM, nN, u.pm, u.pn)) return false; u.pm = __builtin_amdgcn_readfirstlane(u.pm); u.pn = __builtin_amdgcn_readfirstlane(u.pn); u.a = uni(A + (size_t)u.pm * tstep); u.b = uni(Bt + (size_t)u.pn * tstep); return true; }
    __device__ __forceinline__ int gather_tok(const Unit&, int) const { return 0; }
};
template <bool GATHER> struct MoeOrder {
    int nM, nN, G, c; const char* A; const char* Bt; size_t tstep, estride; int pb[7]; const int* perm;
    __device__ __forceinline__ void init(const void* A_, const void* Bt_, const int* meta, int N_, int rowB, int G_, int c_, const int* perm_) {
        nM = __builtin_amdgcn_readfirstlane(meta[0]); nN = N_ / BM; G = G_; c = c_; A = (const char*)A_; Bt = (const char*)Bt_; tstep = (size_t)BM * rowB; estride = (size_t)N_ * rowB; perm = perm_;
#pragma unroll
        for (int k = 0; k < 7; ++k) pb[k] = __builtin_amdgcn_readfirstlane(meta[2 + k]); }
    __device__ __forceinline__ bool next(int i, Unit& u) const { if (!tile_of(i, G, c, nM, nN, u.pm, u.pn)) return false;
        u.pm = __builtin_amdgcn_readfirstlane(u.pm); u.pn = __builtin_amdgcn_readfirstlane(u.pn); int e = 0;
#pragma unroll
        for (int k = 0; k < 7; ++k) e += (u.pm * BM >= pb[k]) ? 1 : 0;
        u.a = uni(GATHER ? A : A + (size_t)u.pm * tstep); u.b = uni(Bt + (size_t)e * estride + (size_t)u.pn * tstep); return true; }
    __device__ __forceinline__ int gather_tok(const Unit& u, int r) const { return perm[u.pm * BM + r]; }
    __device__ __forceinline__ const int* perm_of(const Unit& u) const { return perm + u.pm * BM; }
};

constexpr int PERMBUF_OFF = 131072 + 4096;
template <class Epi, class Sched, bool GATHER, bool FP8 = false>
__device__ __forceinline__ void gemm_phase(LAS unsigned char* lds, const int rowB, const Sched& S, const Epi& E) {
    const int tid = threadIdx.x, wid = __builtin_amdgcn_readfirstlane(tid >> 6), lane = tid & 63, wr = wid >> 2, wc = wid & 3, fr = lane & 15, fq = lane >> 4;
    const int nt = rowB / 128;
    const size_t kstep = (size_t)128;
    const size_t hstep = (size_t)HALF * rowB;
    const int fp8_one = 0x7F7F7F7F;
    unsigned voffB[2]; int sR[2], sC[2];
#pragma unroll
    for (int i = 0; i < 2; ++i) { int R, C; stage_rc(tid * 16 + i * 8192, R, C); const int Rb = (R & ~31) + perm32(R & 31); sR[i] = R; sC[i] = 2 * C; voffB[i] = (unsigned)(Rb * rowB + 2 * C); }
    const unsigned lbase = (unsigned)__builtin_amdgcn_readfirstlane((int)((unsigned)(size_t)lds + (unsigned)wid * 1024u));
    const int aoff = lds_byte(wr * 64 + fr, fq * 8), boff = lds_byte(wc * 32 + fr, fq * 8);
#define PG8_SA(b, h) (((b) * 2 + (h)) * HTB)
#define PG8_SB(b, h) ((4 + (b) * 2 + (h)) * HTB)
#define PG8_GLDS(ldsdst, voff, sbase) asm volatile("s_mov_b32 m0, %0\n\tglobal_load_lds_dwordx4 %1, %2" :: "s"(ldsdst), "v"(voff), "s"(sbase) : "memory", "m0")
#define PG8_STAGE_B(bufoff, gbase) do { _Pragma("unroll") for (int _i = 0; _i < 2; ++_i) PG8_GLDS(lbase + (unsigned)((bufoff) + _i * 8192), voffB[_i], (const char*)(gbase)); } while (0)
#define PG8_STAGE_A(bufoff, gbase, off, h) do { _Pragma("unroll") for (int _i = 0; _i < 2; ++_i) PG8_GLDS(lbase + (unsigned)((bufoff) + _i * 8192), (off)[GATHER ? (h) : 0][_i], GATHER ? (const char*)(gbase) : (const char*)(gbase) + (h) * hstep); } while (0)
#define PG8_LDA(dst, b, h) do { _Pragma("unroll") for (int m = 0; m < 4; ++m) _Pragma("unroll") for (int k = 0; k < 2; ++k) dst[m][k] = *(const LAS bf16x8*)(lds + PG8_SA(b, h) + aoff + m * 2048 + k * 1024); } while (0)
#define PG8_LDB(dst, b, h) do { _Pragma("unroll") for (int n = 0; n < 2; ++n) _Pragma("unroll") for (int k = 0; k < 2; ++k) dst[n][k] = *(const LAS bf16x8*)(lds + PG8_SB(b, h) + boff + n * 2048 + k * 1024); } while (0)
#define PG8_CAT(x, y) __builtin_shufflevector(__builtin_bit_cast(i32x4, (x)), __builtin_bit_cast(i32x4, (y)), 0, 1, 2, 3, 4, 5, 6, 7)
#define PG8_MMA(ai, bj, At, Bt) do { __builtin_amdgcn_s_setprio(1); _Pragma("unroll") for (int m = 0; m < 4; ++m) _Pragma("unroll") for (int n = 0; n < 2; ++n) { \
        if constexpr (FP8) acc[ai][bj][m][n] = __builtin_amdgcn_mfma_scale_f32_16x16x128_f8f6f4(PG8_CAT(Bt[n][0], Bt[n][1]), PG8_CAT(At[m][0], At[m][1]), acc[ai][bj][m][n], 0, 0, 0, fp8_one, 0, fp8_one); \
        else { _Pragma("unroll") for (int k = 0; k < 2; ++k) acc[ai][bj][m][n] = __builtin_amdgcn_mfma_f32_16x16x32_bf16(Bt[n][k], At[m][k], acc[ai][bj][m][n], 0, 0, 0); } } \
        __builtin_amdgcn_s_setprio(0); } while (0)
#define PG8_WAIT_V(n) asm volatile("s_waitcnt vmcnt(" #n ")" ::: "memory")
#define PG8_WAIT_L(n) asm volatile("s_waitcnt lgkmcnt(" #n ")" ::: "memory")
#define PG8_BAR __builtin_amdgcn_s_barrier()
#define PG8_SCHED __builtin_amdgcn_sched_barrier(0)
    Unit cur, nxt; int ui = 0;
    if (!S.next(0, cur)) return;
    unsigned coff[2][2];
#pragma unroll
    for (int h = 0; h < 2; ++h)
#pragma unroll
        for (int i = 0; i < 2; ++i) {
            if constexpr (GATHER) coff[h][i] = (unsigned)(S.gather_tok(cur, h * HALF + sR[i]) * rowB + sC[i]);
            else coff[h][i] = (unsigned)(sR[i] * rowB + sC[i]);
        }
    f32x4 acc[2][2][4][2];
#pragma unroll
    for (int a = 0; a < 2; ++a)
#pragma unroll
        for (int b = 0; b < 2; ++b)
#pragma unroll
            for (int m = 0; m < 4; ++m)
#pragma unroll
                for (int n = 0; n < 2; ++n) acc[a][b][m][n] = (f32x4){0.f, 0.f, 0.f, 0.f};
    bf16x8 At[4][2], B0[2][2], B1[2][2];
    const char* cA = cur.a; const char* cB = cur.b;
    PG8_STAGE_B(PG8_SB(0, 0), cB); PG8_STAGE_B(PG8_SB(0, 1), cB + hstep); PG8_STAGE_A(PG8_SA(0, 0), cA, coff, 0); PG8_STAGE_A(PG8_SA(0, 1), cA, coff, 1);
    if (wr == 1) PG8_BAR;
    PG8_WAIT_V(2); PG8_BAR;
    PG8_STAGE_B(PG8_SB(1, 0), cB + kstep); PG8_STAGE_A(PG8_SA(1, 0), cA + kstep, coff, 0); PG8_STAGE_B(PG8_SB(1, 1), cB + hstep + kstep);
    PG8_WAIT_V(6); PG8_BAR;
    for (;;) {
        const bool has_next = S.next(ui + 1, nxt);
        const char* nA = has_next ? nxt.a : cA; const char* nB = has_next ? nxt.b : cB;
        if constexpr (GATHER) {
            if (has_next) asm volatile("s_mov_b32 m0, %0\n\tglobal_load_lds_dword %1, %2" :: "s"((unsigned)__builtin_amdgcn_readfirstlane((int)((unsigned)(size_t)lds + (unsigned)(PERMBUF_OFF + wr * 1024 + (wid & 3) * 256)))), "v"((unsigned)(lane * 4)), "s"(uni((const char*)(S.perm_of(nxt) + (wid & 3) * 64))) : "memory", "m0");
        }
        for (int t = 0; t < nt; t += 2) {
            const bool last = (t == nt - 2);
            const char* a1 = cA + (size_t)(t + 1) * kstep;
            const char* a2 = last ? nA : cA + (size_t)(t + 2) * kstep; const char* b2 = last ? nB : cB + (size_t)(t + 2) * kstep;
            const char* a3 = a2 + kstep; const char* b3 = b2 + kstep;
            PG8_LDB(B0, 0, 0); PG8_LDB(B1, 0, 1); PG8_SCHED; PG8_LDA(At, 0, 0); PG8_STAGE_A(PG8_SA(1, 1), a1, coff, 1);
            if constexpr (GATHER) { if (last && has_next) {
                int t_ = tid; asm volatile("" : "+v"(t_));
#pragma unroll
                for (int i = 0; i < 2; ++i) { int R_, C_; stage_rc(t_ * 16 + i * 8192, R_, C_);
#pragma unroll
                    for (int h = 0; h < 2; ++h) { int tok; asm volatile("ds_read_b32 %0, %1" : "=v"(tok) : "v"((unsigned)(size_t)lds + (unsigned)(PERMBUF_OFF + wr * 1024 + (h * HALF + R_) * 4)) : "memory");
                        asm volatile("s_waitcnt lgkmcnt(0)" : "+v"(tok) :: "memory"); coff[h][i] = (unsigned)(tok * rowB + 2 * C_); } } } }
            PG8_WAIT_V(8); PG8_WAIT_L(0); PG8_BAR; PG8_MMA(0, 0, At, B0); PG8_MMA(0, 1, At, B1); PG8_BAR; PG8_SCHED;
            PG8_LDA(At, 0, 1); PG8_STAGE_B(PG8_SB(0, 0), b2); PG8_STAGE_B(PG8_SB(0, 1), b2 + hstep); PG8_STAGE_A(PG8_SA(0, 0), a2, coff, 0);
            PG8_WAIT_V(8); PG8_WAIT_L(0); PG8_BAR; PG8_MMA(1, 0, At, B0); PG8_MMA(1, 1, At, B1); PG8_BAR; PG8_SCHED;
            PG8_LDB(B0, 1, 0); PG8_LDB(B1, 1, 1); PG8_SCHED; PG8_LDA(At, 1, 0); PG8_STAGE_A(PG8_SA(0, 1), a2, coff, 1);
            PG8_WAIT_V(8); PG8_WAIT_L(0); PG8_BAR; PG8_MMA(0, 0, At, B0); PG8_MMA(0, 1, At, B1); PG8_BAR; PG8_SCHED;
            PG8_LDA(At, 1, 1); PG8_STAGE_B(PG8_SB(1, 0), b3); PG8_STAGE_B(PG8_SB(1, 1), b3 + hstep); PG8_STAGE_A(PG8_SA(1, 0), a3, coff, 0);
            PG8_WAIT_V(8); PG8_WAIT_L(0); PG8_BAR; PG8_MMA(1, 0, At, B0); PG8_MMA(1, 1, At, B1); PG8_BAR; PG8_SCHED;
        }
        if (wr == 0) PG8_BAR;
        { const int l2 = get_lane(); E(acc, cur, wr, wc, l2 & 15, l2 >> 4); }
        if (!has_next) break;
#pragma unroll
        for (int a = 0; a < 2; ++a)
#pragma unroll
            for (int b = 0; b < 2; ++b)
#pragma unroll
                for (int m = 0; m < 4; ++m)
#pragma unroll
                    for (int n = 0; n < 2; ++n) acc[a][b][m][n] = (f32x4){0.f, 0.f, 0.f, 0.f};
        cur = nxt; cA = nA; cB = nB; ++ui;
        if (wr == 1) PG8_BAR;
    }
    PG8_WAIT_V(0);
    PG8_BAR;
#undef PG8_SA
#undef PG8_SB
#undef PG8_STAGE_A
#undef PG8_STAGE_B
#undef PG8_LDA
#undef PG8_LDB
#undef PG8_MMA
#undef PG8_WAIT_V
#undef PG8_WAIT_L
#undef PG8_BAR
#undef PG8_SCHED
}

typedef f32x4 AccT[2][2][4][2];
#define EPI_ROWS_BEGIN const int row0 = u.pm * BM + wr * 64 + fr; const int colw = wc * 32 + 8 * fq; \
    _Pragma("unroll") for (int ai = 0; ai < 2; ++ai) _Pragma("unroll") for (int m = 0; m < 4; ++m) { const int r = row0 + ai * HALF + m * 16;
#define EPI_ROWS_END }

struct EpiInAB {
    bf16_t* Z; const float* rstd;
    __device__ __forceinline__ void operator()(const AccT& acc, const Unit& u, int wr, int wc, int fr, int fq) const {
        const bool act = u.pn < 4;
        EPI_ROWS_BEGIN
            const float rs = rstd[r]; bf16_t* rowp = Z + (size_t)r * AB_IN + u.pn * BM + colw;
#pragma unroll
            for (int bj = 0; bj < 2; ++bj) { float v[8];
#pragma unroll
                for (int j = 0; j < 4; ++j) { v[j] = acc[ai][bj][m][0][j] * rs; v[4 + j] = acc[ai][bj][m][1][j] * rs; }
                if (act) {
#pragma unroll
                    for (int j = 0; j < 8; ++j) v[j] = fgelu_tanh(v[j]); }
                *(u32x4*)(rowp + bj * HALF) = pack8(v); }
        EPI_ROWS_END
    }
};
struct EpiPlain {
    bf16_t* O; int ldc;
    __device__ __forceinline__ void operator()(const AccT& acc, const Unit& u, int wr, int wc, int fr, int fq) const {
        EPI_ROWS_BEGIN
            bf16_t* rowp = O + (size_t)r * ldc + u.pn * BM + colw;
#pragma unroll
            for (int bj = 0; bj < 2; ++bj) { float v[8];
#pragma unroll
                for (int j = 0; j < 4; ++j) { v[j] = acc[ai][bj][m][0][j]; v[4 + j] = acc[ai][bj][m][1][j]; }
                *(u32x4*)(rowp + bj * HALF) = pack8(v); }
        EPI_ROWS_END
    }
};
template <bool MOE> struct EpiSwiGLU {
    bf16_t* H; int ldh; const float* rstd; const int* perm;
    __device__ __forceinline__ void operator()(const AccT& acc, const Unit& u, int wr, int wc, int fr, int fq) const {
        EPI_ROWS_BEGIN
            const int tok = MOE ? perm[r] : r; const float rs = rstd[tok];
            float v[8];
#pragma unroll
            for (int n = 0; n < 2; ++n)
#pragma unroll
                for (int j = 0; j < 4; ++j) { const float g = acc[ai][0][m][n][j] * rs, up = acc[ai][1][m][n][j] * rs; v[4 * n + j] = fsilu(g) * up; }
            *(u32x4*)(H + (size_t)r * ldh + u.pn * HALF + colw) = pack8(v);
        EPI_ROWS_END
    }
};
struct EpiSwiGLU8 {
    unsigned char* H; int ldh;
    __device__ __forceinline__ void operator()(const AccT& acc, const Unit& u, int wr, int wc, int fr, int fq) const {
        EPI_ROWS_BEGIN
            float v[8];
#pragma unroll
            for (int n = 0; n < 2; ++n)
#pragma unroll
                for (int j = 0; j < 4; ++j) { const float g = acc[ai][0][m][n][j] * (1.0f / SC_GU), up = acc[ai][1][m][n][j] * (1.0f / SC_GU); v[4 * n + j] = fsilu(g) * up; }
            *(u32x2*)(H + (size_t)r * ldh + u.pn * HALF + colw) = pack8_fp8(v);
        EPI_ROWS_END
    }
};
struct EpiInC {
    bf16_t* QFIG; const float* ssp;
    __device__ __forceinline__ void operator()(const AccT& acc, const Unit& u, int wr, int wc, int fr, int fq) const {
        const int type = u.pn >> 2; const int colt = (u.pn & 3) * BM + wc * 32 + 8 * fq;
        bf16_t* base = QFIG + (size_t)type * M * CW;
        EPI_ROWS_BEGIN
            const f32x4 s0 = *(const f32x4*)(ssp + (size_t)r * 4);
            const float rs = __builtin_amdgcn_rsqf(((s0[0] + s0[1]) + (s0[2] + s0[3])) * (1.0f / D) + EPS);
#pragma unroll
            for (int bj = 0; bj < 2; ++bj) { float v[8];
#pragma unroll
                for (int j = 0; j < 4; ++j) { v[j] = acc[ai][bj][m][0][j] * rs; v[4 + j] = acc[ai][bj][m][1][j] * rs; }
                *(u32x4*)(base + (size_t)r * CW + colt + bj * HALF) = pack8(v); }
        EPI_ROWS_END
    }
};
template <bool FINAL> struct EpiPleGate {
    const bf16_t* X; const bf16_t* PP; bf16_t* XO; float* ssp; float* OUT; LAS float* T;
    __device__ __forceinline__ void operator()(const AccT& acc, const Unit& u, int wr, int wc, int fr, int fq) const {
        EPI_ROWS_BEGIN
            const size_t off = (size_t)r * D + u.pn * BM + colw; float ssq = 0.f;
#pragma unroll
            for (int bj = 0; bj < 2; ++bj) { float x[8], p[8];
                unpack8(*(const u32x4*)(X + off + bj * HALF), x); unpack8(*(const u32x4*)(PP + off + bj * HALF), p);
#pragma unroll
                for (int j = 0; j < 8; ++j) { const float a = j < 4 ? acc[ai][bj][m][0][j] : acc[ai][bj][m][1][j - 4]; x[j] = x[j] + fsigmoid(a) * p[j]; ssq += x[j] * x[j]; }
                if (FINAL) { *(f32x4*)(OUT + off + bj * HALF) = (f32x4){x[0], x[1], x[2], x[3]}; *(f32x4*)(OUT + off + bj * HALF + 4) = (f32x4){x[4], x[5], x[6], x[7]}; }
                else *(u32x4*)(XO + off + bj * HALF) = pack8(x); }
            if (!FINAL) { ssq += __shfl_xor(ssq, 16); ssq += __shfl_xor(ssq, 32); if (fq == 0) T[(r - u.pm * BM) * 4 + wc] = ssq; }
        EPI_ROWS_END
        if (!FINAL) {
            asm volatile("s_waitcnt lgkmcnt(0)" ::: "memory"); __builtin_amdgcn_s_barrier(); asm volatile("" ::: "memory");
            if (threadIdx.x < 256) { const f32x4 t = *(const LAS f32x4*)(T + threadIdx.x * 4); ssp[(size_t)(u.pm * BM + threadIdx.x) * 4 + u.pn] = (t[0] + t[1]) + (t[2] + t[3]); }
        }
    }
};
struct EpiMoeDown {
    const int* rowinfo; bf16_t* slots;
    __device__ __forceinline__ void operator()(const AccT& acc, const Unit& u, int wr, int wc, int fr, int fq) const {
        EPI_ROWS_BEGIN
            const int info = rowinfo[2 * r]; const float w = __int_as_float(rowinfo[2 * r + 1]) * (1.0f / SC_DN);
            if (info >= 0) { bf16_t* rowp = slots + (size_t)(info & 1) * M * D + (size_t)(info >> 1) * D + u.pn * BM + colw;
#pragma unroll
                for (int bj = 0; bj < 2; ++bj) { float v[8];
#pragma unroll
                    for (int j = 0; j < 4; ++j) { v[j] = acc[ai][bj][m][0][j] * w; v[4 + j] = acc[ai][bj][m][1][j] * w; }
                    *(u32x4*)(rowp + bj * HALF) = pack8(v); } }
        EPI_ROWS_END
    }
};
}

constexpr size_t MiB = 1u << 20;
constexpr size_t WS_CTL = 0, CTL_ZERO_BYTES = 1 * MiB;
constexpr size_t WS_SMALL = 1 * MiB;
constexpr size_t SM_RSTD0 = WS_SMALL, SM_RSTD1 = SM_RSTD0 + 128 * 1024, SM_RSTD4 = SM_RSTD1 + 128 * 1024;
constexpr size_t SM_LB = SM_RSTD4 + 128 * 1024;
constexpr size_t SM_ROUTE = SM_LB + 4096;
constexpr size_t SM_CNT = SM_ROUTE + 512 * 1024;
constexpr size_t SM_META = SM_CNT + 32 * 1024;
constexpr size_t SM_PERM = SM_META + 4096;
constexpr size_t SM_RINFO = SM_PERM + 512 * 1024;
constexpr size_t SM_SSP = SM_RINFO + 1024 * 1024;
constexpr size_t SM_DLOG = SM_SSP + 2 * MiB;
constexpr size_t SM_W16 = SM_DLOG + 128 * 1024;
static_assert(SM_W16 + 256 * 1024 <= 9 * MiB, "small arrays");
constexpr size_t WS_W = 9 * MiB;
constexpr size_t W_INAB = WS_W, W_OUTAB = W_INAB + 5 * MiB, W_GU0 = W_OUTAB + 2 * MiB, W_DN0 = W_GU0 + 11 * MiB, W_INC = W_DN0 + 5 * MiB + 512 * 1024,
                 W_OUTC = W_INC + 8 * MiB, W_EGU8 = W_OUTC + 2 * MiB, W_EDN8 = W_EGU8 + 56 * MiB, W_PPROJ = W_EDN8 + 28 * MiB, W_PGATE = W_PPROJ + 1 * MiB, W_END = W_PGATE + 4 * MiB;
constexpr size_t WS_PB = W_END;
constexpr size_t WS_XA = WS_PB + 32 * MiB, WS_XB = WS_XA + 64 * MiB;
constexpr size_t WS_X8 = WS_XB + 64 * MiB;
constexpr size_t WS_R = WS_X8 + 32 * MiB;
constexpr size_t R_BYTES = (size_t)MAXP * 256 * EFF * 2;
constexpr size_t WS_END = WS_R + R_BYTES;
constexpr size_t R_Z = 0, R_Y = 160 * MiB, R_MIX = 224 * MiB, R_PP = 288 * MiB, R_HF = 0;
constexpr size_t R_QFIG = 0, R_O = 256 * MiB, R_OG = 384 * MiB, R_MIX1 = 0, R_H = 0, R_PP1 = 0;

constexpr int CW_BAR = 4096;

constexpr int RING_BYTES = 131072;
constexpr int LDSCTL_OFF = RING_BYTES, MISC_OFF = LDSCTL_OFF + 320;
constexpr int LDS_BYTES = 147456;

#define XB_TMO      128
#define XB_XCNT(j)  (256  + 64 * (j))
#define XB_XSUB(j)  (1280 + 64 * (j))
#define XB_XGEN(j)  (2304 + 64 * (j))
#define XB_TOP      3328
#define XB_TOPGEN   3392
#define XCD_BAR_WORDS 3456
#define XB_SPIN_CAP (1u << 18)
__device__ __forceinline__ unsigned xb_ld(unsigned* p)              { return __hip_atomic_load(p, __ATOMIC_RELAXED, __HIP_MEMORY_SCOPE_AGENT); }
__device__ __forceinline__ unsigned xb_add(unsigned* p, unsigned v) { return __hip_atomic_fetch_add(p, v, __ATOMIC_RELAXED, __HIP_MEMORY_SCOPE_AGENT); }
__device__ __forceinline__ unsigned xb_xcc_id() { return (unsigned)__builtin_amdgcn_s_getreg((3 << 11) | 20) & 0xFu; }
#define XB_SPIN(cond, bar) do { unsigned _sp = 0; while (cond) { __builtin_amdgcn_s_sleep(1); \
    if ((++_sp & 255u) == 0u) { if (xb_ld(&(bar)[XB_TMO])) break; if (_sp > XB_SPIN_CAP) { atomicAdd(&(bar)[XB_TMO], 1u); break; } } } } while (0)
struct XcdBarrier { unsigned* bar; unsigned x; volatile LAS unsigned* st; };
__device__ __forceinline__ XcdBarrier xcd_barrier_post(unsigned* bar, volatile LAS unsigned* st) {
    XcdBarrier b; b.bar = bar; b.x = xb_xcc_id(); b.st = st;
    if (threadIdx.x == 0) (void)xb_add(&bar[XB_XCNT(b.x)], 1u);
    return b;
}
__device__ __forceinline__ void xcd_barrier_complete(unsigned* bar, unsigned x, unsigned& nloc, unsigned& nx) {
    const unsigned G = gridDim.x * gridDim.y * gridDim.z;
    unsigned sum, cnt, mine, sp = 0u;
    for (;;) {
        sum = 0u; cnt = 0u; mine = 0u;
#pragma unroll
        for (unsigned j = 0; j < 16; ++j) { const unsigned c = xb_ld(&bar[XB_XCNT(j)]); sum += c; cnt += (c > 0u) ? 1u : 0u; mine = (j == x) ? c : mine; }
        if (sum == G) break;
        __builtin_amdgcn_s_sleep(1);
        if ((++sp & 255u) == 0u) { if (xb_ld(&bar[XB_TMO])) break; if (sp > XB_SPIN_CAP) { atomicAdd(&bar[XB_TMO], 1u); break; } }
    }
    nloc = mine > 0u ? mine : 1u; nx = cnt > 0u ? cnt : 1u;
}
__device__ __forceinline__ void xcd_barrier(const XcdBarrier& b) {
    asm volatile("s_waitcnt vmcnt(0)" ::: "memory");
    __syncthreads();
    if (threadIdx.x == 0) {
        unsigned* bar = b.bar;
        __builtin_amdgcn_s_waitcnt(0);
        unsigned nloc = b.st[0], nx = b.st[1];
        if (nloc == 0u) { xcd_barrier_complete(bar, b.x, nloc, nx); b.st[0] = nloc; b.st[1] = nx; }
        const unsigned old = xb_add(&bar[XB_XSUB(b.x)], 1u);
        const unsigned gen = old / nloc;
        if (old + 1u == (gen + 1u) * nloc) {
            __builtin_amdgcn_fence(__ATOMIC_RELEASE, "agent");
            asm volatile("s_waitcnt vmcnt(0)" ::: "memory");
            const unsigned og = xb_add(&bar[XB_TOP], 1u);
            const unsigned tg = og / nx;
            if (og + 1u == (tg + 1u) * nx) xb_add(&bar[XB_TOPGEN], 1u);
            else XB_SPIN(xb_ld(&bar[XB_TOPGEN]) == tg, bar);
            __builtin_amdgcn_fence(__ATOMIC_ACQUIRE, "agent");
            xb_add(&bar[XB_XGEN(b.x)], 1u);
            asm volatile("s_waitcnt vmcnt(0)" ::: "memory");
        } else {
            XB_SPIN(xb_ld(&bar[XB_XGEN(b.x)]) == gen, bar);
            __builtin_amdgcn_fence(__ATOMIC_ACQUIRE, "agent");
            asm volatile("s_waitcnt vmcnt(0)" ::: "memory");
        }
    }
    __syncthreads();
}


namespace hg {
constexpr int QS_OFF = 0, QS_RS = 272, KS_OFF = 17408, KS_RS = 288, IS_OFF = 35840, IS_RS = 288, PS_OFF = 54272, PS_RS = 144,
              TOT_OFF = 63488, RSC_OFF = 67584, DSC_OFF = 68096, RED_OFF = 68608;
typedef short s16x4 __attribute__((ext_vector_type(4)));
#define HG_MFMA(a, b, c) __builtin_amdgcn_mfma_f32_16x16x32_bf16((a), (b), (c), 0, 0, 0)
__device__ __forceinline__ bf16x8 rowfrag(const LAS unsigned char* img, int rs, int row, int step, int g) {
    const LAS s16x4* p = (const LAS s16x4*)(img + row * rs + (32 * step + 4 * g) * 2); const s16x4 lo = p[0], hi = p[4];
    return __builtin_shufflevector(lo, hi, 0, 1, 2, 3, 4, 5, 6, 7);
}
__device__ __forceinline__ bf16x8 trfrag(unsigned img_addr, int rs, int sb, int cb, int c, int g) {
    const unsigned a0 = img_addr + (unsigned)((32 * sb + 4 * g + (c >> 2)) * rs + 32 * cb + 8 * (c & 3)), a1 = a0 + (unsigned)(16 * rs);
    s16x4 lo, hi;
    asm volatile("ds_read_b64_tr_b16 %0, %2\n\tds_read_b64_tr_b16 %1, %3\n\ts_waitcnt lgkmcnt(0)" : "=&v"(lo), "=&v"(hi) : "v"(a0), "v"(a1) : "memory");
    return __builtin_shufflevector(lo, hi, 0, 1, 2, 3, 4, 5, 6, 7);
}
#define HG_TR8(d, a, O0, O1, O2, O3, O4, O5, O6, O7) asm volatile( \
    "ds_read_b64_tr_b16 %0, %8 offset:" #O0 "\n\tds_read_b64_tr_b16 %1, %8 offset:" #O1 "\n\tds_read_b64_tr_b16 %2, %8 offset:" #O2 "\n\tds_read_b64_tr_b16 %3, %8 offset:" #O3 "\n\t" \
    "ds_read_b64_tr_b16 %4, %8 offset:" #O4 "\n\tds_read_b64_tr_b16 %5, %8 offset:" #O5 "\n\tds_read_b64_tr_b16 %6, %8 offset:" #O6 "\n\tds_read_b64_tr_b16 %7, %8 offset:" #O7 "\n\ts_waitcnt lgkmcnt(0)" \
    : "=&v"(d[0]), "=&v"(d[1]), "=&v"(d[2]), "=&v"(d[3]), "=&v"(d[4]), "=&v"(d[5]), "=&v"(d[6]), "=&v"(d[7]) : "v"(a) : "memory")
#define HG_TR4(d, a, O0, O1, O2, O3) asm volatile( \
    "ds_read_b64_tr_b16 %0, %4 offset:" #O0 "\n\tds_read_b64_tr_b16 %1, %4 offset:" #O1 "\n\tds_read_b64_tr_b16 %2, %4 offset:" #O2 "\n\tds_read_b64_tr_b16 %3, %4 offset:" #O3 "\n\ts_waitcnt lgkmcnt(0)" \
    : "=&v"(d[0]), "=&v"(d[1]), "=&v"(d[2]), "=&v"(d[3]) : "v"(a) : "memory")
#define HG_CAT(lo, hi) __builtin_shufflevector((lo), (hi), 0, 1, 2, 3, 4, 5, 6, 7)
__device__ __forceinline__ bf16x8 pack_acc(const f32x4 a, const f32x4 b) {
    u32x4 p; p.x = cvt_pk_bf16(a[0], a[1]); p.y = cvt_pk_bf16(a[2], a[3]); p.z = cvt_pk_bf16(b[0], b[1]); p.w = cvt_pk_bf16(b[2], b[3]);
    return __builtin_bit_cast(bf16x8, p);
}
template <int PASS>
__device__ __forceinline__ void run(LAS unsigned char* lds, const bf16_t* Qb, const bf16_t* Fb, const bf16_t* Ib, const bf16_t* Gb,
                                    const float* onormg, const float* LBv, float* Useg, float* Dlog, bf16_t* OG, int item) {
    const int tid = threadIdx.x, lane = tid & 63, w = __builtin_amdgcn_readfirstlane(tid >> 6), c = lane & 15, g = lane >> 4;
    const int b = item >> 6, h = (item >> 3) & 7, seg = item & 7;
    const size_t row0 = (size_t)b * SEQ + (size_t)seg * 1024;
    const int colh = h * 128;
    const int kp = lane, tg = w;
    const int isr = tid >> 3, ipc = tid & 7;
    const unsigned lds_addr = (unsigned)(size_t)lds;
    f32x4 S[8];
#pragma unroll
    for (int kt = 0; kt < 8; ++kt) S[kt] = (f32x4){0.f, 0.f, 0.f, 0.f};
    if (PASS == 2) {
        for (int j = 0; j < seg; ++j) { const int it = item - seg + j;
#pragma unroll
            for (int kt = 0; kt < 8; ++kt) { const f32x4 dl = *(const f32x4*)(Dlog + (size_t)it * 128 + 16 * kt + 4 * g);
                const f32x4 uu = *((const f32x4*)Useg + ((size_t)(it * 8 + w) * 8 + kt) * 64 + lane);
#pragma unroll
                for (int r = 0; r < 4; ++r) S[kt][r] = __builtin_amdgcn_exp2f(dl[r]) * S[kt][r] + uu[r]; } }
    }
    f32x4 og4 = (f32x4){0.f, 0.f, 0.f, 0.f}; if (PASS == 2) og4 = *(const f32x4*)(onormg + colh + 16 * w + 4 * g);
    float bsum0 = 0.f, bsum1 = 0.f;
    const float lb0 = LBv[colh + 2 * kp], lb1 = LBv[colh + 2 * kp + 1];
    unsigned lfw[8], qw[8]; u32x4 iw0, iw1;
#pragma unroll
    for (int j = 0; j < 8; ++j) { const size_t r = row0 + 8 * tg + j; lfw[j] = *(const unsigned*)(Fb + r * CW + colh + 2 * kp); qw[j] = PASS == 2 ? *(const unsigned*)(Qb + r * CW + colh + 2 * kp) : 0u; }
    { const size_t r = row0 + isr; iw0 = *(const u32x4*)(Ib + r * CW + colh + ipc * 16); iw1 = *(const u32x4*)(Ib + r * CW + colh + ipc * 16 + 8); }
    for (int ch = 0; ch < 16; ++ch) {
        const size_t crow = row0 + (size_t)ch * 64;
        float b0[8], b1[8], kk0[8], kk1[8]; { float a0 = 0.f, a1 = 0.f;
#pragma unroll
            for (int j = 0; j < 8; ++j) { const float f0 = lb0 + (1.0f - lb0) * fsigmoid(bflo(lfw[j])), f1 = lb1 + (1.0f - lb1) * fsigmoid(bfhi(lfw[j]));
                kk0[j] = 1.0f - f0; kk1[j] = 1.0f - f1; a0 += __builtin_amdgcn_logf(f0); a1 += __builtin_amdgcn_logf(f1); b0[j] = a0; b1[j] = a1; }
            *(LAS f32x2*)(lds + TOT_OFF + (tg * 128 + 2 * kp) * 4) = (f32x2){a0, a1}; }
        u32x2 gw[4];
        if (PASS == 2) {
#pragma unroll
            for (int tt = 0; tt < 4; ++tt) gw[tt] = *(const u32x2*)(Gb + (crow + 16 * tt + c) * CW + colh + 16 * w + 4 * g); }
        __syncthreads();
        { float p0 = 0.f, p1 = 0.f, r0 = 0.f, r1 = 0.f, e0 = 0.f, e1 = 0.f;
#pragma unroll
          for (int t8 = 0; t8 < 8; ++t8) { const f32x2 tv = *(const LAS f32x2*)(lds + TOT_OFF + (t8 * 128 + 2 * kp) * 4);
              if (t8 < tg) { p0 += tv.x; p1 += tv.y; } if (t8 < 4) { r0 += tv.x; r1 += tv.y; } e0 += tv.x; e1 += tv.y; }
#pragma unroll
          for (int j = 0; j < 8; ++j) { const int t = 8 * tg + j; const float bb0 = b0[j] + p0, bb1 = b1[j] + p1;
              *(LAS unsigned*)(lds + KS_OFF + t * KS_RS + kp * 4) = cvt_pk_bf16(kk0[j] * __builtin_amdgcn_exp2f(r0 - bb0), kk1[j] * __builtin_amdgcn_exp2f(r1 - bb1));
              if (PASS == 2) *(LAS unsigned*)(lds + QS_OFF + t * QS_RS + kp * 4) = cvt_pk_bf16(fsilu(bflo(qw[j])) * __builtin_amdgcn_exp2f(bb0 - r0), fsilu(bfhi(qw[j])) * __builtin_amdgcn_exp2f(bb1 - r1)); }
          if (tg == 0) { *(LAS f32x2*)(lds + RSC_OFF + kp * 8) = (f32x2){__builtin_amdgcn_exp2f(r0), __builtin_amdgcn_exp2f(r1)};
              *(LAS f32x2*)(lds + DSC_OFF + kp * 8) = (f32x2){__builtin_amdgcn_exp2f(e0 - r0), __builtin_amdgcn_exp2f(e1 - r1)}; bsum0 += e0; bsum1 += e1; }
          *(LAS u32x4*)(lds + IS_OFF + isr * IS_RS + ipc * 32) = iw0; *(LAS u32x4*)(lds + IS_OFF + isr * IS_RS + ipc * 32 + 16) = iw1; }
        { const size_t nrow = row0 + (size_t)(ch < 15 ? ch + 1 : ch) * 64;
#pragma unroll
          for (int j = 0; j < 8; ++j) { const size_t r = nrow + 8 * tg + j; lfw[j] = *(const unsigned*)(Fb + r * CW + colh + 2 * kp); if (PASS == 2) qw[j] = *(const unsigned*)(Qb + r * CW + colh + 2 * kp); }
          const size_t r = nrow + isr; iw0 = *(const u32x4*)(Ib + r * CW + colh + ipc * 16); iw1 = *(const u32x4*)(Ib + r * CW + colh + ipc * 16 + 8); }
        __syncthreads();
        if (PASS == 2) {
            const int st = w >> 1;
            bf16x8 Kf[4];
#pragma unroll
            for (int sp = 0; sp < 4; ++sp) Kf[sp] = rowfrag(lds + KS_OFF, KS_RS, 16 * st + c, sp, g);
#pragma unroll
            for (int i = 0; i < 2; ++i) { const int tt = 2 * (w & 1) + i; f32x4 acc = (f32x4){0.f, 0.f, 0.f, 0.f};
#pragma unroll
                for (int sp = 0; sp < 4; ++sp) acc = HG_MFMA(Kf[sp], rowfrag(lds + QS_OFF, QS_RS, 16 * tt + c, sp, g), acc);
                const int t = 16 * tt + c, s0 = 16 * st + 4 * g;
#pragma unroll
                for (int r = 0; r < 4; ++r) acc[r] = (s0 + r <= t) ? acc[r] : 0.f;
                u32x2 pw; pw.x = cvt_pk_bf16(acc[0], acc[1]); pw.y = cvt_pk_bf16(acc[2], acc[3]);
                *(LAS u32x2*)(lds + PS_OFF + t * PS_RS + s0 * 2) = pw; }
            __syncthreads();
        }
#pragma unroll
        for (int kt = 0; kt < 8; ++kt) { const f32x4 rs = *(const LAS f32x4*)(lds + RSC_OFF + (16 * kt + 4 * g) * 4); S[kt] = S[kt] * rs; }
        bf16x8 If[2];
        { s16x4 d[4]; HG_TR4(d, lds_addr + IS_OFF + (unsigned)((4 * g + (c >> 2)) * IS_RS + 32 * w + 8 * (c & 3)), 0, 4608, 9216, 13824); If[0] = HG_CAT(d[0], d[1]); If[1] = HG_CAT(d[2], d[3]); }
        f32x4 O[4];
        if (PASS == 2) {
            bf16x8 Sp[4];
#pragma unroll
            for (int sp = 0; sp < 4; ++sp) Sp[sp] = pack_acc(S[2 * sp], S[2 * sp + 1]);
#pragma unroll
            for (int tt = 0; tt < 4; ++tt) { f32x4 acc = (f32x4){0.f, 0.f, 0.f, 0.f};
#pragma unroll
                for (int sp = 0; sp < 4; ++sp) acc = HG_MFMA(Sp[sp], rowfrag(lds + QS_OFF, QS_RS, 16 * tt + c, sp, g), acc);
#pragma unroll
                for (int sb = 0; sb < 2; ++sb) if (32 * sb <= 16 * tt + 15) acc = HG_MFMA(If[sb], rowfrag(lds + PS_OFF, PS_RS, 16 * tt + c, sb, g), acc);
                O[tt] = acc; }
        }
        { const unsigned kbase = lds_addr + KS_OFF + (unsigned)((4 * g + (c >> 2)) * KS_RS + 8 * (c & 3));
#pragma unroll
          for (int kt = 0; kt < 8; kt += 2) { s16x4 d[8]; HG_TR8(d, kbase + 32 * kt, 0, 4608, 9216, 13824, 32, 4640, 9248, 13856);
              S[kt] = HG_MFMA(HG_CAT(d[0], d[1]), If[0], S[kt]); S[kt] = HG_MFMA(HG_CAT(d[2], d[3]), If[1], S[kt]);
              S[kt + 1] = HG_MFMA(HG_CAT(d[4], d[5]), If[0], S[kt + 1]); S[kt + 1] = HG_MFMA(HG_CAT(d[6], d[7]), If[1], S[kt + 1]); }
#pragma unroll
          for (int kt = 0; kt < 8; ++kt) { const f32x4 ds = *(const LAS f32x4*)(lds + DSC_OFF + (16 * kt + 4 * g) * 4); S[kt] = S[kt] * ds; } }
        if (PASS == 2) {
#pragma unroll
            for (int tt = 0; tt < 4; ++tt) { float ss = (O[tt][0] * O[tt][0] + O[tt][1] * O[tt][1]) + (O[tt][2] * O[tt][2] + O[tt][3] * O[tt][3]);
                ss += __shfl_xor(ss, 16); ss += __shfl_xor(ss, 32); if (g == 0) *(LAS float*)(lds + RED_OFF + ((16 * tt + c) * 8 + w) * 4) = ss; }
            __syncthreads();
#pragma unroll
            for (int tt = 0; tt < 4; ++tt) { const LAS f32x4* rp = (const LAS f32x4*)(lds + RED_OFF + (16 * tt + c) * 32); const f32x4 ra = rp[0], rb = rp[1];
                const float tot = ((ra[0] + ra[1]) + (ra[2] + ra[3])) + ((rb[0] + rb[1]) + (rb[2] + rb[3]));
                const float rstd = __builtin_amdgcn_rsqf(tot * (1.0f / 128.0f) + EPS);
                const float o0 = O[tt][0] * rstd * og4[0] * fsilu(bflo(gw[tt].x)), o1 = O[tt][1] * rstd * og4[1] * fsilu(bfhi(gw[tt].x)), o2 = O[tt][2] * rstd * og4[2] * fsilu(bflo(gw[tt].y)), o3 = O[tt][3] * rstd * og4[3] * fsilu(bfhi(gw[tt].y));
                u32x2 ow; ow.x = cvt_pk_bf16(o0, o1); ow.y = cvt_pk_bf16(o2, o3);
                *(u32x2*)(OG + (crow + 16 * tt + c) * CW + colh + 16 * w + 4 * g) = ow; }
        }
    }
    if (PASS == 1) {
#pragma unroll
        for (int kt = 0; kt < 8; ++kt) *((f32x4*)Useg + ((size_t)(item * 8 + w) * 8 + kt) * 64 + lane) = S[kt];
        if (tg == 0) *(f32x2*)(Dlog + (size_t)item * 128 + 2 * kp) = (f32x2){bsum0, bsum1};
    }
    __syncthreads();
}
}

struct Args { const float* in[22]; float* out; unsigned char* ws; int ph_lo, ph_hi, li, pad; };
enum { I_X = 0, I_P, I_NORMG, I_WINAB, I_ALNG, I_ALNB, I_AWS, I_ABS, I_BCONV, I_WOUTAB, I_FFNGU, I_FFNDN, I_WINC, I_LBP, I_ONORMG, I_WOUTC, I_WROUTER, I_BROUTER, I_EGU, I_EDN, I_PPROJ, I_PGATE };

template <bool F8> __device__ __forceinline__ void transpose_item(const float* W, int K, int N, void* WTv, const float* gain, int gu_ff, float scale, LAS float* scr, int item, int lane) {
    const int nblk = N / 32, kb = item / nblk, nb = item % nblk, k0 = 64 * kb, n0 = 32 * nb;
#pragma unroll 8
    for (int i = 0; i < 32; ++i) { const int kk = 2 * i + (lane >> 5); float w = W[(size_t)(k0 + kk) * N + n0 + (lane & 31)]; if (gain) w *= gain[k0 + kk]; if (F8) w *= scale; scr[kk * 33 + (lane & 31)] = w; }
    asm volatile("s_waitcnt lgkmcnt(0)" ::: "memory");
    int d0 = n0; if (gu_ff) { const int half = n0 >= gu_ff ? 1 : 0, j = n0 - half * gu_ff; d0 = (j / 128) * 256 + half * 128 + (j % 128); }
    const int c = lane & 7;
#pragma unroll
    for (int j = 0; j < 4; ++j) { const int n = (lane >> 3) + 8 * j; const LAS float* s = scr + (8 * c) * 33 + n;
        if (F8) { u32x2 o; o.x = pk4_fp8(s[0 * 33], s[1 * 33], s[2 * 33], s[3 * 33]); o.y = pk4_fp8(s[4 * 33], s[5 * 33], s[6 * 33], s[7 * 33]);
            *(u32x2*)((unsigned char*)WTv + (size_t)(d0 + n) * K + k0 + 8 * c) = o; }
        else { u32x4 o; o.x = cvt_pk_bf16(s[0 * 33], s[1 * 33]); o.y = cvt_pk_bf16(s[2 * 33], s[3 * 33]); o.z = cvt_pk_bf16(s[4 * 33], s[5 * 33]); o.w = cvt_pk_bf16(s[6 * 33], s[7 * 33]);
            *(u32x4*)((bf16_t*)WTv + (size_t)(d0 + n) * K + k0 + 8 * c) = o; } }
    asm volatile("s_waitcnt lgkmcnt(0)" ::: "memory");
}

__device__ __forceinline__ void ld_row_bf16(const bf16_t* row, int lane, float (&v)[16]) { unpack8(*(const u32x4*)(row + lane * 8), v); unpack8(*(const u32x4*)(row + 512 + lane * 8), v + 8); }
__device__ __forceinline__ void st_row_bf16(bf16_t* row, int lane, const float (&v)[16]) { *(u32x4*)(row + lane * 8) = pack8(v); *(u32x4*)(row + 512 + lane * 8) = pack8(v + 8); }
__device__ __forceinline__ void ld_row_f32(const float* row, int lane, float (&v)[16]) {
    const f32x4 a = *(const f32x4*)(row + lane * 8), b = *(const f32x4*)(row + lane * 8 + 4), c = *(const f32x4*)(row + 512 + lane * 8), d = *(const f32x4*)(row + 512 + lane * 8 + 4);
#pragma unroll
    for (int j = 0; j < 4; ++j) { v[j] = a[j]; v[4 + j] = b[j]; v[8 + j] = c[j]; v[12 + j] = d[j]; }
}
__device__ __forceinline__ float sumsq16(const float (&v)[16]) { float s = 0.f;
#pragma unroll
    for (int j = 0; j < 16; ++j) s += v[j] * v[j];
    return s; }


template <int NSRC, bool WRITE_RSTD>
__device__ __forceinline__ void thin_resid(const bf16_t* mix0, const bf16_t* mix1, const bf16_t* xin, bf16_t* xout, float* rstd_out, const float* gain, int m0, int nrows, int lane) {
    float g[16]; ld_row_f32(gain, lane, g);
    for (int i0 = 0; i0 < nrows; i0 += 4) {
        float mx[4][16], x[4][16];
#pragma unroll
        for (int r = 0; r < 4; ++r) { const size_t m = (size_t)(m0 + i0 + r); ld_row_bf16(mix0 + m * D, lane, mx[r]); ld_row_bf16(xin + m * D, lane, x[r]);
            if (NSRC == 2) { float m2[16]; ld_row_bf16(mix1 + m * D, lane, m2);
#pragma unroll
                for (int j = 0; j < 16; ++j) mx[r][j] += m2[j]; } }
#pragma unroll
        for (int r = 0; r < 4; ++r) { const size_t m = (size_t)(m0 + i0 + r);
            const float rm = __builtin_amdgcn_rsqf(wave_sum(sumsq16(mx[r])) * (1.0f / D) + EPS);
#pragma unroll
            for (int j = 0; j < 16; ++j) x[r][j] += g[j] * mx[r][j] * rm;
            st_row_bf16(xout + m * D, lane, x[r]);
            if (WRITE_RSTD) { const float ss = wave_sum(sumsq16(x[r])); if (lane == 0) rstd_out[m] = __builtin_amdgcn_rsqf(ss * (1.0f / D) + EPS); } }
    }
}

__global__ void __launch_bounds__(NTHR, 2) trunk_fwd(Args args) {
    extern __shared__ __attribute__((aligned(16))) unsigned char lds_raw[];
    LAS unsigned char* lds = (LAS unsigned char*)lds_raw;
    volatile LAS unsigned* MISC = (volatile LAS unsigned*)(lds + MISC_OFF);
    const int tid = threadIdx.x;
    const int G = gridDim.x, bx = blockIdx.x;
    unsigned char* ws = args.ws;
    for (int u = tid; u < (LDS_BYTES - LDSCTL_OFF) / 4; u += NTHR) ((LAS unsigned*)(lds + LDSCTL_OFF))[u] = 0u;
    __syncthreads();
    XcdBarrier bar; bar.bar = (unsigned*)(ws + WS_CTL) + CW_BAR; bar.x = 0; bar.st = nullptr;
    if (MK_N_LAUNCHES == 1) bar = xcd_barrier_post((unsigned*)(ws + WS_CTL) + CW_BAR, MISC + 8);
    const int lo = args.ph_lo, hi = args.ph_hi;
#define IN(k) (lo <= (k) && (k) < hi)
#define SEAM(k) do { if (IN(k) && IN((k) + 1)) xcd_barrier(bar); } while (0)

    const float* normg = args.in[I_NORMG];
    float* rstd0 = (float*)(ws + SM_RSTD0); float* rstd1 = (float*)(ws + SM_RSTD1); float* rstd4 = (float*)(ws + SM_RSTD4);
    float* LB = (float*)(ws + SM_LB); int* route = (int*)(ws + SM_ROUTE); int* cntg = (int*)(ws + SM_CNT); int* meta = (int*)(ws + SM_META);
    int* perm = (int*)(ws + SM_PERM); int* rinfo = (int*)(ws + SM_RINFO); float* ssp = (float*)(ws + SM_SSP);
    bf16_t* XA = (bf16_t*)(ws + WS_XA); bf16_t* XB = (bf16_t*)(ws + WS_XB); bf16_t* PB = (bf16_t*)(ws + WS_PB);
    unsigned char* R = ws + WS_R;
    const int NGW = G * NWAVES;
    const int RPW = M / G;

    if (IN(0)) for (int rep_ = 0; rep_ < NREP(0); ++rep_) { const int lane = get_lane(), wave = get_wave(); const int gw = bx * NWAVES + wave; (void)gw; (void)lane;
        LAS float* scr = (LAS float*)(lds + wave * 16384);
        constexpr int I1 = 16 * 80, I2 = 16 * 32, I3 = 16 * 176, I4 = 44 * 32, I5 = 16 * 128, I6 = 16 * 32, I7E = 16 * 224, I8E = 56 * 32, I9L = 4 * 32, I10L = 16 * 32;
        constexpr int NITEMS = I1 + I2 + I3 + I4 + I5 + I6 + 8 * I7E + 8 * I8E + 2 * I9L + 2 * I10L;
        for (int it = gw; it < NITEMS; it += NGW) {
            int r = it;
            if (r < I1) { transpose_item<false>(args.in[I_WINAB], D, AB_IN, (bf16_t*)(ws + W_INAB), normg + 0 * D, 0, 1.0f, scr, r, lane); continue; } r -= I1;
            if (r < I2) { transpose_item<false>(args.in[I_WOUTAB], D, D, (bf16_t*)(ws + W_OUTAB), nullptr, 0, 1.0f, scr, r, lane); continue; } r -= I2;
            if (r < I3) { transpose_item<false>(args.in[I_FFNGU], D, 2 * FF, (bf16_t*)(ws + W_GU0), normg + 2 * D, FF, 1.0f, scr, r, lane); continue; } r -= I3;
            if (r < I4) { transpose_item<false>(args.in[I_FFNDN], FF, D, (bf16_t*)(ws + W_DN0), nullptr, 0, 1.0f, scr, r, lane); continue; } r -= I4;
            if (r < I5) { transpose_item<false>(args.in[I_WINC], D, 4 * CW, (bf16_t*)(ws + W_INC), normg + 4 * D, 0, 1.0f, scr, r, lane); continue; } r -= I5;
            if (r < I6) { transpose_item<false>(args.in[I_WOUTC], CW, D, (bf16_t*)(ws + W_OUTC), nullptr, 0, 1.0f, scr, r, lane); continue; } r -= I6;
            if (r < 8 * I7E) { const int e = r / I7E; transpose_item<true>(args.in[I_EGU] + (size_t)e * D * 2 * EFF, D, 2 * EFF, ws + W_EGU8 + (size_t)e * 2 * EFF * D, normg + 6 * D, EFF, SC_GU, scr, r % I7E, lane); continue; } r -= 8 * I7E;
            if (r < 8 * I8E) { const int e = r / I8E; transpose_item<true>(args.in[I_EDN] + (size_t)e * EFF * D, EFF, D, ws + W_EDN8 + (size_t)e * D * EFF, nullptr, 0, SC_DN, scr, r % I8E, lane); continue; } r -= 8 * I8E;
            if (r < 2 * I9L) { const int l = r / I9L; transpose_item<false>(args.in[I_PPROJ] + (size_t)l * PLE * D, PLE, D, (bf16_t*)(ws + W_PPROJ) + (size_t)l * D * PLE, nullptr, 0, 1.0f, scr, r % I9L, lane); continue; } r -= 2 * I9L;
            { const int l = r / I10L; transpose_item<false>(args.in[I_PGATE] + (size_t)l * D * D, D, D, (bf16_t*)(ws + W_PGATE) + (size_t)l * D * D, nullptr, 0, 1.0f, scr, r % I10L, lane); }
        }
        for (int m = gw; m < M; m += NGW) { float v[16]; ld_row_f32(args.in[I_X] + (size_t)m * D, lane, v);
            const float ss = wave_sum(sumsq16(v)); st_row_bf16(XA + (size_t)m * D, lane, v); if (lane == 0) rstd0[m] = __builtin_amdgcn_rsqf(ss * (1.0f / D) + EPS); }
        { const float* p = args.in[I_P]; const size_t n8 = (size_t)2 * M * PLE / 8;
          for (size_t i = (size_t)bx * NTHR + tid; i < n8; i += (size_t)G * NTHR) { const f32x4 a = *(const f32x4*)(p + i * 8), b = *(const f32x4*)(p + i * 8 + 4);
              float v[8] = {a[0], a[1], a[2], a[3], b[0], b[1], b[2], b[3]}; *(u32x4*)(PB + i * 8) = pack8(v); } }
        { bf16_t* W16 = (bf16_t*)(ws + SM_W16); for (int e = bx * NTHR + tid; e < 8 * 128 * 128; e += G * NTHR) W16[e] = f2bf(args.in[I_AWS][e]); }
        if (bx == 0) for (int c = tid; c < CW; c += NTHR) { const float d = args.in[I_LBP][CW + c] - args.in[I_LBP][c]; LB[c] = 1.0f / (1.0f + expf(-d)); }
    }
    SEAM(0);

    if (IN(1)) for (int rep_ = 0; rep_ < NREP(1); ++rep_) { pg8::StaticOrder S; S.init(XA, (const bf16_t*)(ws + W_INAB), M, AB_IN, D, G, bx); pg8::EpiInAB E{(bf16_t*)(R + R_Z), rstd0};
        pg8::gemm_phase<pg8::EpiInAB, pg8::StaticOrder, false>(lds, 2 * D, S, E); }
    SEAM(1);

    if (IN(2)) for (int rep_ = 0; rep_ < NREP(2); ++rep_) { const int lane = get_lane(), wave = get_wave();
        const bf16_t* Z = (const bf16_t*)(R + R_Z); bf16_t* Y = (bf16_t*)(R + R_Y); const bf16_t* W16 = (const bf16_t*)(ws + SM_W16);
        constexpr int IRS = 544;
        const unsigned lds_addr = (unsigned)(size_t)lds; const int c = lane & 15, g = lane >> 4;
        for (int blk = bx; blk < M / 128; blk += G) {
            const int t0 = blk * 128;
            for (int hg2 = 0; hg2 < 2; ++hg2) {
                { const int row = tid >> 2, dq = tid & 3;
#pragma unroll 1
                  for (int hh = 0; hh < 4; ++hh) { const int h = hg2 * 4 + hh; const bf16_t* vp = Z + (size_t)(t0 + row) * AB_IN + 512 + h * 64 + dq * 16; float v[16];
                      unpack8(*(const u32x4*)vp, v); unpack8(*(const u32x4*)(vp + 8), v + 8);
                      float sm = 0.f;
#pragma unroll
                      for (int j = 0; j < 16; ++j) sm += v[j];
                      sm += __shfl_xor(sm, 1); sm += __shfl_xor(sm, 2); const float mu = sm * (1.0f / 64.0f); float q = 0.f;
#pragma unroll
                      for (int j = 0; j < 16; ++j) { v[j] -= mu; q += v[j] * v[j]; }
                      q += __shfl_xor(q, 1); q += __shfl_xor(q, 2); const float rs = __builtin_amdgcn_rsqf(q * (1.0f / 64.0f) + EPS);
                      const float* lg = args.in[I_ALNG] + h * 64 + dq * 16; const float* lb = args.in[I_ALNB] + h * 64 + dq * 16;
#pragma unroll
                      for (int j4 = 0; j4 < 4; ++j4) { const f32x4 gg = *(const f32x4*)(lg + 4 * j4), bb = *(const f32x4*)(lb + 4 * j4);
#pragma unroll
                          for (int j = 0; j < 4; ++j) v[4 * j4 + j] = v[4 * j4 + j] * rs * gg[j] + bb[j]; }
                      LAS unsigned char* ip = lds + row * IRS + (hh * 64 + dq * 16) * 2; *(LAS u32x4*)ip = pack8(v); *(LAS u32x4*)(ip + 16) = pack8(v + 8); } }
                __syncthreads();
                { const int nks = wave < 4 ? 2 : 4; const int i = 16 * wave + c;
#pragma unroll 1
                  for (int hh = 0; hh < 4; ++hh) { const int h = hg2 * 4 + hh; const bf16_t* wrow = W16 + ((size_t)h * 128 + i) * 128 + 4 * g; bf16x8 Bf[4];
#pragma unroll
                      for (int ks = 0; ks < 4; ++ks) { if (ks < nks) { const hg::s16x4 lo = *(const hg::s16x4*)(wrow + 32 * ks), hi = *(const hg::s16x4*)(wrow + 32 * ks + 16); Bf[ks] = __builtin_shufflevector(lo, hi, 0, 1, 2, 3, 4, 5, 6, 7); } else Bf[ks] = Bf[0]; }
                      const float bsv = args.in[I_ABS][h * 128 + i];
#pragma unroll
                      for (int dt = 0; dt < 4; ++dt) { f32x4 acc = (f32x4){0.f, 0.f, 0.f, 0.f};
                          { const unsigned ib = lds_addr + (unsigned)((4 * g + (c >> 2)) * IRS + 32 * (hh * 4 + dt) + 8 * (c & 3)); hg::s16x4 d[8];
                            if (nks == 4) { HG_TR8(d, ib, 0, 8704, 17408, 26112, 34816, 43520, 52224, 60928);
#pragma unroll
                                for (int ks = 0; ks < 4; ++ks) acc = HG_MFMA(HG_CAT(d[2 * ks], d[2 * ks + 1]), Bf[ks], acc); }
                            else { HG_TR4(d, ib, 0, 8704, 17408, 26112); acc = HG_MFMA(HG_CAT(d[0], d[1]), Bf[0], acc); acc = HG_MFMA(HG_CAT(d[2], d[3]), Bf[1], acc); } }
                          const int col = h * 64 + 16 * dt + 4 * g; const u32x2 uw = *(const u32x2*)(Z + (size_t)(t0 + i) * AB_IN + col);
                          u32x2 yw; yw.x = cvt_pk_bf16(bflo(uw.x) * (acc[0] + bsv), bfhi(uw.x) * (acc[1] + bsv)); yw.y = cvt_pk_bf16(bflo(uw.y) * (acc[2] + bsv), bfhi(uw.y) * (acc[3] + bsv));
                          *(u32x2*)(Y + (size_t)(t0 + i) * D + col) = yw; } } }
                __syncthreads();
            }
            { const int cg8 = lane * 8, r0 = t0 + 16 * wave; float w0[8], w1[8], w2[8], p2[8], p1[8];
              { const float* bc = args.in[I_BCONV];
#pragma unroll
                for (int j4 = 0; j4 < 2; ++j4) { const f32x4 a = *(const f32x4*)(bc + cg8 + 4 * j4), b = *(const f32x4*)(bc + 512 + cg8 + 4 * j4), cc = *(const f32x4*)(bc + 1024 + cg8 + 4 * j4);
#pragma unroll
                    for (int j = 0; j < 4; ++j) { w0[4 * j4 + j] = a[j]; w1[4 * j4 + j] = b[j]; w2[4 * j4 + j] = cc[j]; } } }
              if ((r0 % SEQ) != 0) { float xa[8], ca[8], xb2[8], cb2[8];
                  unpack8(*(const u32x4*)(Z + (size_t)(r0 - 2) * AB_IN + 1024 + cg8), xa); unpack8(*(const u32x4*)(Z + (size_t)(r0 - 2) * AB_IN + 1536 + cg8), ca);
                  unpack8(*(const u32x4*)(Z + (size_t)(r0 - 1) * AB_IN + 1024 + cg8), xb2); unpack8(*(const u32x4*)(Z + (size_t)(r0 - 1) * AB_IN + 1536 + cg8), cb2);
#pragma unroll
                  for (int j = 0; j < 8; ++j) { p2[j] = xa[j] * ca[j]; p1[j] = xb2[j] * cb2[j]; } }
              else {
#pragma unroll
                  for (int j = 0; j < 8; ++j) { p2[j] = 0.f; p1[j] = 0.f; } }
              for (int tb = 0; tb < 16; tb += 8) { u32x4 xw[8], cw[8], bw[8];
#pragma unroll
                  for (int t = 0; t < 8; ++t) { const bf16_t* z = Z + (size_t)(r0 + tb + t) * AB_IN + cg8; xw[t] = *(const u32x4*)(z + 1024); cw[t] = *(const u32x4*)(z + 1536); bw[t] = *(const u32x4*)(z + 2048); }
#pragma unroll
                  for (int t = 0; t < 8; ++t) { float xv[8], cv[8], bv[8], o[8]; unpack8(xw[t], xv); unpack8(cw[t], cv); unpack8(bw[t], bv);
#pragma unroll
                      for (int j = 0; j < 8; ++j) { const float p0 = xv[j] * cv[j]; o[j] = bv[j] * (w0[j] * p2[j] + w1[j] * p1[j] + w2[j] * p0); p2[j] = p1[j]; p1[j] = p0; }
                      *(u32x4*)(Y + (size_t)(r0 + tb + t) * D + 512 + cg8) = pack8(o); } } }
        }
    }
    SEAM(2);

    if (IN(3)) for (int rep_ = 0; rep_ < NREP(3); ++rep_) { pg8::StaticOrder S; S.init((const bf16_t*)(R + R_Y), (const bf16_t*)(ws + W_OUTAB), M, D, D, G, bx); pg8::EpiPlain E{(bf16_t*)(R + R_MIX), D};
        pg8::gemm_phase<pg8::EpiPlain, pg8::StaticOrder, false>(lds, 2 * D, S, E); }
    SEAM(3);

    if (IN(4)) for (int rep_ = 0; rep_ < NREP(4); ++rep_) { const int lane = get_lane(), wave = get_wave(); const int gw = bx * NWAVES + wave; (void)gw; (void)lane;
        thin_resid<1, true>((const bf16_t*)(R + R_MIX), nullptr, XA, XB, rstd1, normg + 1 * D, bx * RPW + wave * (RPW / NWAVES), RPW / NWAVES, lane); }
    SEAM(4);

    if (IN(5)) for (int rep_ = 0; rep_ < NREP(5); ++rep_) { pg8::StaticOrder S; S.init(XB, (const bf16_t*)(ws + W_GU0), M, 2 * FF, D, G, bx); pg8::EpiSwiGLU<false> E{(bf16_t*)(R + R_HF), FF, rstd1, nullptr};
        pg8::gemm_phase<pg8::EpiSwiGLU<false>, pg8::StaticOrder, false>(lds, 2 * D, S, E); }
    SEAM(5);

    if (IN(6)) for (int rep_ = 0; rep_ < NREP(6); ++rep_) { pg8::StaticOrder S; S.init((const bf16_t*)(R + R_HF), (const bf16_t*)(ws + W_DN0), M, D, FF, G, bx); pg8::EpiPlain E{(bf16_t*)(R + R_MIX), D};
        pg8::gemm_phase<pg8::EpiPlain, pg8::StaticOrder, false>(lds, 2 * FF, S, E); }
    SEAM(6);

    if (IN(7)) for (int rep_ = 0; rep_ < NREP(7); ++rep_) { const int lane = get_lane(), wave = get_wave(); const int gw = bx * NWAVES + wave; (void)gw; (void)lane;
        thin_resid<1, false>((const bf16_t*)(R + R_MIX), nullptr, XB, XA, nullptr, normg + 3 * D, bx * RPW + wave * (RPW / NWAVES), RPW / NWAVES, lane); }
    SEAM(7);

    if (IN(8)) for (int rep_ = 0; rep_ < NREP(8); ++rep_) { pg8::StaticOrder S; S.init(PB, (const bf16_t*)(ws + W_PPROJ), M, D, PLE, G, bx); pg8::EpiPlain E{(bf16_t*)(R + R_PP), D};
        pg8::gemm_phase<pg8::EpiPlain, pg8::StaticOrder, false>(lds, 2 * PLE, S, E); }

    if (IN(9)) for (int rep_ = 0; rep_ < NREP(9); ++rep_) { pg8::StaticOrder S; S.init(XA, (const bf16_t*)(ws + W_PGATE), M, D, D, G, bx); pg8::EpiPleGate<false> E{XA, (const bf16_t*)(R + R_PP), XB, ssp, nullptr, (LAS float*)(lds + pg8::PERMBUF_OFF + 2048)};
        pg8::gemm_phase<pg8::EpiPleGate<false>, pg8::StaticOrder, false>(lds, 2 * D, S, E); }
    SEAM(9);

    if (IN(10)) for (int rep_ = 0; rep_ < NREP(10); ++rep_) { pg8::StaticOrder S; S.init(XB, (const bf16_t*)(ws + W_INC), M, 4 * CW, D, G, bx); pg8::EpiInC E{(bf16_t*)(R + R_QFIG), ssp};
        pg8::gemm_phase<pg8::EpiInC, pg8::StaticOrder, false>(lds, 2 * D, S, E); }
    SEAM(10);

    if (IN(11)) for (int rep_ = 0; rep_ < NREP(11); ++rep_) {
        const bf16_t* Qb = (const bf16_t*)(R + R_QFIG); const bf16_t* Fb = Qb + (size_t)M * CW; const bf16_t* Ib = Fb + (size_t)M * CW; const bf16_t* Gb = Ib + (size_t)M * CW;
        for (int item = bx; item < BATCH * 8 * 8; item += G) { if ((item & 7) == 7) continue;
            hg::run<1>(lds, Qb, Fb, Ib, Gb, args.in[I_ONORMG], LB, (float*)(R + R_O), (float*)(ws + SM_DLOG), (bf16_t*)(R + R_OG), item); }
    }
    SEAM(11);

    if (IN(12)) for (int rep_ = 0; rep_ < NREP(12); ++rep_) {
        const bf16_t* Qb = (const bf16_t*)(R + R_QFIG); const bf16_t* Fb = Qb + (size_t)M * CW; const bf16_t* Ib = Fb + (size_t)M * CW; const bf16_t* Gb = Ib + (size_t)M * CW;
        for (int item = bx; item < BATCH * 8 * 8; item += G)
            hg::run<2>(lds, Qb, Fb, Ib, Gb, args.in[I_ONORMG], LB, (float*)(R + R_O), (float*)(ws + SM_DLOG), (bf16_t*)(R + R_OG), item);
    }
    SEAM(12);

    if (IN(13)) for (int rep_ = 0; rep_ < NREP(13); ++rep_) { pg8::StaticOrder S; S.init((const bf16_t*)(R + R_OG), (const bf16_t*)(ws + W_OUTC), M, D, CW, G, bx); pg8::EpiPlain E{(bf16_t*)(R + R_MIX1), D};
        pg8::gemm_phase<pg8::EpiPlain, pg8::StaticOrder, false>(lds, 2 * CW, S, E); }
    SEAM(13);

    if (IN(14)) for (int rep_ = 0; rep_ < NREP(14); ++rep_) { const int lane = get_lane(), wave = get_wave(); const int gw = bx * NWAVES + wave; (void)gw; (void)lane; const bf16_t* MIX = (const bf16_t*)(R + R_MIX1); float g[16], g2[16]; ld_row_f32(normg + 5 * D, lane, g); ld_row_f32(normg + 6 * D, lane, g2);
        LAS float* wrl = (LAS float*)lds;
        LAS int* lcnt = (LAS int*)(lds + 32768);
        for (int e = tid; e < D * NE; e += NTHR) wrl[(e & 7) * D + (e >> 3)] = args.in[I_WROUTER][e];
        if (tid < NE) lcnt[tid] = 0;
        __syncthreads();
        for (int i0 = 0; i0 < RPW / NWAVES; i0 += 2) { float mx2[2][16], x2[2][16];
#pragma unroll
          for (int r2 = 0; r2 < 2; ++r2) { const int m = bx * RPW + wave * (RPW / NWAVES) + i0 + r2; ld_row_bf16(MIX + (size_t)m * D, lane, mx2[r2]); ld_row_bf16(XB + (size_t)m * D, lane, x2[r2]); }
#pragma unroll
          for (int r2 = 0; r2 < 2; ++r2) { const int m = bx * RPW + wave * (RPW / NWAVES) + i0 + r2; float (&mx)[16] = mx2[r2]; float (&x)[16] = x2[r2];
            const float rm = __builtin_amdgcn_rsqf(wave_sum(sumsq16(mx)) * (1.0f / D) + EPS);
#pragma unroll
            for (int j = 0; j < 16; ++j) x[j] += g[j] * mx[j] * rm;
            const float rs = __builtin_amdgcn_rsqf(wave_sum(sumsq16(x)) * (1.0f / D) + EPS);
            st_row_bf16(XA + (size_t)m * D, lane, x); if (lane == 0) rstd4[m] = rs;
            { float xn[16];
#pragma unroll
              for (int j = 0; j < 16; ++j) xn[j] = x[j] * rs;
              unsigned char* x8 = ws + WS_X8 + (size_t)m * D; *(u32x2*)(x8 + lane * 8) = pack8_fp8(xn); *(u32x2*)(x8 + 512 + lane * 8) = pack8_fp8(xn + 8); }
            float lg[NE];
#pragma unroll
            for (int e = 0; e < NE; ++e) lg[e] = 0.f;
            { float hn[16];
#pragma unroll
              for (int j = 0; j < 16; ++j) hn[j] = x[j] * rs * g2[j];
#pragma unroll
              for (int e = 0; e < NE; ++e) { const LAS f32x4* wp0 = (const LAS f32x4*)(wrl + e * D + lane * 8); const LAS f32x4* wp1 = (const LAS f32x4*)(wrl + e * D + 512 + lane * 8);
                  const f32x4 a0 = wp0[0], a1 = wp0[1], c0 = wp1[0], c1 = wp1[1];
#pragma unroll
                  for (int j = 0; j < 4; ++j) lg[e] += hn[j] * a0[j] + hn[4 + j] * a1[j] + hn[8 + j] * c0[j] + hn[12 + j] * c1[j]; } }
#pragma unroll
            for (int e = 0; e < NE; ++e) lg[e] = wave_sum(lg[e]) + args.in[I_BROUTER][e];
            if (lane == 0) { int e1 = 0; float l1 = lg[0];
#pragma unroll
                for (int e = 1; e < NE; ++e) if (lg[e] > l1) { l1 = lg[e]; e1 = e; }
                int e2 = -1; float l2 = -3.0e38f;
#pragma unroll
                for (int e = 0; e < NE; ++e) if (e != e1 && lg[e] > l2) { l2 = lg[e]; e2 = e; }
                const float ex = expf(l2 - l1), w1 = 1.0f / (1.0f + ex), w2 = ex / (1.0f + ex);
                *(i32x4*)(route + (size_t)m * 4) = (i32x4){e1, e2, __float_as_int(w1), __float_as_int(w2)};
                atomicAdd((int*)(lcnt + e1), 1); atomicAdd((int*)(lcnt + e2), 1); } } }
        __syncthreads();
        if (tid < NE) cntg[bx * NE + tid] = lcnt[tid];
    }
    SEAM(14);

    if (IN(15)) for (int rep_ = 0; rep_ < NREP(15); ++rep_) { const int lane = get_lane(), wave = get_wave(); const int gw = bx * NWAVES + wave; (void)gw; (void)lane;
        LAS int* lc = (LAS int*)lds;
        LAS int* tot = (LAS int*)(lds + 32768);
        for (int e = tid; e < G * NE; e += NTHR) lc[e] = cntg[e];
        __syncthreads();
        if (tid < NE) { int t = 0, pre = 0; for (int w = 0; w < G; ++w) { if (w == bx) pre = t; t += lc[w * NE + tid]; } tot[tid] = t; tot[8 + tid] = pre; }
        __syncthreads();
        if (tid == 0) { int b = 0; for (int e = 0; e < NE; ++e) { tot[16 + e] = b; b += (tot[e] + 255) & ~255; } tot[24] = b; }
        __syncthreads();
        if (wave == 0) { int run[NE];
#pragma unroll
            for (int e = 0; e < NE; ++e) run[e] = 0;
            for (int it = 0; it < RPW / 64; ++it) { const int m = bx * RPW + it * 64 + lane; const i32x4 rt = *(const i32x4*)(route + (size_t)m * 4);
                const unsigned long long lt = (1ull << lane) - 1ull;
#pragma unroll
                for (int e = 0; e < NE; ++e) { const bool has = (rt[0] == e) || (rt[1] == e); const unsigned long long mask = __ballot(has);
                    if (has) { const int pos = tot[16 + e] + tot[8 + e] + run[e] + __popcll(mask & lt); const int slot = (rt[1] == e) ? 1 : 0;
                        perm[pos] = m; rinfo[2 * pos] = m * 2 + slot; rinfo[2 * pos + 1] = slot ? rt[3] : rt[2]; }
                    run[e] += __popcll(mask); } } }
        if (bx < NE) { const int e = bx; const int beg = tot[16 + e] + tot[e], end = tot[16 + e] + ((tot[e] + 255) & ~255);
            for (int p = beg + tid; p < end; p += NTHR) { perm[p] = 0; rinfo[2 * p] = -1; rinfo[2 * p + 1] = 0; } }
        if (bx == 0) { if (tid == 0) meta[0] = tot[24] / 256; if (tid < NE) meta[1 + tid] = tot[16 + tid];
            for (int p = tid; p < tot[24] / 256; p += NTHR) { int e = 0;
#pragma unroll
                for (int k = 1; k < NE; ++k) if (p * 256 >= tot[16 + k]) e = k;
                meta[16 + p] = e; } }
        __syncthreads();
    }
    SEAM(15);

    if (IN(16)) for (int rep_ = 0; rep_ < NREP(16); ++rep_) {
        pg8::MoeOrder<true> S; S.init(ws + WS_X8, ws + W_EGU8, meta, 2 * EFF, D, G, bx, perm); pg8::EpiSwiGLU8 E{R + R_H, EFF};
        pg8::gemm_phase<pg8::EpiSwiGLU8, pg8::MoeOrder<true>, true, true>(lds, D, S, E); }
    SEAM(16);

    if (IN(17)) for (int rep_ = 0; rep_ < NREP(17); ++rep_) {
        pg8::MoeOrder<false> S; S.init(R + R_H, ws + W_EDN8, meta, D, EFF, G, bx, perm); pg8::EpiMoeDown E{rinfo, (bf16_t*)args.out};
        pg8::gemm_phase<pg8::EpiMoeDown, pg8::MoeOrder<false>, false, true>(lds, EFF, S, E); }
    SEAM(17);

    if (IN(18)) for (int rep_ = 0; rep_ < NREP(18); ++rep_) { const int lane = get_lane(), wave = get_wave(); const int gw = bx * NWAVES + wave; (void)gw; (void)lane;
        thin_resid<2, false>((const bf16_t*)args.out, (const bf16_t*)args.out + (size_t)M * D, XA, XB, nullptr, normg + 7 * D, bx * RPW + wave * (RPW / NWAVES), RPW / NWAVES, lane); }
    SEAM(18);

    if (IN(19)) for (int rep_ = 0; rep_ < NREP(19); ++rep_) { pg8::StaticOrder S; S.init(PB + (size_t)M * PLE, (const bf16_t*)(ws + W_PPROJ) + (size_t)D * PLE, M, D, PLE, G, bx); pg8::EpiPlain E{(bf16_t*)(R + R_PP1), D};
        pg8::gemm_phase<pg8::EpiPlain, pg8::StaticOrder, false>(lds, 2 * PLE, S, E); }

    if (IN(20)) for (int rep_ = 0; rep_ < NREP(20); ++rep_) { pg8::StaticOrder S; S.init(XB, (const bf16_t*)(ws + W_PGATE) + (size_t)D * D, M, D, D, G, bx); pg8::EpiPleGate<true> E{XB, (const bf16_t*)(R + R_PP1), nullptr, nullptr, args.out, nullptr};
        pg8::gemm_phase<pg8::EpiPleGate<true>, pg8::StaticOrder, false>(lds, 2 * D, S, E); }
#undef IN
#undef SEAM
}

constexpr int N_PHASES = 21;
extern "C" void kernel_launch(void* const* d_in, const int* in_sizes, int n_in, void* d_out, int out_size, void* d_ws, size_t ws_size, hipStream_t stream) {
    static int grid = 0;
    if (grid == 0) {
        if (n_in != 22 || in_sizes[0] != M * D || out_size != M * D || ws_size < WS_END) { fprintf(stderr, "kernel_launch: unexpected shapes (n_in %d, in0 %d, out %d, ws %zu < %zu); nothing launched\n", n_in, n_in > 0 ? in_sizes[0] : -1, out_size, ws_size, (size_t)WS_END); grid = -1; return; }
        int dev = 0, cus = 0, per_cu = 0;
        if (hipGetDevice(&dev) != hipSuccess || hipDeviceGetAttribute(&cus, hipDeviceAttributeMultiprocessorCount, dev) != hipSuccess) { grid = -1; return; }
        if (hipFuncSetAttribute((const void*)trunk_fwd, hipFuncAttributeMaxDynamicSharedMemorySize, LDS_BYTES) != hipSuccess) { fprintf(stderr, "kernel_launch: hipFuncSetAttribute failed\n"); grid = -1; return; }
        if (hipOccupancyMaxActiveBlocksPerMultiprocessor(&per_cu, (const void*)trunk_fwd, NTHR, LDS_BYTES) != hipSuccess || per_cu < 1) { fprintf(stderr, "kernel_launch: occupancy query reports %d workgroups per CU\n", per_cu); }
        (void)hipGetLastError();
        grid = cus;
        if (grid > 1024 || (M % (grid * NWAVES)) != 0 || ((M / grid) % 64) != 0) { fprintf(stderr, "kernel_launch: unsupported CU count %d\n", grid); grid = -1; return; }
    }
    if (grid < 0) return;
    if (hipMemsetAsync((char*)d_ws + WS_CTL, 0, CTL_ZERO_BYTES, stream) != hipSuccess) return;
    Args a{};
    for (int i = 0; i < 22; ++i) a.in[i] = (const float*)d_in[i];
    a.out = (float*)d_out; a.ws = (unsigned char*)d_ws; a.pad = 0;
    if (MK_N_LAUNCHES == 1) { a.ph_lo = 0; a.ph_hi = N_PHASES; a.li = 0; hipLaunchKernelGGL(trunk_fwd, dim3(grid), dim3(NTHR), LDS_BYTES, stream, a); }
    else for (int ph = 0; ph < N_PHASES; ++ph) { a.ph_lo = ph; a.ph_hi = ph + 1; a.li = ph; hipLaunchKernelGGL(trunk_fwd, dim3(grid), dim3(NTHR), LDS_BYTES, stream, a); }
}
```

```cpp
#include <hip/hip_runtime.h>
#include <cstdio>
#include <cstdint>

#ifndef MK_N_LAUNCHES
#define MK_N_LAUNCHES 1
#endif

#ifndef PROBE_REP
#define PROBE_REP 0u
#endif
#define NREP(k) (1 + (int)((PROBE_REP >> (k)) & 1u))
#define GAS __attribute__((address_space(1)))
#define LAS __attribute__((address_space(3)))
typedef unsigned short bf16_t;
typedef short bf16x8 __attribute__((ext_vector_type(8)));
typedef float f32x4 __attribute__((ext_vector_type(4)));
typedef float f32x2 __attribute__((ext_vector_type(2)));
typedef unsigned u32x4 __attribute__((ext_vector_type(4)));
typedef unsigned u32x2 __attribute__((ext_vector_type(2)));
typedef int i32x4 __attribute__((ext_vector_type(4)));
typedef int i32x8 __attribute__((ext_vector_type(8)));

constexpr int D = 1024, BATCH = 4, SEQ = 8192, M = BATCH * SEQ;
constexpr int PLE = 256, AB_IN = 2560, FF = 2816, CW = 1024, NE = 8, EFF = 3584;
constexpr float EPS = 1e-6f;
constexpr int NWAVES = 8, NTHR = 512;
constexpr int MAXP = 264;

__device__ __forceinline__ float bflo(unsigned w) { return __uint_as_float(w << 16); }
__device__ __forceinline__ float bfhi(unsigned w) { return __uint_as_float(w & 0xffff0000u); }
__device__ __forceinline__ float bf2f(bf16_t b) { return __uint_as_float((unsigned)b << 16); }
__device__ __forceinline__ unsigned cvt_pk_bf16(float lo, float hi) { unsigned r; asm volatile("v_cvt_pk_bf16_f32 %0, %1, %2" : "=v"(r) : "v"(lo), "v"(hi)); return r; }
__device__ __forceinline__ bf16_t f2bf(float f) { return (bf16_t)(cvt_pk_bf16(f, 0.f) & 0xffffu); }
__device__ __forceinline__ unsigned pk4_fp8(float a, float b, float c, float d) { int w = __builtin_amdgcn_cvt_pk_fp8_f32(a, b, 0, false); w = __builtin_amdgcn_cvt_pk_fp8_f32(c, d, w, true); return (unsigned)w; }
__device__ __forceinline__ u32x2 pack8_fp8(const float* v) { u32x2 w; w.x = pk4_fp8(v[0], v[1], v[2], v[3]); w.y = pk4_fp8(v[4], v[5], v[6], v[7]); return w; }
constexpr float SC_GU = 64.0f, SC_DN = 64.0f, SC_PG = 32.0f;
__device__ __forceinline__ float fsigmoid(float x) { return __builtin_amdgcn_rcpf(1.0f + __builtin_amdgcn_exp2f(-1.4426950408889634f * x)); }
__device__ __forceinline__ float fsilu(float x) { return x * fsigmoid(x); }
__device__ __forceinline__ float fgelu_tanh(float x) { const float u = x + 0.044715f * x * x * x; return x * __builtin_amdgcn_rcpf(1.0f + __builtin_amdgcn_exp2f(-2.3022082f * u)); }
__device__ __forceinline__ int get_lane() { int t; asm volatile("v_and_b32 %0, 63, %1" : "=v"(t) : "v"(threadIdx.x)); return t; }
__device__ __forceinline__ int get_wave() { int t; asm volatile("v_lshrrev_b32 %0, 6, %1" : "=v"(t) : "v"(threadIdx.x)); return __builtin_amdgcn_readfirstlane(t); }
__device__ __forceinline__ float wave_sum(float v) {
#pragma unroll
    for (int o = 1; o < 64; o <<= 1) v += __shfl_xor(v, o);
    return v;
}
__device__ __forceinline__ void unpack8(const u32x4 a, float* v) { v[0] = bflo(a.x); v[1] = bfhi(a.x); v[2] = bflo(a.y); v[3] = bfhi(a.y); v[4] = bflo(a.z); v[5] = bfhi(a.z); v[6] = bflo(a.w); v[7] = bfhi(a.w); }
__device__ __forceinline__ u32x4 pack8(const float* v) { u32x4 w; w.x = cvt_pk_bf16(v[0], v[1]); w.y = cvt_pk_bf16(v[2], v[3]); w.z = cvt_pk_bf16(v[4], v[5]); w.w = cvt_pk_bf16(v[6], v[7]); return w; }

namespace pg8 {
constexpr int BM = 256, BK = 64, HALF = 128, HTB = HALF * BK * 2, STAGE_BYTES = 8 * HTB, NXCD = 8, WGM = 8;
__host__ __device__ __forceinline__ int lds_byte(int r, int c) { const int st = (r >> 4) * 2 + (c >> 5), rr = r & 15, cc = c & 31, ob = rr * 64 + cc * 2; return st * 1024 + (ob ^ (((ob >> 9) & 1) << 5)); }
__host__ __device__ __forceinline__ void stage_rc(int b, int& R, int& C) { const int st = b / 1024, sb = b % 1024, swz = sb ^ (((sb >> 9) & 1) << 5); R = (st >> 1) * 16 + swz / 64; C = (st & 1) * 32 + (swz % 64) / 2; }
__host__ __device__ __forceinline__ int perm32(int rho) { const int n = rho >> 4, i = rho & 15; return 8 * (i >> 2) + 4 * n + (i & 3); }

struct Unit { int pm, pn; const char* a; const char* b; };
__device__ __forceinline__ const char* uni(const char* p) { const unsigned long long v = (unsigned long long)p; const unsigned lo = __builtin_amdgcn_readfirstlane((unsigned)v), hi = __builtin_amdgcn_readfirstlane((unsigned)(v >> 32)); return (const char*)(((unsigned long long)hi << 32) | lo); }

__device__ __forceinline__ bool tile_of(int i, int G, int c, int nM, int nN, int& pm, int& pn) {
    const int nwg = nM * nN; const int L = i * G + c; if (L >= nwg) return false;
    int wgid = L; { const int q = nwg / NXCD, r = nwg % NXCD, xcd = wgid % NXCD, off = wgid / NXCD; wgid = (xcd < r ? xcd * (q + 1) : r * (q + 1) + (xcd - r) * q) + off; }
    const int nig = WGM * nN, gid = wgid / nig, fm = gid * WGM, gsz = (nM - fm) < WGM ? (nM - fm) : WGM;
    pm = fm + ((wgid % nig) % gsz); pn = (wgid % nig) / gsz; return true;
}
struct StaticOrder {
    int nM, nN, G, c; const char* A; const char* Bt; size_t tstep;
    __device__ __forceinline__ void init(const bf16_t* A_, const bf16_t* Bt_, int M_, int N_, int K_, int G_, int c_) { nM = M_ / BM; nN = N_ / BM; G = G_; c = c_; A = (const char*)A_; Bt = (const char*)Bt_; tstep = (size_t)BM * K_ * 2; }
    __device__ __forceinline__ const int* perm_of(const Unit&) const { return nullptr; }
    __device__ __forceinline__ void init_bytes(const void* A_, const void* Bt_, int M_, int N_, int rowB, int G_, int c_) { nM = M_ / BM; nN = N_ / BM; G = G_; c = c_; A = (const char*)A_; Bt = (const char*)Bt_; tstep = (size_t)BM * rowB; }
    __device__ __forceinline__ bool next(int i, Unit& u) const { if (!tile_of(i, G, c, nM, nN, u.pm, u.pn)) return false; u.pm = __builtin_amdgcn_readfirstlane(u.pm); u.pn = __builtin_amdgcn_readfirstlane(u.pn); u.a = uni(A + (size_t)u.pm * tstep); u.b = uni(Bt + (size_t)u.pn * tstep); return true; }
    __device__ __forceinline__ int gather_tok(const Unit&, int) const { return 0; }
};
struct TailOrder {
    int nM, nN, nshort, rho; const char* A; const char* Bt; size_t tstep;
    __device__ __forceinline__ void init(const bf16_t* A_, const bf16_t* Bt_, int M_, int N_, int K_, int nshort_, int rho_) { nM = M_ / BM; nN = N_ / BM; nshort = nshort_; rho = rho_; A = (const char*)A_; Bt = (const char*)Bt_; tstep = (size_t)BM * K_ * 2; }
    __device__ __forceinline__ bool next(int i, Unit& u) const { if (rho < 0) return false; if (!tile_of(i, nshort, rho, nM, nN, u.pm, u.pn)) return false;
        u.pm = __builtin_amdgcn_readfirstlane(u.pm); u.pn = __builtin_amdgcn_readfirstlane(u.pn); u.a = uni(A + (size_t)u.pm * tstep); u.b = uni(Bt + (size_t)u.pn * tstep); return true; }
    __device__ __forceinline__ int gather_tok(const Unit&, int) const { return 0; }
    __device__ __forceinline__ const int* perm_of(const Unit&) const { return nullptr; }
};
template <bool GATHER> struct MoeOrder {
    int nM, nN, G, c; const char* A; const char* Bt; size_t tstep, estride; int pb[7]; const int* perm;
    __device__ __forceinline__ void init(const void* A_, const void* Bt_, const int* meta, int N_, int rowB, int G_, int c_, const int* perm_) {
        nM = __builtin_amdgcn_readfirstlane(meta[0]); nN = N_ / BM; G = G_; c = c_; A = (const char*)A_; Bt = (const char*)Bt_; tstep = (size_t)BM * rowB; estride = (size_t)N_ * rowB; perm = perm_;
#pragma unroll
        for (int k = 0; k < 7; ++k) pb[k] = __builtin_amdgcn_readfirstlane(meta[2 + k]); }
    __device__ __forceinline__ bool next(int i, Unit& u) const { if (!tile_of(i, G, c, nM, nN, u.pm, u.pn)) return false;
        u.pm = __builtin_amdgcn_readfirstlane(u.pm); u.pn = __builtin_amdgcn_readfirstlane(u.pn); int e = 0;
#pragma unroll
        for (int k = 0; k < 7; ++k) e += (u.pm * BM >= pb[k]) ? 1 : 0;
        u.a = uni(GATHER ? A : A + (size_t)u.pm * tstep); u.b = uni(Bt + (size_t)e * estride + (size_t)u.pn * tstep); return true; }
    __device__ __forceinline__ int gather_tok(const Unit& u, int r) const { return perm[u.pm * BM + r]; }
    __device__ __forceinline__ const int* perm_of(const Unit& u) const { return perm + u.pm * BM; }
};

constexpr int PERMBUF_OFF = 131072 + 4096;
template <class Epi, class Sched, bool GATHER, bool FP8 = false>
__device__ __forceinline__ void gemm_phase(LAS unsigned char* lds, const int rowB, const Sched& S, const Epi& E) {
    int tid = threadIdx.x; asm volatile("" : "+v"(tid));
    const int wid = __builtin_amdgcn_readfirstlane(tid >> 6), lane = tid & 63, wr = wid >> 2, wc = wid & 3, fr = lane & 15, fq = lane >> 4;
    const int nt = rowB / 128;
    const size_t kstep = (size_t)128;
    const size_t hstep = (size_t)HALF * rowB;
    const int fp8_one = 0x7F7F7F7F;
    unsigned voffB[2]; int sR[2], sC[2];
#pragma unroll
    for (int i = 0; i < 2; ++i) { int R, C; stage_rc(tid * 16 + i * 8192, R, C); const int Rb = (R & ~31) + perm32(R & 31); sR[i] = R; sC[i] = 2 * C; voffB[i] = (unsigned)(Rb * rowB + 2 * C); }
    const unsigned lbase = (unsigned)__builtin_amdgcn_readfirstlane((int)((unsigned)(size_t)lds + (unsigned)wid * 1024u));
    const int aoff = lds_byte(wr * 64 + fr, fq * 8), boff = lds_byte(wc * 32 + fr, fq * 8);
#define PG8_SA(b, h) (((b) * 2 + (h)) * HTB)
#define PG8_SB(b, h) ((4 + (b) * 2 + (h)) * HTB)
#define PG8_GLDS(ldsdst, voff, sbase) asm volatile("s_mov_b32 m0, %0\n\tglobal_load_lds_dwordx4 %1, %2" :: "s"(ldsdst), "v"(voff), "s"(sbase) : "memory", "m0")
#define PG8_STAGE_B(bufoff, gbase) do { _Pragma("unroll") for (int _i = 0; _i < 2; ++_i) PG8_GLDS(lbase + (unsigned)((bufoff) + _i * 8192), voffB[_i], (const char*)(gbase)); } while (0)
#define PG8_STAGE_A(bufoff, gbase, off, h) do { _Pragma("unroll") for (int _i = 0; _i < 2; ++_i) PG8_GLDS(lbase + (unsigned)((bufoff) + _i * 8192), (off)[GATHER ? (h) : 0][_i], GATHER ? (const char*)(gbase) : (const char*)(gbase) + (h) * hstep); } while (0)
#define PG8_LDA(dst, b, h) do { _Pragma("unroll") for (int m = 0; m < 4; ++m) _Pragma("unroll") for (int k = 0; k < 2; ++k) dst[m][k] = *(const LAS bf16x8*)(lds + PG8_SA(b, h) + aoff + m * 2048 + k * 1024); } while (0)
#define PG8_LDB(dst, b, h) do { _Pragma("unroll") for (int n = 0; n < 2; ++n) _Pragma("unroll") for (int k = 0; k < 2; ++k) dst[n][k] = *(const LAS bf16x8*)(lds + PG8_SB(b, h) + boff + n * 2048 + k * 1024); } while (0)
#define PG8_CAT(x, y) __builtin_shufflevector(__builtin_bit_cast(i32x4, (x)), __builtin_bit_cast(i32x4, (y)), 0, 1, 2, 3, 4, 5, 6, 7)
#define PG8_MMA(ai, bj, At, Bt) do { __builtin_amdgcn_s_setprio(1); _Pragma("unroll") for (int m = 0; m < 4; ++m) _Pragma("unroll") for (int n = 0; n < 2; ++n) { \
        if constexpr (FP8) acc[ai][bj][m][n] = __builtin_amdgcn_mfma_scale_f32_16x16x128_f8f6f4(PG8_CAT(Bt[n][0], Bt[n][1]), PG8_CAT(At[m][0], At[m][1]), acc[ai][bj][m][n], 0, 0, 0, fp8_one, 0, fp8_one); \
        else { _Pragma("unroll") for (int k = 0; k < 2; ++k) acc[ai][bj][m][n] = __builtin_amdgcn_mfma_f32_16x16x32_bf16(Bt[n][k], At[m][k], acc[ai][bj][m][n], 0, 0, 0); } } \
        __builtin_amdgcn_s_setprio(0); } while (0)
#define PG8_WAIT_V(n) asm volatile("s_waitcnt vmcnt(" #n ")" ::: "memory")
#define PG8_WAIT_L(n) asm volatile("s_waitcnt lgkmcnt(" #n ")" ::: "memory")
#define PG8_BAR __builtin_amdgcn_s_barrier()
#define PG8_SCHED __builtin_amdgcn_sched_barrier(0)
    Unit cur, nxt; int ui = 0;
    if (!S.next(0, cur)) return;
    unsigned coff[2][2];
#pragma unroll
    for (int h = 0; h < 2; ++h)
#pragma unroll
        for (int i = 0; i < 2; ++i) {
            if constexpr (GATHER) coff[h][i] = (unsigned)(S.gather_tok(cur, h * HALF + sR[i]) * rowB + sC[i]);
            else coff[h][i] = (unsigned)(sR[i] * rowB + sC[i]);
        }
    f32x4 acc[2][2][4][2];
#pragma unroll
    for (int a = 0; a < 2; ++a)
#pragma unroll
        for (int b = 0; b < 2; ++b)
#pragma unroll
            for (int m = 0; m < 4; ++m)
#pragma unroll
                for (int n = 0; n < 2; ++n) acc[a][b][m][n] = (f32x4){0.f, 0.f, 0.f, 0.f};
    bf16x8 At[4][2], B0[2][2], B1[2][2];
    const char* cA = cur.a; const char* cB = cur.b;
    PG8_STAGE_B(PG8_SB(0, 0), cB); PG8_STAGE_B(PG8_SB(0, 1), cB + hstep); PG8_STAGE_A(PG8_SA(0, 0), cA, coff, 0); PG8_STAGE_A(PG8_SA(0, 1), cA, coff, 1);
    if (wr == 1) PG8_BAR;
    PG8_WAIT_V(2); PG8_BAR;
    PG8_STAGE_B(PG8_SB(1, 0), cB + kstep); PG8_STAGE_A(PG8_SA(1, 0), cA + kstep, coff, 0); PG8_STAGE_B(PG8_SB(1, 1), cB + hstep + kstep);
    PG8_WAIT_V(6); PG8_BAR;
    for (;;) {
        const bool has_next = S.next(ui + 1, nxt);
        const char* nA = has_next ? nxt.a : cA; const char* nB = has_next ? nxt.b : cB;
        if constexpr (GATHER) {
            if (has_next) asm volatile("s_mov_b32 m0, %0\n\tglobal_load_lds_dword %1, %2" :: "s"((unsigned)__builtin_amdgcn_readfirstlane((int)((unsigned)(size_t)lds + (unsigned)(PERMBUF_OFF + wr * 1024 + (wid & 3) * 256)))), "v"((unsigned)(lane * 4)), "s"(uni((const char*)(S.perm_of(nxt) + (wid & 3) * 64))) : "memory", "m0");
        }
        for (int t = 0; t < nt; t += 2) {
            const bool last = (t == nt - 2);
            const char* a1 = cA + (size_t)(t + 1) * kstep;
            const char* a2 = last ? nA : cA + (size_t)(t + 2) * kstep; const char* b2 = last ? nB : cB + (size_t)(t + 2) * kstep;
            const char* a3 = a2 + kstep; const char* b3 = b2 + kstep;
            PG8_LDB(B0, 0, 0); PG8_LDB(B1, 0, 1); PG8_SCHED; PG8_LDA(At, 0, 0); PG8_STAGE_A(PG8_SA(1, 1), a1, coff, 1);
            if constexpr (GATHER) { if (last && has_next) {
                int t_ = tid; asm volatile("" : "+v"(t_));
#pragma unroll
                for (int i = 0; i < 2; ++i) { int R_, C_; stage_rc(t_ * 16 + i * 8192, R_, C_);
#pragma unroll
                    for (int h = 0; h < 2; ++h) { int tok; asm volatile("ds_read_b32 %0, %1" : "=v"(tok) : "v"((unsigned)(size_t)lds + (unsigned)(PERMBUF_OFF + wr * 1024 + (h * HALF + R_) * 4)) : "memory");
                        asm volatile("s_waitcnt lgkmcnt(0)" : "+v"(tok) :: "memory"); coff[h][i] = (unsigned)(tok * rowB + 2 * C_); } } } }
            PG8_WAIT_V(8); PG8_WAIT_L(0); PG8_BAR; PG8_MMA(0, 0, At, B0); PG8_MMA(0, 1, At, B1); PG8_BAR; PG8_SCHED;
            PG8_LDA(At, 0, 1); PG8_STAGE_B(PG8_SB(0, 0), b2); PG8_STAGE_B(PG8_SB(0, 1), b2 + hstep); PG8_STAGE_A(PG8_SA(0, 0), a2, coff, 0);
            PG8_WAIT_V(8); PG8_WAIT_L(0); PG8_BAR; PG8_MMA(1, 0, At, B0); PG8_MMA(1, 1, At, B1); PG8_BAR; PG8_SCHED;
            PG8_LDB(B0, 1, 0); PG8_LDB(B1, 1, 1); PG8_SCHED; PG8_LDA(At, 1, 0); PG8_STAGE_A(PG8_SA(0, 1), a2, coff, 1);
            PG8_WAIT_V(8); PG8_WAIT_L(0); PG8_BAR; PG8_MMA(0, 0, At, B0); PG8_MMA(0, 1, At, B1); PG8_BAR; PG8_SCHED;
            PG8_LDA(At, 1, 1); PG8_STAGE_B(PG8_SB(1, 0), b3); PG8_STAGE_B(PG8_SB(1, 1), b3 + hstep); PG8_STAGE_A(PG8_SA(1, 0), a3, coff, 0);
            PG8_WAIT_V(8); PG8_WAIT_L(0); PG8_BAR; PG8_MMA(1, 0, At, B0); PG8_MMA(1, 1, At, B1); PG8_BAR; PG8_SCHED;
        }
        if (wr == 0) PG8_BAR;
        { const int l2 = get_lane(); E(acc, cur, wr, wc, l2 & 15, l2 >> 4); }
        if (!has_next) break;
#pragma unroll
        for (int a = 0; a < 2; ++a)
#pragma unroll
            for (int b = 0; b < 2; ++b)
#pragma unroll
                for (int m = 0; m < 4; ++m)
#pragma unroll
                    for (int n = 0; n < 2; ++n) acc[a][b][m][n] = (f32x4){0.f, 0.f, 0.f, 0.f};
        cur = nxt; cA = nA; cB = nB; ++ui;
        if (wr == 1) PG8_BAR;
    }
    PG8_WAIT_V(0);
    PG8_BAR;
#undef PG8_SA
#undef PG8_SB
#undef PG8_STAGE_A
#undef PG8_STAGE_B
#undef PG8_LDA
#undef PG8_LDB
#undef PG8_MMA
#undef PG8_WAIT_V
#undef PG8_WAIT_L
#undef PG8_BAR
#undef PG8_SCHED
}

typedef f32x4 AccT[2][2][4][2];
#define EPI_ROWS_BEGIN const int row0 = u.pm * BM + wr * 64 + fr; const int colw = wc * 32 + 8 * fq; \
    _Pragma("unroll") for (int ai = 0; ai < 2; ++ai) _Pragma("unroll") for (int m = 0; m < 4; ++m) { const int r = row0 + ai * HALF + m * 16;
#define EPI_ROWS_END }

struct EpiInAB {
    bf16_t* Z; const float* rstd;
    __device__ __forceinline__ void operator()(const AccT& acc, const Unit& u, int wr, int wc, int fr, int fq) const {
        const bool act = u.pn < 4;
        EPI_ROWS_BEGIN
            const float rs = rstd[r]; bf16_t* rowp = Z + (size_t)r * AB_IN + u.pn * BM + colw;
#pragma unroll
            for (int bj = 0; bj < 2; ++bj) { float v[8];
#pragma unroll
                for (int j = 0; j < 4; ++j) { v[j] = acc[ai][bj][m][0][j] * rs; v[4 + j] = acc[ai][bj][m][1][j] * rs; }
                if (act) {
#pragma unroll
                    for (int j = 0; j < 8; ++j) v[j] = fgelu_tanh(v[j]); }
                *(u32x4*)(rowp + bj * HALF) = pack8(v); }
        EPI_ROWS_END
    }
};
struct EpiPlain {
    bf16_t* O; int ldc;
    __device__ __forceinline__ void operator()(const AccT& acc, const Unit& u, int wr, int wc, int fr, int fq) const {
        EPI_ROWS_BEGIN
            bf16_t* rowp = O + (size_t)r * ldc + u.pn * BM + colw;
#pragma unroll
            for (int bj = 0; bj < 2; ++bj) { float v[8];
#pragma unroll
                for (int j = 0; j < 4; ++j) { v[j] = acc[ai][bj][m][0][j]; v[4 + j] = acc[ai][bj][m][1][j]; }
                *(u32x4*)(rowp + bj * HALF) = pack8(v); }
        EPI_ROWS_END
    }
};
template <bool MOE> struct EpiSwiGLU {
    bf16_t* H; int ldh; const float* rstd; const int* perm;
    __device__ __forceinline__ void operator()(const AccT& acc, const Unit& u, int wr, int wc, int fr, int fq) const {
        EPI_ROWS_BEGIN
            const int tok = MOE ? perm[r] : r; const float rs = rstd[tok];
            float v[8];
#pragma unroll
            for (int n = 0; n < 2; ++n)
#pragma unroll
                for (int j = 0; j < 4; ++j) { const float g = acc[ai][0][m][n][j] * rs, up = acc[ai][1][m][n][j] * rs; v[4 * n + j] = fsilu(g) * up; }
            *(u32x4*)(H + (size_t)r * ldh + u.pn * HALF + colw) = pack8(v);
        EPI_ROWS_END
    }
};
struct EpiSwiGLU8 {
    unsigned char* H; int ldh;
    __device__ __forceinline__ void operator()(const AccT& acc, const Unit& u, int wr, int wc, int fr, int fq) const {
        EPI_ROWS_BEGIN
            float v[8];
#pragma unroll
            for (int n = 0; n < 2; ++n)
#pragma unroll
                for (int j = 0; j < 4; ++j) { const float g = acc[ai][0][m][n][j] * (1.0f / SC_GU), up = acc[ai][1][m][n][j] * (1.0f / SC_GU); v[4 * n + j] = fsilu(g) * up; }
            *(u32x2*)(H + (size_t)r * ldh + u.pn * HALF + colw) = pack8_fp8(v);
        EPI_ROWS_END
    }
};
struct EpiInC {
    bf16_t* QFIG; const float* ssp;
    __device__ __forceinline__ void operator()(const AccT& acc, const Unit& u, int wr, int wc, int fr, int fq) const {
        const int type = u.pn >> 2; const int colt = (u.pn & 3) * BM + wc * 32 + 8 * fq;
        bf16_t* base = QFIG + (size_t)type * M * CW;
        EPI_ROWS_BEGIN
            const f32x4 s0 = *(const f32x4*)(ssp + (size_t)r * 4);
            const float rs = __builtin_amdgcn_rsqf(((s0[0] + s0[1]) + (s0[2] + s0[3])) * (1.0f / D) + EPS);
#pragma unroll
            for (int bj = 0; bj < 2; ++bj) { float v[8];
#pragma unroll
                for (int j = 0; j < 4; ++j) { v[j] = acc[ai][bj][m][0][j] * rs; v[4 + j] = acc[ai][bj][m][1][j] * rs; }
                *(u32x4*)(base + (size_t)r * CW + colt + bj * HALF) = pack8(v); }
        EPI_ROWS_END
    }
};
template <bool FINAL> struct EpiPleGate {
    const bf16_t* X; const bf16_t* PP; bf16_t* XO; float* ssp; float* OUT; LAS float* T; float asc;
    __device__ __forceinline__ void operator()(const AccT& acc, const Unit& u, int wr, int wc, int fr, int fq) const {
        EPI_ROWS_BEGIN
            const size_t off = (size_t)r * D + u.pn * BM + colw; float ssq = 0.f;
#pragma unroll
            for (int bj = 0; bj < 2; ++bj) { float x[8], p[8];
                unpack8(*(const u32x4*)(X + off + bj * HALF), x); unpack8(*(const u32x4*)(PP + off + bj * HALF), p);
#pragma unroll
                for (int j = 0; j < 8; ++j) { const float a = j < 4 ? acc[ai][bj][m][0][j] : acc[ai][bj][m][1][j - 4]; x[j] = x[j] + fsigmoid(a * asc) * p[j]; ssq += x[j] * x[j]; }
                if (FINAL) { *(f32x4*)(OUT + off + bj * HALF) = (f32x4){x[0], x[1], x[2], x[3]}; *(f32x4*)(OUT + off + bj * HALF + 4) = (f32x4){x[4], x[5], x[6], x[7]}; }
                else *(u32x4*)(XO + off + bj * HALF) = pack8(x); }
            if (!FINAL) { ssq += __shfl_xor(ssq, 16); ssq += __shfl_xor(ssq, 32); if (fq == 0) T[(r - u.pm * BM) * 4 + wc] = ssq; }
        EPI_ROWS_END
        if (!FINAL) {
            asm volatile("s_waitcnt lgkmcnt(0)" ::: "memory"); __builtin_amdgcn_s_barrier(); asm volatile("" ::: "memory");
            if (threadIdx.x < 256) { const f32x4 t = *(const LAS f32x4*)(T + threadIdx.x * 4); ssp[(size_t)(u.pm * BM + threadIdx.x) * 4 + u.pn] = (t[0] + t[1]) + (t[2] + t[3]); }
        }
    }
};
struct EpiMoeDown {
    const int* rowinfo; bf16_t* slots;
    __device__ __forceinline__ void operator()(const AccT& acc, const Unit& u, int wr, int wc, int fr, int fq) const {
        EPI_ROWS_BEGIN
            const int info = rowinfo[2 * r]; const float w = __int_as_float(rowinfo[2 * r + 1]) * (1.0f / SC_DN);
            if (info >= 0) { bf16_t* rowp = slots + (size_t)(info & 1) * M * D + (size_t)(info >> 1) * D + u.pn * BM + colw;
#pragma unroll
                for (int bj = 0; bj < 2; ++bj) { float v[8];
#pragma unroll
                    for (int j = 0; j < 4; ++j) { v[j] = acc[ai][bj][m][0][j] * w; v[4 + j] = acc[ai][bj][m][1][j] * w; }
                    *(u32x4*)(rowp + bj * HALF) = pack8(v); } }
        EPI_ROWS_END
    }
};
}

constexpr size_t MiB = 1u << 20;
constexpr size_t WS_CTL = 0, CTL_ZERO_BYTES = 1 * MiB;
constexpr size_t WS_SMALL = 1 * MiB;
constexpr size_t SM_RSTD0 = WS_SMALL, SM_RSTD1 = SM_RSTD0 + 128 * 1024, SM_RSTD4 = SM_RSTD1 + 128 * 1024;
constexpr size_t SM_LB = SM_RSTD4 + 128 * 1024;
constexpr size_t SM_ROUTE = SM_LB + 4096;
constexpr size_t SM_CNT = SM_ROUTE + 512 * 1024;
constexpr size_t SM_META = SM_CNT + 32 * 1024;
constexpr size_t SM_PERM = SM_META + 4096;
constexpr size_t SM_RINFO = SM_PERM + 512 * 1024;
constexpr size_t SM_SSP = SM_RINFO + 1024 * 1024;
constexpr size_t SM_DLOG = SM_SSP + 2 * MiB;
constexpr size_t SM_W16 = SM_DLOG + 128 * 1024;
static_assert(SM_W16 + 256 * 1024 <= 9 * MiB, "small arrays");
constexpr size_t WS_W = 9 * MiB;
constexpr size_t W_INAB = WS_W, W_OUTAB = W_INAB + 5 * MiB, W_GU0 = W_OUTAB + 2 * MiB, W_DN0 = W_GU0 + 11 * MiB, W_INC = W_DN0 + 5 * MiB + 512 * 1024,
                 W_OUTC = W_INC + 8 * MiB, W_EGU8 = W_OUTC + 2 * MiB, W_EDN8 = W_EGU8 + 56 * MiB, W_PPROJ = W_EDN8 + 28 * MiB, W_PGATE = W_PPROJ + 1 * MiB, W_PG8 = W_PGATE + 4 * MiB, W_END = W_PG8 + 1 * MiB;
constexpr size_t WS_PB = W_END;
constexpr size_t WS_XA = WS_PB + 32 * MiB, WS_XB = WS_XA + 64 * MiB;
constexpr size_t WS_X8 = WS_XB + 64 * MiB;
constexpr size_t WS_R = WS_X8 + 32 * MiB;
constexpr size_t R_BYTES = (size_t)MAXP * 256 * EFF * 2;
constexpr size_t WS_END = WS_R + R_BYTES;
constexpr size_t R_Z = 0, R_Y = 160 * MiB, R_MIX = 224 * MiB, R_PP = 288 * MiB, R_HF = 0;
constexpr size_t R_QFIG = 0, R_O = 256 * MiB, R_OG = 384 * MiB, R_MIX1 = 0, R_H = 0, R_PP1 = 256 * MiB;

constexpr int CW_BAR = 4096;

constexpr int RING_BYTES = 131072;
constexpr int LDSCTL_OFF = RING_BYTES, MISC_OFF = LDSCTL_OFF + 320;
constexpr int LDS_BYTES = 147456;

#define XB_TMO      128
#define XB_XCNT(j)  (256  + 64 * (j))
#define XB_XSUB(j)  (1280 + 64 * (j))
#define XB_XGEN(j)  (2304 + 64 * (j))
#define XB_TOP      3328
#define XB_TOPGEN   3392
#define XCD_BAR_WORDS 3456
#define XB_SPIN_CAP (1u << 18)
__device__ __forceinline__ unsigned xb_ld(unsigned* p)              { return __hip_atomic_load(p, __ATOMIC_RELAXED, __HIP_MEMORY_SCOPE_AGENT); }
__device__ __forceinline__ unsigned xb_add(unsigned* p, unsigned v) { return __hip_atomic_fetch_add(p, v, __ATOMIC_RELAXED, __HIP_MEMORY_SCOPE_AGENT); }
__device__ __forceinline__ unsigned xb_xcc_id() { return (unsigned)__builtin_amdgcn_s_getreg((3 << 11) | 20) & 0xFu; }
#define XB_SPIN(cond, bar) do { unsigned _sp = 0; while (cond) { __builtin_amdgcn_s_sleep(1); \
    if ((++_sp & 255u) == 0u) { if (xb_ld(&(bar)[XB_TMO])) break; if (_sp > XB_SPIN_CAP) { atomicAdd(&(bar)[XB_TMO], 1u); break; } } } } while (0)
struct XcdBarrier { unsigned* bar; unsigned x; volatile LAS unsigned* st; };
__device__ __forceinline__ XcdBarrier xcd_barrier_post(unsigned* bar, volatile LAS unsigned* st) {
    XcdBarrier b; b.bar = bar; b.x = xb_xcc_id(); b.st = st;
    if (threadIdx.x == 0) (void)xb_add(&bar[XB_XCNT(b.x)], 1u);
    return b;
}
__device__ __forceinline__ void xcd_barrier_complete(unsigned* bar, unsigned x, unsigned& nloc, unsigned& nx) {
    const unsigned G = gridDim.x * gridDim.y * gridDim.z;
    unsigned sum, cnt, mine, sp = 0u;
    for (;;) {
        sum = 0u; cnt = 0u; mine = 0u;
#pragma unroll
        for (unsigned j = 0; j < 16; ++j) { const unsigned c = xb_ld(&bar[XB_XCNT(j)]); sum += c; cnt += (c > 0u) ? 1u : 0u; mine = (j == x) ? c : mine; }
        if (sum == G) break;
        __builtin_amdgcn_s_sleep(1);
        if ((++sp & 255u) == 0u) { if (xb_ld(&bar[XB_TMO])) break; if (sp > XB_SPIN_CAP) { atomicAdd(&bar[XB_TMO], 1u); break; } }
    }
    nloc = mine > 0u ? mine : 1u; nx = cnt > 0u ? cnt : 1u;
}
__device__ __forceinline__ void xcd_barrier(const XcdBarrier& b) {
    asm volatile("s_waitcnt vmcnt(0)" ::: "memory");
    __syncthreads();
    if (threadIdx.x == 0) {
        unsigned* bar = b.bar;
        __builtin_amdgcn_s_waitcnt(0);
        unsigned nloc = b.st[0], nx = b.st[1];
        if (nloc == 0u) { xcd_barrier_complete(bar, b.x, nloc, nx); b.st[0] = nloc; b.st[1] = nx; }
        const unsigned old = xb_add(&bar[XB_XSUB(b.x)], 1u);
        const unsigned gen = old / nloc;
        if (old + 1u == (gen + 1u) * nloc) {
            __builtin_amdgcn_fence(__ATOMIC_RELEASE, "agent");
            asm volatile("s_waitcnt vmcnt(0)" ::: "memory");
            const unsigned og = xb_add(&bar[XB_TOP], 1u);
            const unsigned tg = og / nx;
            if (og + 1u == (tg + 1u) * nx) xb_add(&bar[XB_TOPGEN], 1u);
            else XB_SPIN(xb_ld(&bar[XB_TOPGEN]) == tg, bar);
            __builtin_amdgcn_fence(__ATOMIC_ACQUIRE, "agent");
            xb_add(&bar[XB_XGEN(b.x)], 1u);
            asm volatile("s_waitcnt vmcnt(0)" ::: "memory");
        } else {
            XB_SPIN(xb_ld(&bar[XB_XGEN(b.x)]) == gen, bar);
            __builtin_amdgcn_fence(__ATOMIC_ACQUIRE, "agent");
            asm volatile("s_waitcnt vmcnt(0)" ::: "memory");
        }
    }
    __syncthreads();
}


namespace hg {
constexpr int QS_OFF = 0, QS_RS = 272, KS_OFF = 17408, KS_RS = 288, IS_OFF = 35840, IS_RS = 288, PS_OFF = 54272, PS_RS = 144,
              TOT_OFF = 63488, RSC_OFF = 67584, DSC_OFF = 68096, RED_OFF = 68608;
typedef short s16x4 __attribute__((ext_vector_type(4)));
#define HG_MFMA(a, b, c) __builtin_amdgcn_mfma_f32_16x16x32_bf16((a), (b), (c), 0, 0, 0)
__device__ __forceinline__ bf16x8 rowfrag(const LAS unsigned char* img, int rs, int row, int step, int g) {
    const LAS s16x4* p = (const LAS s16x4*)(img + row * rs + (32 * step + 4 * g) * 2); const s16x4 lo = p[0], hi = p[4];
    return __builtin_shufflevector(lo, hi, 0, 1, 2, 3, 4, 5, 6, 7);
}
__device__ __forceinline__ bf16x8 trfrag(unsigned img_addr, int rs, int sb, int cb, int c, int g) {
    const unsigned a0 = img_addr + (unsigned)((32 * sb + 4 * g + (c >> 2)) * rs + 32 * cb + 8 * (c & 3)), a1 = a0 + (unsigned)(16 * rs);
    s16x4 lo, hi;
    asm volatile("ds_read_b64_tr_b16 %0, %2\n\tds_read_b64_tr_b16 %1, %3\n\ts_waitcnt lgkmcnt(0)" : "=&v"(lo), "=&v"(hi) : "v"(a0), "v"(a1) : "memory");
    return __builtin_shufflevector(lo, hi, 0, 1, 2, 3, 4, 5, 6, 7);
}
#define HG_TR8(d, a, O0, O1, O2, O3, O4, O5, O6, O7) asm volatile( \
    "ds_read_b64_tr_b16 %0, %8 offset:" #O0 "\n\tds_read_b64_tr_b16 %1, %8 offset:" #O1 "\n\tds_read_b64_tr_b16 %2, %8 offset:" #O2 "\n\tds_read_b64_tr_b16 %3, %8 offset:" #O3 "\n\t" \
    "ds_read_b64_tr_b16 %4, %8 offset:" #O4 "\n\tds_read_b64_tr_b16 %5, %8 offset:" #O5 "\n\tds_read_b64_tr_b16 %6, %8 offset:" #O6 "\n\tds_read_b64_tr_b16 %7, %8 offset:" #O7 "\n\ts_waitcnt lgkmcnt(0)" \
    : "=&v"(d[0]), "=&v"(d[1]), "=&v"(d[2]), "=&v"(d[3]), "=&v"(d[4]), "=&v"(d[5]), "=&v"(d[6]), "=&v"(d[7]) : "v"(a) : "memory")
#define HG_TR4(d, a, O0, O1, O2, O3) asm volatile( \
    "ds_read_b64_tr_b16 %0, %4 offset:" #O0 "\n\tds_read_b64_tr_b16 %1, %4 offset:" #O1 "\n\tds_read_b64_tr_b16 %2, %4 offset:" #O2 "\n\tds_read_b64_tr_b16 %3, %4 offset:" #O3 "\n\ts_waitcnt lgkmcnt(0)" \
    : "=&v"(d[0]), "=&v"(d[1]), "=&v"(d[2]), "=&v"(d[3]) : "v"(a) : "memory")
#define HG_CAT(lo, hi) __builtin_shufflevector((lo), (hi), 0, 1, 2, 3, 4, 5, 6, 7)
__device__ __forceinline__ bf16x8 pack_acc(const f32x4 a, const f32x4 b) {
    u32x4 p; p.x = cvt_pk_bf16(a[0], a[1]); p.y = cvt_pk_bf16(a[2], a[3]); p.z = cvt_pk_bf16(b[0], b[1]); p.w = cvt_pk_bf16(b[2], b[3]);
    return __builtin_bit_cast(bf16x8, p);
}
template <int PASS>
__device__ __forceinline__ void run(LAS unsigned char* lds, const bf16_t* Qb, const bf16_t* Fb, const bf16_t* Ib, const bf16_t* Gb,
                                    const float* onormg, const float* LBv, float* Useg, float* Dlog, bf16_t* OG, int item) {
    const int tid = threadIdx.x, lane = tid & 63, w = __builtin_amdgcn_readfirstlane(tid >> 6), c = lane & 15, g = lane >> 4;
    const int b = item >> 6, h = (item >> 3) & 7, seg = item & 7;
    const size_t row0 = (size_t)b * SEQ + (size_t)seg * 1024;
    const int colh = h * 128;
    const int kp = lane, tg = w;
    const int isr = tid >> 3, ipc = tid & 7;
    const unsigned lds_addr = (unsigned)(size_t)lds;
    f32x4 S[8];
#pragma unroll
    for (int kt = 0; kt < 8; ++kt) S[kt] = (f32x4){0.f, 0.f, 0.f, 0.f};
    if (PASS == 2) {
        for (int j = 0; j < seg; ++j) { const int it = item - seg + j;
#pragma unroll
            for (int kt = 0; kt < 8; ++kt) { const f32x4 dl = *(const f32x4*)(Dlog + (size_t)it * 128 + 16 * kt + 4 * g);
                const f32x4 uu = *((const f32x4*)Useg + ((size_t)(it * 8 + w) * 8 + kt) * 64 + lane);
#pragma unroll
                for (int r = 0; r < 4; ++r) S[kt][r] = __builtin_amdgcn_exp2f(dl[r]) * S[kt][r] + uu[r]; } }
    }
    f32x4 og4 = (f32x4){0.f, 0.f, 0.f, 0.f}; if (PASS == 2) og4 = *(const f32x4*)(onormg + colh + 16 * w + 4 * g);
    float bsum0 = 0.f, bsum1 = 0.f;
    const float lb0 = LBv[colh + 2 * kp], lb1 = LBv[colh + 2 * kp + 1];
    unsigned lfw[8], qw[8]; u32x4 iw0, iw1;
#pragma unroll
    for (int j = 0; j < 8; ++j) { const size_t r = row0 + 8 * tg + j; lfw[j] = *(const unsigned*)(Fb + r * CW + colh + 2 * kp); qw[j] = PASS == 2 ? *(const unsigned*)(Qb + r * CW + colh + 2 * kp) : 0u; }
    { const size_t r = row0 + isr; iw0 = *(const u32x4*)(Ib + r * CW + colh + ipc * 16); iw1 = *(const u32x4*)(Ib + r * CW + colh + ipc * 16 + 8); }
    for (int ch = 0; ch < 16; ++ch) {
        const size_t crow = row0 + (size_t)ch * 64;
        float F0[8], F1[8], B0[8], B1[8], kk0[8], kk1[8], sl0, sl1; { float a0 = 1.f, a1 = 1.f, fv0[8], fv1[8];
#pragma unroll
            for (int j = 0; j < 8; ++j) { const float f0 = lb0 + (1.0f - lb0) * fsigmoid(bflo(lfw[j])), f1 = lb1 + (1.0f - lb1) * fsigmoid(bfhi(lfw[j]));
                fv0[j] = f0; fv1[j] = f1; kk0[j] = 1.0f - f0; kk1[j] = 1.0f - f1; a0 *= f0; a1 *= f1; F0[j] = a0; F1[j] = a1; }
            float c0 = 1.f, c1 = 1.f;
#pragma unroll
            for (int j = 7; j >= 0; --j) { B0[j] = c0; B1[j] = c1; c0 *= fv0[j]; c1 *= fv1[j]; }
            sl0 = __builtin_amdgcn_logf(a0); sl1 = __builtin_amdgcn_logf(a1);
            *(LAS f32x2*)(lds + TOT_OFF + (tg * 128 + 2 * kp) * 4) = (f32x2){sl0, sl1}; }
        u32x2 gw[4];
        if (PASS == 2) {
#pragma unroll
            for (int tt = 0; tt < 4; ++tt) gw[tt] = *(const u32x2*)(Gb + (crow + 16 * tt + c) * CW + colh + 16 * w + 4 * g); }
        __syncthreads();
        { float p0 = 0.f, p1 = 0.f, r0 = 0.f, r1 = 0.f, e0 = 0.f, e1 = 0.f;
#pragma unroll
          for (int t8 = 0; t8 < 8; ++t8) { const f32x2 tv = *(const LAS f32x2*)(lds + TOT_OFF + (t8 * 128 + 2 * kp) * 4);
              if (t8 < tg) { p0 += tv.x; p1 += tv.y; } if (t8 < 4) { r0 += tv.x; r1 += tv.y; } e0 += tv.x; e1 += tv.y; }
          const float sq0 = __builtin_amdgcn_exp2f(p0 - r0), sq1 = __builtin_amdgcn_exp2f(p1 - r1), sk0 = __builtin_amdgcn_exp2f(r0 - p0 - sl0), sk1 = __builtin_amdgcn_exp2f(r1 - p1 - sl1);
#pragma unroll
          for (int j = 0; j < 8; ++j) { const int t = 8 * tg + j;
              *(LAS unsigned*)(lds + KS_OFF + t * KS_RS + kp * 4) = cvt_pk_bf16(kk0[j] * (sk0 * B0[j]), kk1[j] * (sk1 * B1[j]));
              if (PASS == 2) *(LAS unsigned*)(lds + QS_OFF + t * QS_RS + kp * 4) = cvt_pk_bf16(fsilu(bflo(qw[j])) * (sq0 * F0[j]), fsilu(bfhi(qw[j])) * (sq1 * F1[j])); }
          if (tg == 0) { *(LAS f32x2*)(lds + RSC_OFF + kp * 8) = (f32x2){__builtin_amdgcn_exp2f(r0), __builtin_amdgcn_exp2f(r1)};
              *(LAS f32x2*)(lds + DSC_OFF + kp * 8) = (f32x2){__builtin_amdgcn_exp2f(e0 - r0), __builtin_amdgcn_exp2f(e1 - r1)}; bsum0 += e0; bsum1 += e1; }
          *(LAS u32x4*)(lds + IS_OFF + isr * IS_RS + ipc * 32) = iw0; *(LAS u32x4*)(lds + IS_OFF + isr * IS_RS + ipc * 32 + 16) = iw1; }
        { const size_t nrow = row0 + (size_t)(ch < 15 ? ch + 1 : ch) * 64;
#pragma unroll
          for (int j = 0; j < 8; ++j) { const size_t r = nrow + 8 * tg + j; lfw[j] = *(const unsigned*)(Fb + r * CW + colh + 2 * kp); if (PASS == 2) qw[j] = *(const unsigned*)(Qb + r * CW + colh + 2 * kp); }
          const size_t r = nrow + isr; iw0 = *(const u32x4*)(Ib + r * CW + colh + ipc * 16); iw1 = *(const u32x4*)(Ib + r * CW + colh + ipc * 16 + 8); }
        __syncthreads();
        if (PASS == 2) {
            const int st = w >> 1;
            bf16x8 Kf[4];
#pragma unroll
            for (int sp = 0; sp < 4; ++sp) Kf[sp] = rowfrag(lds + KS_OFF, KS_RS, 16 * st + c, sp, g);
#pragma unroll
            for (int i = 0; i < 2; ++i) { const int tt = 2 * (w & 1) + i; f32x4 acc = (f32x4){0.f, 0.f, 0.f, 0.f};
#pragma unroll
                for (int sp = 0; sp < 4; ++sp) acc = HG_MFMA(Kf[sp], rowfrag(lds + QS_OFF, QS_RS, 16 * tt + c, sp, g), acc);
                const int t = 16 * tt + c, s0 = 16 * st + 4 * g;
#pragma unroll
                for (int r = 0; r < 4; ++r) acc[r] = (s0 + r <= t) ? acc[r] : 0.f;
                u32x2 pw; pw.x = cvt_pk_bf16(acc[0], acc[1]); pw.y = cvt_pk_bf16(acc[2], acc[3]);
                *(LAS u32x2*)(lds + PS_OFF + t * PS_RS + s0 * 2) = pw; }
            __syncthreads();
        }
#pragma unroll
        for (int kt = 0; kt < 8; ++kt) { const f32x4 rs = *(const LAS f32x4*)(lds + RSC_OFF + (16 * kt + 4 * g) * 4); S[kt] = S[kt] * rs; }
        bf16x8 If[2];
        { s16x4 d[4]; HG_TR4(d, lds_addr + IS_OFF + (unsigned)((4 * g + (c >> 2)) * IS_RS + 32 * w + 8 * (c & 3)), 0, 4608, 9216, 13824); If[0] = HG_CAT(d[0], d[1]); If[1] = HG_CAT(d[2], d[3]); }
        f32x4 O[4];
        if (PASS == 2) {
            bf16x8 Sp[4];
#pragma unroll
            for (int sp = 0; sp < 4; ++sp) Sp[sp] = pack_acc(S[2 * sp], S[2 * sp + 1]);
#pragma unroll
            for (int tt = 0; tt < 4; ++tt) { f32x4 acc = (f32x4){0.f, 0.f, 0.f, 0.f};
#pragma unroll
                for (int sp = 0; sp < 4; ++sp) acc = HG_MFMA(Sp[sp], rowfrag(lds + QS_OFF, QS_RS, 16 * tt + c, sp, g), acc);
#pragma unroll
                for (int sb = 0; sb < 2; ++sb) if (32 * sb <= 16 * tt + 15) acc = HG_MFMA(If[sb], rowfrag(lds + PS_OFF, PS_RS, 16 * tt + c, sb, g), acc);
                O[tt] = acc; }
        }
        { const unsigned kbase = lds_addr + KS_OFF + (unsigned)((4 * g + (c >> 2)) * KS_RS + 8 * (c & 3));
#pragma unroll
          for (int kt = 0; kt < 8; kt += 2) { s16x4 d[8]; HG_TR8(d, kbase + 32 * kt, 0, 4608, 9216, 13824, 32, 4640, 9248, 13856);
              S[kt] = HG_MFMA(HG_CAT(d[0], d[1]), If[0], S[kt]); S[kt] = HG_MFMA(HG_CAT(d[2], d[3]), If[1], S[kt]);
              S[kt + 1] = HG_MFMA(HG_CAT(d[4], d[5]), If[0], S[kt + 1]); S[kt + 1] = HG_MFMA(HG_CAT(d[6], d[7]), If[1], S[kt + 1]); }
#pragma unroll
          for (int kt = 0; kt < 8; ++kt) { const f32x4 ds = *(const LAS f32x4*)(lds + DSC_OFF + (16 * kt + 4 * g) * 4); S[kt] = S[kt] * ds; } }
        if (PASS == 2) {
#pragma unroll
            for (int tt = 0; tt < 4; ++tt) { float ss = (O[tt][0] * O[tt][0] + O[tt][1] * O[tt][1]) + (O[tt][2] * O[tt][2] + O[tt][3] * O[tt][3]);
                ss += __shfl_xor(ss, 16); ss += __shfl_xor(ss, 32); if (g == 0) *(LAS float*)(lds + RED_OFF + ((16 * tt + c) * 8 + w) * 4) = ss; }
            __syncthreads();
#pragma unroll
            for (int tt = 0; tt < 4; ++tt) { const LAS f32x4* rp = (const LAS f32x4*)(lds + RED_OFF + (16 * tt + c) * 32); const f32x4 ra = rp[0], rb = rp[1];
                const float tot = ((ra[0] + ra[1]) + (ra[2] + ra[3])) + ((rb[0] + rb[1]) + (rb[2] + rb[3]));
                const float rstd = __builtin_amdgcn_rsqf(tot * (1.0f / 128.0f) + EPS);
                const float o0 = O[tt][0] * rstd * og4[0] * fsilu(bflo(gw[tt].x)), o1 = O[tt][1] * rstd * og4[1] * fsilu(bfhi(gw[tt].x)), o2 = O[tt][2] * rstd * og4[2] * fsilu(bflo(gw[tt].y)), o3 = O[tt][3] * rstd * og4[3] * fsilu(bfhi(gw[tt].y));
                u32x2 ow; ow.x = cvt_pk_bf16(o0, o1); ow.y = cvt_pk_bf16(o2, o3);
                *(u32x2*)(OG + (crow + 16 * tt + c) * CW + colh + 16 * w + 4 * g) = ow; }
        }
    }
    if (PASS == 1) {
#pragma unroll
        for (int kt = 0; kt < 8; ++kt) *((f32x4*)Useg + ((size_t)(item * 8 + w) * 8 + kt) * 64 + lane) = S[kt];
        if (tg == 0) *(f32x2*)(Dlog + (size_t)item * 128 + 2 * kp) = (f32x2){bsum0, bsum1};
    }
    __syncthreads();
}
}

struct Args { const float* in[22]; float* out; unsigned char* ws; int ph_lo, ph_hi, li, pad; };
enum { I_X = 0, I_P, I_NORMG, I_WINAB, I_ALNG, I_ALNB, I_AWS, I_ABS, I_BCONV, I_WOUTAB, I_FFNGU, I_FFNDN, I_WINC, I_LBP, I_ONORMG, I_WOUTC, I_WROUTER, I_BROUTER, I_EGU, I_EDN, I_PPROJ, I_PGATE };

template <bool F8> __device__ __forceinline__ void transpose_item(const float* W, int K, int N, void* WTv, const float* gain, int gu_ff, float scale, LAS float* scr, int item, int lane) {
    const int nblk = N / 32, kb = item / nblk, nb = item % nblk, k0 = 64 * kb, n0 = 32 * nb;
#pragma unroll 8
    for (int i = 0; i < 32; ++i) { const int kk = 2 * i + (lane >> 5); float w = W[(size_t)(k0 + kk) * N + n0 + (lane & 31)]; if (gain) w *= gain[k0 + kk]; if (F8) w *= scale; scr[kk * 33 + (lane & 31)] = w; }
    asm volatile("s_waitcnt lgkmcnt(0)" ::: "memory");
    int d0 = n0; if (gu_ff) { const int half = n0 >= gu_ff ? 1 : 0, j = n0 - half * gu_ff; d0 = (j / 128) * 256 + half * 128 + (j % 128); }
    const int c = lane & 7;
#pragma unroll
    for (int j = 0; j < 4; ++j) { const int n = (lane >> 3) + 8 * j; const LAS float* s = scr + (8 * c) * 33 + n;
        if (F8) { u32x2 o; o.x = pk4_fp8(s[0 * 33], s[1 * 33], s[2 * 33], s[3 * 33]); o.y = pk4_fp8(s[4 * 33], s[5 * 33], s[6 * 33], s[7 * 33]);
            *(u32x2*)((unsigned char*)WTv + (size_t)(d0 + n) * K + k0 + 8 * c) = o; }
        else { u32x4 o; o.x = cvt_pk_bf16(s[0 * 33], s[1 * 33]); o.y = cvt_pk_bf16(s[2 * 33], s[3 * 33]); o.z = cvt_pk_bf16(s[4 * 33], s[5 * 33]); o.w = cvt_pk_bf16(s[6 * 33], s[7 * 33]);
            *(u32x4*)((bf16_t*)WTv + (size_t)(d0 + n) * K + k0 + 8 * c) = o; } }
    asm volatile("s_waitcnt lgkmcnt(0)" ::: "memory");
}

__device__ __forceinline__ void ld_row_bf16(const bf16_t* row, int lane, float (&v)[16]) { unpack8(*(const u32x4*)(row + lane * 8), v); unpack8(*(const u32x4*)(row + 512 + lane * 8), v + 8); }
__device__ __forceinline__ void st_row_bf16(bf16_t* row, int lane, const float (&v)[16]) { *(u32x4*)(row + lane * 8) = pack8(v); *(u32x4*)(row + 512 + lane * 8) = pack8(v + 8); }
__device__ __forceinline__ void ld_row_f32(const float* row, int lane, float (&v)[16]) {
    const f32x4 a = *(const f32x4*)(row + lane * 8), b = *(const f32x4*)(row + lane * 8 + 4), c = *(const f32x4*)(row + 512 + lane * 8), d = *(const f32x4*)(row + 512 + lane * 8 + 4);
#pragma unroll
    for (int j = 0; j < 4; ++j) { v[j] = a[j]; v[4 + j] = b[j]; v[8 + j] = c[j]; v[12 + j] = d[j]; }
}
__device__ __forceinline__ float sumsq16(const float (&v)[16]) { float s = 0.f;
#pragma unroll
    for (int j = 0; j < 16; ++j) s += v[j] * v[j];
    return s; }


template <int NSRC, bool WRITE_RSTD, bool WRITE_F8 = false>
__device__ __forceinline__ void thin_resid(const bf16_t* mix0, const bf16_t* mix1, const bf16_t* xin, bf16_t* xout, float* rstd_out, const float* gain, int m0, int nrows, int lane, unsigned char* x8out = nullptr) {
    float g[16]; ld_row_f32(gain, lane, g);
    for (int i0 = 0; i0 < nrows; i0 += 4) {
        float mx[4][16], x[4][16];
#pragma unroll
        for (int r = 0; r < 4; ++r) { const size_t m = (size_t)(m0 + i0 + r); ld_row_bf16(mix0 + m * D, lane, mx[r]); ld_row_bf16(xin + m * D, lane, x[r]);
            if (NSRC == 2) { float m2[16]; ld_row_bf16(mix1 + m * D, lane, m2);
#pragma unroll
                for (int j = 0; j < 16; ++j) mx[r][j] += m2[j]; } }
#pragma unroll
        for (int r = 0; r < 4; ++r) { const size_t m = (size_t)(m0 + i0 + r);
            const float rm = __builtin_amdgcn_rsqf(wave_sum(sumsq16(mx[r])) * (1.0f / D) + EPS);
#pragma unroll
            for (int j = 0; j < 16; ++j) x[r][j] += g[j] * mx[r][j] * rm;
            st_row_bf16(xout + m * D, lane, x[r]);
            if (WRITE_F8) { unsigned char* x8 = x8out + m * D; *(u32x2*)(x8 + lane * 8) = pack8_fp8(x[r]); *(u32x2*)(x8 + 512 + lane * 8) = pack8_fp8(x[r] + 8); }
            if (WRITE_RSTD) { const float ss = wave_sum(sumsq16(x[r])); if (lane == 0) rstd_out[m] = __builtin_amdgcn_rsqf(ss * (1.0f / D) + EPS); } }
    }
}

__global__ void __launch_bounds__(NTHR, 2) trunk_fwd(Args args) {
    extern __shared__ __attribute__((aligned(16))) unsigned char lds_raw[];
    LAS unsigned char* lds = (LAS unsigned char*)lds_raw;
    volatile LAS unsigned* MISC = (volatile LAS unsigned*)(lds + MISC_OFF);
    const int tid = threadIdx.x;
    const int G = gridDim.x, bx = blockIdx.x;
    unsigned char* ws = args.ws;
    for (int u = tid; u < (LDS_BYTES - LDSCTL_OFF) / 4; u += NTHR) ((LAS unsigned*)(lds + LDSCTL_OFF))[u] = 0u;
    __syncthreads();
    XcdBarrier bar; bar.bar = (unsigned*)(ws + WS_CTL) + CW_BAR; bar.x = 0; bar.st = nullptr;
    if (MK_N_LAUNCHES == 1) bar = xcd_barrier_post((unsigned*)(ws + WS_CTL) + CW_BAR, MISC + 8);
    const int lo = args.ph_lo, hi = args.ph_hi;
#define IN(k) (lo <= (k) && (k) < hi)
#define SEAM(k) do { if (IN(k) && IN((k) + 1)) xcd_barrier(bar); } while (0)

    const float* normg = args.in[I_NORMG];
    float* rstd0 = (float*)(ws + SM_RSTD0); float* rstd1 = (float*)(ws + SM_RSTD1); float* rstd4 = (float*)(ws + SM_RSTD4);
    float* LB = (float*)(ws + SM_LB); int* route = (int*)(ws + SM_ROUTE); int* cntg = (int*)(ws + SM_CNT); int* meta = (int*)(ws + SM_META);
    int* perm = (int*)(ws + SM_PERM); int* rinfo = (int*)(ws + SM_RINFO); float* ssp = (float*)(ws + SM_SSP);
    bf16_t* XA = (bf16_t*)(ws + WS_XA); bf16_t* XB = (bf16_t*)(ws + WS_XB); bf16_t* PB = (bf16_t*)(ws + WS_PB);
    unsigned char* R = ws + WS_R;
    const int NGW = G * NWAVES;
    const int RPW = M / G;

    if (IN(0)) for (int rep_ = 0; rep_ < NREP(0); ++rep_) { const int lane = get_lane(), wave = get_wave(); const int gw = bx * NWAVES + wave; (void)gw; (void)lane;
        LAS float* scr = (LAS float*)(lds + wave * 16384);
        constexpr int I1 = 16 * 80, I2 = 16 * 32, I3 = 16 * 176, I4 = 44 * 32, I5 = 16 * 128, I6 = 16 * 32, I7E = 16 * 224, I8E = 56 * 32, I9L = 4 * 32, I10L = 16 * 32;
        constexpr int NITEMS = I1 + I2 + I3 + I4 + I5 + I6 + 8 * I7E + 8 * I8E + 2 * I9L + 2 * I10L;
        for (int it = gw; it < NITEMS; it += NGW) {
            int r = it;
            if (r < I1) { transpose_item<false>(args.in[I_WINAB], D, AB_IN, (bf16_t*)(ws + W_INAB), normg + 0 * D, 0, 1.0f, scr, r, lane); continue; } r -= I1;
            if (r < I2) { transpose_item<false>(args.in[I_WOUTAB], D, D, (bf16_t*)(ws + W_OUTAB), nullptr, 0, 1.0f, scr, r, lane); continue; } r -= I2;
            if (r < I3) { transpose_item<false>(args.in[I_FFNGU], D, 2 * FF, (bf16_t*)(ws + W_GU0), normg + 2 * D, FF, 1.0f, scr, r, lane); continue; } r -= I3;
            if (r < I4) { transpose_item<false>(args.in[I_FFNDN], FF, D, (bf16_t*)(ws + W_DN0), nullptr, 0, 1.0f, scr, r, lane); continue; } r -= I4;
            if (r < I5) { transpose_item<false>(args.in[I_WINC], D, 4 * CW, (bf16_t*)(ws + W_INC), normg + 4 * D, 0, 1.0f, scr, r, lane); continue; } r -= I5;
            if (r < I6) { transpose_item<false>(args.in[I_WOUTC], CW, D, (bf16_t*)(ws + W_OUTC), nullptr, 0, 1.0f, scr, r, lane); continue; } r -= I6;
            if (r < 8 * I7E) { const int e = r / I7E; transpose_item<true>(args.in[I_EGU] + (size_t)e * D * 2 * EFF, D, 2 * EFF, ws + W_EGU8 + (size_t)e * 2 * EFF * D, normg + 6 * D, EFF, SC_GU, scr, r % I7E, lane); continue; } r -= 8 * I7E;
            if (r < 8 * I8E) { const int e = r / I8E; transpose_item<true>(args.in[I_EDN] + (size_t)e * EFF * D, EFF, D, ws + W_EDN8 + (size_t)e * D * EFF, nullptr, 0, SC_DN, scr, r % I8E, lane); continue; } r -= 8 * I8E;
            if (r < 2 * I9L) { const int l = r / I9L; transpose_item<false>(args.in[I_PPROJ] + (size_t)l * PLE * D, PLE, D, (bf16_t*)(ws + W_PPROJ) + (size_t)l * D * PLE, nullptr, 0, 1.0f, scr, r % I9L, lane); continue; } r -= 2 * I9L;
            { const int l = r / I10L; if (l == 0) transpose_item<false>(args.in[I_PGATE], D, D, (bf16_t*)(ws + W_PGATE), nullptr, 0, 1.0f, scr, r % I10L, lane);
              else transpose_item<true>(args.in[I_PGATE] + (size_t)D * D, D, D, ws + W_PG8, nullptr, 0, SC_PG, scr, r % I10L, lane); }
        }
        for (int m = gw; m < M; m += NGW) { float v[16]; ld_row_f32(args.in[I_X] + (size_t)m * D, lane, v);
            const float ss = wave_sum(sumsq16(v)); st_row_bf16(XA + (size_t)m * D, lane, v); if (lane == 0) rstd0[m] = __builtin_amdgcn_rsqf(ss * (1.0f / D) + EPS); }
        { const float* p = args.in[I_P]; const size_t n8 = (size_t)2 * M * PLE / 8;
          for (size_t i = (size_t)bx * NTHR + tid; i < n8; i += (size_t)G * NTHR) { const f32x4 a = *(const f32x4*)(p + i * 8), b = *(const f32x4*)(p + i * 8 + 4);
              float v[8] = {a[0], a[1], a[2], a[3], b[0], b[1], b[2], b[3]}; *(u32x4*)(PB + i * 8) = pack8(v); } }
        { bf16_t* W16 = (bf16_t*)(ws + SM_W16); for (int e = bx * NTHR + tid; e < 8 * 128 * 128; e += G * NTHR) W16[e] = f2bf(args.in[I_AWS][e]); }
        if (bx == 0) for (int c = tid; c < CW; c += NTHR) { const float d = args.in[I_LBP][CW + c] - args.in[I_LBP][c]; LB[c] = 1.0f / (1.0f + expf(-d)); }
    }
    SEAM(0);

    if (IN(1)) for (int rep_ = 0; rep_ < NREP(1); ++rep_) { pg8::StaticOrder S; S.init(XA, (const bf16_t*)(ws + W_INAB), M, AB_IN, D, G, bx); pg8::EpiInAB E{(bf16_t*)(R + R_Z), rstd0};
        pg8::gemm_phase<pg8::EpiInAB, pg8::StaticOrder, false>(lds, 2 * D, S, E); }
    SEAM(1);

    if (IN(2)) for (int rep_ = 0; rep_ < NREP(2); ++rep_) { const int lane = get_lane(), wave = get_wave();
        const bf16_t* Z = (const bf16_t*)(R + R_Z); bf16_t* Y = (bf16_t*)(R + R_Y); const bf16_t* W16 = (const bf16_t*)(ws + SM_W16);
        constexpr int IRS = 544;
        const unsigned lds_addr = (unsigned)(size_t)lds; const int c = lane & 15, g = lane >> 4;
        for (int blk = bx; blk < M / 128; blk += G) {
            const int t0 = blk * 128;
            for (int hg2 = 0; hg2 < 2; ++hg2) {
                { const int row = tid >> 2, dq = tid & 3;
#pragma unroll 1
                  for (int hh = 0; hh < 4; ++hh) { const int h = hg2 * 4 + hh; const bf16_t* vp = Z + (size_t)(t0 + row) * AB_IN + 512 + h * 64 + dq * 16; float v[16];
                      unpack8(*(const u32x4*)vp, v); unpack8(*(const u32x4*)(vp + 8), v + 8);
                      float sm = 0.f;
#pragma unroll
                      for (int j = 0; j < 16; ++j) sm += v[j];
                      sm += __shfl_xor(sm, 1); sm += __shfl_xor(sm, 2); const float mu = sm * (1.0f / 64.0f); float q = 0.f;
#pragma unroll
                      for (int j = 0; j < 16; ++j) { v[j] -= mu; q += v[j] * v[j]; }
                      q += __shfl_xor(q, 1); q += __shfl_xor(q, 2); const float rs = __builtin_amdgcn_rsqf(q * (1.0f / 64.0f) + EPS);
                      const float* lg = args.in[I_ALNG] + h * 64 + dq * 16; const float* lb = args.in[I_ALNB] + h * 64 + dq * 16;
#pragma unroll
                      for (int j4 = 0; j4 < 4; ++j4) { const f32x4 gg = *(const f32x4*)(lg + 4 * j4), bb = *(const f32x4*)(lb + 4 * j4);
#pragma unroll
                          for (int j = 0; j < 4; ++j) v[4 * j4 + j] = v[4 * j4 + j] * rs * gg[j] + bb[j]; }
                      LAS unsigned char* ip = lds + row * IRS + (hh * 64 + dq * 16) * 2; *(LAS u32x4*)ip = pack8(v); *(LAS u32x4*)(ip + 16) = pack8(v + 8); } }
                __syncthreads();
                { const int nks = wave < 4 ? 2 : 4; const int i = 16 * wave + c;
#pragma unroll 1
                  for (int hh = 0; hh < 4; ++hh) { const int h = hg2 * 4 + hh; const bf16_t* wrow = W16 + ((size_t)h * 128 + i) * 128 + 4 * g; bf16x8 Bf[4];
#pragma unroll
                      for (int ks = 0; ks < 4; ++ks) { if (ks < nks) { const hg::s16x4 lo = *(const hg::s16x4*)(wrow + 32 * ks), hi = *(const hg::s16x4*)(wrow + 32 * ks + 16); Bf[ks] = __builtin_shufflevector(lo, hi, 0, 1, 2, 3, 4, 5, 6, 7); } else Bf[ks] = Bf[0]; }
                      const float bsv = args.in[I_ABS][h * 128 + i];
#pragma unroll
                      for (int dt = 0; dt < 4; ++dt) { f32x4 acc = (f32x4){0.f, 0.f, 0.f, 0.f};
                          { const unsigned ib = lds_addr + (unsigned)((4 * g + (c >> 2)) * IRS + 32 * (hh * 4 + dt) + 8 * (c & 3)); hg::s16x4 d[8];
                            if (nks == 4) { HG_TR8(d, ib, 0, 8704, 17408, 26112, 34816, 43520, 52224, 60928);
#pragma unroll
                                for (int ks = 0; ks < 4; ++ks) acc = HG_MFMA(HG_CAT(d[2 * ks], d[2 * ks + 1]), Bf[ks], acc); }
                            else { HG_TR4(d, ib, 0, 8704, 17408, 26112); acc = HG_MFMA(HG_CAT(d[0], d[1]), Bf[0], acc); acc = HG_MFMA(HG_CAT(d[2], d[3]), Bf[1], acc); } }
                          const int col = h * 64 + 16 * dt + 4 * g; const u32x2 uw = *(const u32x2*)(Z + (size_t)(t0 + i) * AB_IN + col);
                          u32x2 yw; yw.x = cvt_pk_bf16(bflo(uw.x) * (acc[0] + bsv), bfhi(uw.x) * (acc[1] + bsv)); yw.y = cvt_pk_bf16(bflo(uw.y) * (acc[2] + bsv), bfhi(uw.y) * (acc[3] + bsv));
                          *(u32x2*)(Y + (size_t)(t0 + i) * D + col) = yw; } } }
                __syncthreads();
            }
            { const int cg8 = lane * 8, r0 = t0 + 16 * wave; float w0[8], w1[8], w2[8], p2[8], p1[8];
              { const float* bc = args.in[I_BCONV];
#pragma unroll
                for (int j4 = 0; j4 < 2; ++j4) { const f32x4 a = *(const f32x4*)(bc + cg8 + 4 * j4), b = *(const f32x4*)(bc + 512 + cg8 + 4 * j4), cc = *(const f32x4*)(bc + 1024 + cg8 + 4 * j4);
#pragma unroll
                    for (int j = 0; j < 4; ++j) { w0[4 * j4 + j] = a[j]; w1[4 * j4 + j] = b[j]; w2[4 * j4 + j] = cc[j]; } } }
              if ((r0 % SEQ) != 0) { float xa[8], ca[8], xb2[8], cb2[8];
                  unpack8(*(const u32x4*)(Z + (size_t)(r0 - 2) * AB_IN + 1024 + cg8), xa); unpack8(*(const u32x4*)(Z + (size_t)(r0 - 2) * AB_IN + 1536 + cg8), ca);
                  unpack8(*(const u32x4*)(Z + (size_t)(r0 - 1) * AB_IN + 1024 + cg8), xb2); unpack8(*(const u32x4*)(Z + (size_t)(r0 - 1) * AB_IN + 1536 + cg8), cb2);
#pragma unroll
                  for (int j = 0; j < 8; ++j) { p2[j] = xa[j] * ca[j]; p1[j] = xb2[j] * cb2[j]; } }
              else {
#pragma unroll
                  for (int j = 0; j < 8; ++j) { p2[j] = 0.f; p1[j] = 0.f; } }
              for (int tb = 0; tb < 16; tb += 8) { u32x4 xw[8], cw[8], bw[8];
#pragma unroll
                  for (int t = 0; t < 8; ++t) { const bf16_t* z = Z + (size_t)(r0 + tb + t) * AB_IN + cg8; xw[t] = *(const u32x4*)(z + 1024); cw[t] = *(const u32x4*)(z + 1536); bw[t] = *(const u32x4*)(z + 2048); }
#pragma unroll
                  for (int t = 0; t < 8; ++t) { float xv[8], cv[8], bv[8], o[8]; unpack8(xw[t], xv); unpack8(cw[t], cv); unpack8(bw[t], bv);
#pragma unroll
                      for (int j = 0; j < 8; ++j) { const float p0 = xv[j] * cv[j]; o[j] = bv[j] * (w0[j] * p2[j] + w1[j] * p1[j] + w2[j] * p0); p2[j] = p1[j]; p1[j] = p0; }
                      *(u32x4*)(Y + (size_t)(r0 + tb + t) * D + 512 + cg8) = pack8(o); } } }
        }
    }
    SEAM(2);

    if (IN(3)) for (int rep_ = 0; rep_ < NREP(3); ++rep_) { pg8::StaticOrder S; S.init((const bf16_t*)(R + R_Y), (const bf16_t*)(ws + W_OUTAB), M, D, D, G, bx); pg8::EpiPlain E{(bf16_t*)(R + R_MIX), D};
        pg8::gemm_phase<pg8::EpiPlain, pg8::StaticOrder, false>(lds, 2 * D, S, E); }
    SEAM(3);

    if (IN(4)) for (int rep_ = 0; rep_ < NREP(4); ++rep_) { const int lane = get_lane(), wave = get_wave(); const int gw = bx * NWAVES + wave; (void)gw; (void)lane;
        thin_resid<1, true>((const bf16_t*)(R + R_MIX), nullptr, XA, XB, rstd1, normg + 1 * D, bx * RPW + wave * (RPW / NWAVES), RPW / NWAVES, lane); }
    SEAM(4);

    if (IN(5)) for (int rep_ = 0; rep_ < NREP(5); ++rep_) { pg8::StaticOrder S; S.init(XB, (const bf16_t*)(ws + W_GU0), M, 2 * FF, D, G, bx); pg8::EpiSwiGLU<false> E{(bf16_t*)(R + R_HF), FF, rstd1, nullptr};
        pg8::gemm_phase<pg8::EpiSwiGLU<false>, pg8::StaticOrder, false>(lds, 2 * D, S, E); }
    SEAM(5);

    if (IN(6)) for (int rep_ = 0; rep_ < NREP(6); ++rep_) { pg8::StaticOrder S; S.init((const bf16_t*)(R + R_HF), (const bf16_t*)(ws + W_DN0), M, D, FF, G, bx); pg8::EpiPlain E{(bf16_t*)(R + R_MIX), D};
        pg8::gemm_phase<pg8::EpiPlain, pg8::StaticOrder, false>(lds, 2 * FF, S, E); }
    SEAM(6);

    if (IN(7)) for (int rep_ = 0; rep_ < NREP(7); ++rep_) { const int lane = get_lane(), wave = get_wave(); const int gw = bx * NWAVES + wave; (void)gw; (void)lane;
        thin_resid<1, false>((const bf16_t*)(R + R_MIX), nullptr, XB, XA, nullptr, normg + 3 * D, bx * RPW + wave * (RPW / NWAVES), RPW / NWAVES, lane); }
    SEAM(7);

    if (IN(8)) for (int rep_ = 0; rep_ < NREP(8); ++rep_) { pg8::StaticOrder S; S.init(PB, (const bf16_t*)(ws + W_PPROJ), M, D, PLE, G, bx); pg8::EpiPlain E{(bf16_t*)(R + R_PP), D};
        pg8::gemm_phase<pg8::EpiPlain, pg8::StaticOrder, false>(lds, 2 * PLE, S, E); }

    if (IN(9)) for (int rep_ = 0; rep_ < NREP(9); ++rep_) { pg8::StaticOrder S; S.init(XA, (const bf16_t*)(ws + W_PGATE), M, D, D, G, bx); pg8::EpiPleGate<false> E{XA, (const bf16_t*)(R + R_PP), XB, ssp, nullptr, (LAS float*)(lds + pg8::PERMBUF_OFF + 2048), 1.0f};
        pg8::gemm_phase<pg8::EpiPleGate<false>, pg8::StaticOrder, false>(lds, 2 * D, S, E); }
    SEAM(9);

    if (IN(10)) for (int rep_ = 0; rep_ < NREP(10); ++rep_) { pg8::StaticOrder S; S.init(XB, (const bf16_t*)(ws + W_INC), M, 4 * CW, D, G, bx); pg8::EpiInC E{(bf16_t*)(R + R_QFIG), ssp};
        pg8::gemm_phase<pg8::EpiInC, pg8::StaticOrder, false>(lds, 2 * D, S, E); }
    SEAM(10);

    if (IN(11)) for (int rep_ = 0; rep_ < NREP(11); ++rep_) {
        const bf16_t* Qb = (const bf16_t*)(R + R_QFIG); const bf16_t* Fb = Qb + (size_t)M * CW; const bf16_t* Ib = Fb + (size_t)M * CW; const bf16_t* Gb = Ib + (size_t)M * CW;
        for (int item = bx; item < BATCH * 8 * 8; item += G) { if ((item & 7) == 7) continue;
            hg::run<1>(lds, Qb, Fb, Ib, Gb, args.in[I_ONORMG], LB, (float*)(R + R_O), (float*)(ws + SM_DLOG), (bf16_t*)(R + R_OG), item); }
    }
    SEAM(11);

    if (IN(12)) for (int rep_ = 0; rep_ < NREP(12); ++rep_) {
        const bf16_t* Qb = (const bf16_t*)(R + R_QFIG); const bf16_t* Fb = Qb + (size_t)M * CW; const bf16_t* Ib = Fb + (size_t)M * CW; const bf16_t* Gb = Ib + (size_t)M * CW;
        for (int item = bx; item < BATCH * 8 * 8; item += G)
            hg::run<2>(lds, Qb, Fb, Ib, Gb, args.in[I_ONORMG], LB, (float*)(R + R_O), (float*)(ws + SM_DLOG), (bf16_t*)(R + R_OG), item);
    }
    SEAM(12);

    if (IN(13)) for (int rep_ = 0; rep_ < NREP(13); ++rep_) { pg8::StaticOrder S; S.init((const bf16_t*)(R + R_OG), (const bf16_t*)(ws + W_OUTC), M, D, CW, G, bx); pg8::EpiPlain E{(bf16_t*)(R + R_MIX1), D};
        pg8::gemm_phase<pg8::EpiPlain, pg8::StaticOrder, false>(lds, 2 * CW, S, E); }
    SEAM(13);

    if (IN(14)) for (int rep_ = 0; rep_ < NREP(14); ++rep_) { const int lane = get_lane(), wave = get_wave(); const int gw = bx * NWAVES + wave; (void)gw; (void)lane; const bf16_t* MIX = (const bf16_t*)(R + R_MIX1); float g[16], g2[16]; ld_row_f32(normg + 5 * D, lane, g); ld_row_f32(normg + 6 * D, lane, g2);
        LAS float* wrl = (LAS float*)lds;
        LAS int* lcnt = (LAS int*)(lds + 32768);
        for (int e = tid; e < D * NE; e += NTHR) wrl[(e & 7) * D + (e >> 3)] = args.in[I_WROUTER][e];
        if (tid < NE) lcnt[tid] = 0;
        __syncthreads();
        for (int i0 = 0; i0 < RPW / NWAVES; i0 += 2) { float mx2[2][16], x2[2][16];
#pragma unroll
          for (int r2 = 0; r2 < 2; ++r2) { const int m = bx * RPW + wave * (RPW / NWAVES) + i0 + r2; ld_row_bf16(MIX + (size_t)m * D, lane, mx2[r2]); ld_row_bf16(XB + (size_t)m * D, lane, x2[r2]); }
#pragma unroll
          for (int r2 = 0; r2 < 2; ++r2) { const int m = bx * RPW + wave * (RPW / NWAVES) + i0 + r2; float (&mx)[16] = mx2[r2]; float (&x)[16] = x2[r2];
            const float rm = __builtin_amdgcn_rsqf(wave_sum(sumsq16(mx)) * (1.0f / D) + EPS);
#pragma unroll
            for (int j = 0; j < 16; ++j) x[j] += g[j] * mx[j] * rm;
            const float rs = __builtin_amdgcn_rsqf(wave_sum(sumsq16(x)) * (1.0f / D) + EPS);
            st_row_bf16(XA + (size_t)m * D, lane, x); if (lane == 0) rstd4[m] = rs;
            { float xn[16];
#pragma unroll
              for (int j = 0; j < 16; ++j) xn[j] = x[j] * rs;
              unsigned char* x8 = ws + WS_X8 + (size_t)m * D; *(u32x2*)(x8 + lane * 8) = pack8_fp8(xn); *(u32x2*)(x8 + 512 + lane * 8) = pack8_fp8(xn + 8); }
            float lg[NE];
#pragma unroll
            for (int e = 0; e < NE; ++e) lg[e] = 0.f;
            { float hn[16];
#pragma unroll
              for (int j = 0; j < 16; ++j) hn[j] = x[j] * rs * g2[j];
#pragma unroll
              for (int e = 0; e < NE; ++e) { const LAS f32x4* wp0 = (const LAS f32x4*)(wrl + e * D + lane * 8); const LAS f32x4* wp1 = (const LAS f32x4*)(wrl + e * D + 512 + lane * 8);
                  const f32x4 a0 = wp0[0], a1 = wp0[1], c0 = wp1[0], c1 = wp1[1];
#pragma unroll
                  for (int j = 0; j < 4; ++j) lg[e] += hn[j] * a0[j] + hn[4 + j] * a1[j] + hn[8 + j] * c0[j] + hn[12 + j] * c1[j]; } }
#pragma unroll
            for (int e = 0; e < NE; ++e) lg[e] = wave_sum(lg[e]) + args.in[I_BROUTER][e];
            if (lane == 0) { int e1 = 0; float l1 = lg[0];
#pragma unroll
                for (int e = 1; e < NE; ++e) if (lg[e] > l1) { l1 = lg[e]; e1 = e; }
                int e2 = -1; float l2 = -3.0e38f;
#pragma unroll
                for (int e = 0; e < NE; ++e) if (e != e1 && lg[e] > l2) { l2 = lg[e]; e2 = e; }
                const float ex = expf(l2 - l1), w1 = 1.0f / (1.0f + ex), w2 = ex / (1.0f + ex);
                *(i32x4*)(route + (size_t)m * 4) = (i32x4){e1, e2, __float_as_int(w1), __float_as_int(w2)};
                atomicAdd((int*)(lcnt + e1), 1); atomicAdd((int*)(lcnt + e2), 1); } } }
        __syncthreads();
        if (tid < NE) cntg[bx * NE + tid] = lcnt[tid];
    }
    SEAM(14);

    if (IN(15)) for (int rep_ = 0; rep_ < NREP(15); ++rep_) { const int lane = get_lane(), wave = get_wave(); const int gw = bx * NWAVES + wave; (void)gw; (void)lane;
        LAS int* lc = (LAS int*)lds;
        LAS int* tot = (LAS int*)(lds + 32768);
        for (int e = tid; e < G * NE; e += NTHR) lc[e] = cntg[e];
        __syncthreads();
        if (tid < NE) { int t = 0, pre = 0; for (int w = 0; w < G; ++w) { if (w == bx) pre = t; t += lc[w * NE + tid]; } tot[tid] = t; tot[8 + tid] = pre; }
        __syncthreads();
        if (tid == 0) { int b = 0; for (int e = 0; e < NE; ++e) { tot[16 + e] = b; b += (tot[e] + 255) & ~255; } tot[24] = b; }
        __syncthreads();
        if (wave == 0) { int run[NE];
#pragma unroll
            for (int e = 0; e < NE; ++e) run[e] = 0;
            for (int it = 0; it < RPW / 64; ++it) { const int m = bx * RPW + it * 64 + lane; const i32x4 rt = *(const i32x4*)(route + (size_t)m * 4);
                const unsigned long long lt = (1ull << lane) - 1ull;
#pragma unroll
                for (int e = 0; e < NE; ++e) { const bool has = (rt[0] == e) || (rt[1] == e); const unsigned long long mask = __ballot(has);
                    if (has) { const int pos = tot[16 + e] + tot[8 + e] + run[e] + __popcll(mask & lt); const int slot = (rt[1] == e) ? 1 : 0;
                        perm[pos] = m; rinfo[2 * pos] = m * 2 + slot; rinfo[2 * pos + 1] = slot ? rt[3] : rt[2]; }
                    run[e] += __popcll(mask); } } }
        if (bx < NE) { const int e = bx; const int beg = tot[16 + e] + tot[e], end = tot[16 + e] + ((tot[e] + 255) & ~255);
            for (int p = beg + tid; p < end; p += NTHR) { perm[p] = 0; rinfo[2 * p] = -1; rinfo[2 * p + 1] = 0; } }
        if (bx == 0) { if (tid == 0) meta[0] = tot[24] / 256; if (tid < NE) meta[1 + tid] = tot[16 + tid];
            for (int p = tid; p < tot[24] / 256; p += NTHR) { int e = 0;
#pragma unroll
                for (int k = 1; k < NE; ++k) if (p * 256 >= tot[16 + k]) e = k;
                meta[16 + p] = e; } }
        __syncthreads();
    }
    SEAM(15);

    if (IN(16)) for (int rep_ = 0; rep_ < NREP(16); ++rep_) {
        pg8::MoeOrder<true> S; S.init(ws + WS_X8, ws + W_EGU8, meta, 2 * EFF, D, G, bx, perm); pg8::EpiSwiGLU8 E{R + R_H, EFF};
        pg8::gemm_phase<pg8::EpiSwiGLU8, pg8::MoeOrder<true>, true, true>(lds, D, S, E); }
    SEAM(16);

    if (IN(17)) for (int rep_ = 0; rep_ < NREP(17); ++rep_) {
        pg8::MoeOrder<false> S; S.init(R + R_H, ws + W_EDN8, meta, D, EFF, G, bx, perm); pg8::EpiMoeDown E{rinfo, (bf16_t*)args.out};
        pg8::gemm_phase<pg8::EpiMoeDown, pg8::MoeOrder<false>, false, true>(lds, EFF, S, E); }
    if (IN(17)) {
        asm volatile("" ::: "memory");
        { const int nwg17 = __builtin_amdgcn_readfirstlane(meta[0]) * (D / 256), nlong = nwg17 % G; const int rho = nlong == 0 ? bx : bx - nlong;
          pg8::TailOrder T; T.init(PB + (size_t)M * PLE, (const bf16_t*)(ws + W_PPROJ) + (size_t)D * PLE, M, D, PLE, G - nlong, rho); pg8::EpiPlain E2{(bf16_t*)(R + R_PP1), D};
          pg8::gemm_phase<pg8::EpiPlain, pg8::TailOrder, false>(lds, 2 * PLE, T, E2); } }
    SEAM(17);

    if (IN(18)) for (int rep_ = 0; rep_ < NREP(18); ++rep_) { const int lane = get_lane(), wave = get_wave(); const int gw = bx * NWAVES + wave; (void)gw; (void)lane;
        thin_resid<2, false, true>((const bf16_t*)args.out, (const bf16_t*)args.out + (size_t)M * D, XA, XB, nullptr, normg + 7 * D, bx * RPW + wave * (RPW / NWAVES), RPW / NWAVES, lane, ws + WS_X8); }
    SEAM(18);


    if (IN(20)) for (int rep_ = 0; rep_ < NREP(20); ++rep_) { pg8::StaticOrder S; S.init_bytes(ws + WS_X8, ws + W_PG8, M, D, D, G, bx);
        pg8::EpiPleGate<true> E{XB, (const bf16_t*)(R + R_PP1), nullptr, nullptr, args.out, nullptr, 1.0f / SC_PG};
        pg8::gemm_phase<pg8::EpiPleGate<true>, pg8::StaticOrder, false, true>(lds, D, S, E); }
#undef IN
#undef SEAM
}

constexpr int N_PHASES = 21;
extern "C" void kernel_launch(void* const* d_in, const int* in_sizes, int n_in, void* d_out, int out_size, void* d_ws, size_t ws_size, hipStream_t stream) {
    static int grid = 0;
    if (grid == 0) {
        if (n_in != 22 || in_sizes[0] != M * D || out_size != M * D || ws_size < WS_END) { fprintf(stderr, "kernel_launch: unexpected shapes (n_in %d, in0 %d, out %d, ws %zu < %zu); nothing launched\n", n_in, n_in > 0 ? in_sizes[0] : -1, out_size, ws_size, (size_t)WS_END); grid = -1; return; }
        int dev = 0, cus = 0, per_cu = 0;
        if (hipGetDevice(&dev) != hipSuccess || hipDeviceGetAttribute(&cus, hipDeviceAttributeMultiprocessorCount, dev) != hipSuccess) { grid = -1; return; }
        if (hipFuncSetAttribute((const void*)trunk_fwd, hipFuncAttributeMaxDynamicSharedMemorySize, LDS_BYTES) != hipSuccess) { fprintf(stderr, "kernel_launch: hipFuncSetAttribute failed\n"); grid = -1; return; }
        if (hipOccupancyMaxActiveBlocksPerMultiprocessor(&per_cu, (const void*)trunk_fwd, NTHR, LDS_BYTES) != hipSuccess || per_cu < 1) { fprintf(stderr, "kernel_launch: occupancy query reports %d workgroups per CU\n", per_cu); }
        (void)hipGetLastError();
        grid = cus;
        if (grid > 1024 || (M % (grid * NWAVES)) != 0 || ((M / grid) % 64) != 0) { fprintf(stderr, "kernel_launch: unsupported CU count %d\n", grid); grid = -1; return; }
    }
    if (grid < 0) return;
    if (hipMemsetAsync((char*)d_ws + WS_CTL, 0, CTL_ZERO_BYTES, stream) != hipSuccess) return;
    Args a{};
    for (int i = 0; i < 22; ++i) a.in[i] = (const float*)d_in[i];
    a.out = (float*)d_out; a.ws = (unsigned char*)d_ws; a.pad = 0;
    if (MK_N_LAUNCHES == 1) { a.ph_lo = 0; a.ph_hi = N_PHASES; a.li = 0; hipLaunchKernelGGL(trunk_fwd, dim3(grid), dim3(NTHR), LDS_BYTES, stream, a); }
    else for (int ph = 0; ph < N_PHASES; ++ph) { a.ph_lo = ph; a.ph_hi = ph + 1; a.li = ph; hipLaunchKernelGGL(trunk_fwd, dim3(grid), dim3(NTHR), LDS_BYTES, stream, a); }
}
```
